# Optimizing an MI355X kernel written in HIP

```python
import math
import jax, jax.numpy as jnp
from jax import lax
import numpy as np

D_MODEL = 1024
BATCH = 8
SEQ = 4096
DEPTH = 4

MIX_WIDTH = D_MODEL
ATTN_HEAD_DIM = 128
ATTN_HEADS = (MIX_WIDTH // 2) // ATTN_HEAD_DIM
ATTN_WIDTH = ATTN_HEADS * ATTN_HEAD_DIM
IDX_HEADS = 8
IDX_HEAD_DIM = 64
TOPK_MAX = 256
LRU_WIDTH = MIX_WIDTH - ATTN_WIDTH
LRU_BLOCKS = 8
LRU_BLOCK = LRU_WIDTH // LRU_BLOCKS
CONV_WIDTH = 4
LRU_C = 8.0
D_FF = 4 * D_MODEL
ROPE_THETA = 10000.0
Q_BLOCK = 128
LN_EPS = 1e-5
N_MOD = 6
SPLIT_SIZES = (ATTN_WIDTH, ATTN_WIDTH, ATTN_WIDTH,
               IDX_HEADS * IDX_HEAD_DIM, IDX_HEAD_DIM, IDX_HEADS,
               LRU_WIDTH, LRU_WIDTH)
IN_COLS = sum(SPLIT_SIZES)

kernel_name = "hymba_dsa_rglru_deepnorm_adaln"


def _deepnorm_alpha():
    return (2.0 * DEPTH) ** 0.25


def _deepnorm_beta():
    return (8.0 * DEPTH) ** -0.25


def layer_norm(x, g, b):
    xf = x.astype(jnp.float32)
    mu = jnp.mean(xf, -1, keepdims=True)
    var = jnp.mean(jnp.square(xf - mu), -1, keepdims=True)
    y = (xf - mu) * lax.rsqrt(var + LN_EPS) * g.astype(jnp.float32) + b.astype(jnp.float32)
    return y.astype(x.dtype)


def rms_norm(x, g):
    xf = x.astype(jnp.float32)
    y = xf * lax.rsqrt(jnp.mean(jnp.square(xf), -1, keepdims=True) + LN_EPS) * g.astype(jnp.float32)
    return y.astype(x.dtype)


def rope_tables(positions, dim):
    inv = ROPE_THETA ** (-jnp.arange(0, dim, 2, dtype=jnp.float32) / dim)
    ang = positions.astype(jnp.float32)[..., None] * inv
    return jnp.cos(ang)[:, :, None, :], jnp.sin(ang)[:, :, None, :]


def apply_rope(x, cos, sin):
    x1, x2 = jnp.split(x.astype(jnp.float32), 2, axis=-1)
    y = jnp.concatenate([x1 * cos - x2 * sin, x2 * cos + x1 * sin], axis=-1)
    return y.astype(x.dtype)


def dsa_attention(q, k, v, qi, ki, wi):
    B, L = q.shape[0], q.shape[1]
    topk = min(TOPK_MAX, L // 4)
    qb = min(Q_BLOCK, L)
    nblk = L // qb

    def to_blocks(a):
        return a.reshape((B, nblk, qb) + a.shape[2:]).swapaxes(0, 1)

    t_blocks = jnp.arange(L, dtype=jnp.int32).reshape(nblk, qb)
    key_pos = jnp.arange(L, dtype=jnp.int32)
    scale = ATTN_HEAD_DIM ** -0.5
    ki32 = ki.astype(jnp.float32)

    def block(args):
        q_b, qi_b, wi_b, t_b = args
        causal = key_pos[None, :] <= t_b[:, None]
        rel = jax.nn.relu(jnp.einsum('bthd,bsd->bths', qi_b.astype(jnp.float32), ki32))
        idx_score = jnp.einsum('bths,bth->bts', rel, wi_b.astype(jnp.float32))
        idx_score = jnp.where(causal[None], idx_score, -jnp.inf)
        _, sel = lax.top_k(idx_score, topk)
        valid = sel <= t_b[None, :, None]
        k_sel = jax.vmap(lambda kb, ib: kb[ib])(k, sel)
        v_sel = jax.vmap(lambda vb, ib: vb[ib])(v, sel)
        s = jnp.einsum('bthd,btkhd->bhtk', q_b, k_sel).astype(jnp.float32) * scale
        s = jnp.where(valid[:, None], s, -jnp.inf)
        p = jax.nn.softmax(s, axis=-1).astype(v.dtype)
        return jnp.einsum('bhtk,btkhd->bthd', p, v_sel)

    out = lax.map(block, (to_blocks(q), to_blocks(qi), to_blocks(wi), t_blocks))
    return out.swapaxes(0, 1).reshape(B, L, -1)


def causal_depthwise_conv(x, w, b):
    S = x.shape[1]
    xp = jnp.pad(x, ((0, 0), (CONV_WIDTH - 1, 0), (0, 0)))
    y = b
    for j in range(CONV_WIDTH):
        y = y + xp[:, j:j + S] * w[j]
    return y


def _lin_combine(left, right):
    a1, b1 = left
    a2, b2 = right
    return a1 * a2, a2 * b1 + b2


def rg_lru(xc, w_a, b_a, w_x, b_x, lam):
    B, S, _ = xc.shape
    xf = xc.astype(jnp.float32)
    xb = xf.reshape(B, S, LRU_BLOCKS, LRU_BLOCK)
    r = jax.nn.sigmoid(jnp.einsum('bsnc,ncd->bsnd', xb, w_a.astype(jnp.float32)).reshape(B, S, -1)
                       + b_a.astype(jnp.float32))
    i = jax.nn.sigmoid(jnp.einsum('bsnc,ncd->bsnd', xb, w_x.astype(jnp.float32)).reshape(B, S, -1)
                       + b_x.astype(jnp.float32))
    log_a = -LRU_C * r * jax.nn.softplus(-lam.astype(jnp.float32))
    a = jnp.exp(log_a)
    u = jnp.sqrt(-jnp.expm1(2.0 * log_a)) * (i * xf)
    _, h = lax.associative_scan(_lin_combine, (a, u), axis=1)
    return h.astype(xc.dtype)


def setup_inputs(seed: int = 0) -> dict:
    key = jax.random.key(seed)
    ks = jax.random.split(key, 24)
    f32 = jnp.float32
    beta = _deepnorm_beta()
    L = DEPTH

    def nrm(k, shape, std):
        return jax.random.normal(k, shape, f32) * std

    x = jax.random.normal(ks[0], (BATCH, SEQ, D_MODEL), f32)
    c = jax.random.normal(ks[1], (BATCH, D_MODEL), f32)
    positions = jnp.broadcast_to(jnp.arange(SEQ, dtype=jnp.int32)[None, :], (BATCH, SEQ))

    w_mod = nrm(ks[2], (L, D_MODEL, N_MOD * D_MODEL), 0.1 * D_MODEL ** -0.5)
    b_mod = nrm(ks[3], (L, N_MOD * D_MODEL), 0.01)

    col_scale = np.ones((IN_COLS,), np.float32)
    col_scale[2 * ATTN_WIDTH:3 * ATTN_WIDTH] = beta
    w_in = nrm(ks[4], (L, D_MODEL, IN_COLS), D_MODEL ** -0.5) * jnp.asarray(col_scale)

    conv_w = nrm(ks[5], (L, CONV_WIDTH, LRU_WIDTH), CONV_WIDTH ** -0.5)
    conv_b = nrm(ks[6], (L, LRU_WIDTH), 0.01)
    w_gate_a = nrm(ks[7], (L, LRU_BLOCKS, LRU_BLOCK, LRU_BLOCK), LRU_BLOCK ** -0.5)
    b_gate_a = nrm(ks[8], (L, LRU_WIDTH), 0.01)
    w_gate_x = nrm(ks[9], (L, LRU_BLOCKS, LRU_BLOCK, LRU_BLOCK), LRU_BLOCK ** -0.5)
    b_gate_x = nrm(ks[10], (L, LRU_WIDTH), 0.01)
    u = jax.random.uniform(ks[11], (L, LRU_WIDTH), f32, 0.9, 0.999)
    a0 = u ** (1.0 / LRU_C)
    lru_lambda = jnp.log(a0) - jnp.log1p(-a0)

    g_attn_out = 1.0 + nrm(ks[12], (L, ATTN_WIDTH), 0.02)
    g_lru_out = 1.0 + nrm(ks[13], (L, LRU_WIDTH), 0.02)
    w_out = nrm(ks[14], (L, MIX_WIDTH, D_MODEL), MIX_WIDTH ** -0.5 * beta)
    ln1_g = 1.0 + nrm(ks[15], (L, D_MODEL), 0.02)
    ln1_b = nrm(ks[16], (L, D_MODEL), 0.02)
    w_up = nrm(ks[17], (L, D_MODEL, D_FF), D_MODEL ** -0.5)
    w_down = nrm(ks[18], (L, D_FF, D_MODEL), D_FF ** -0.5 * beta)
    ln2_g = 1.0 + nrm(ks[19], (L, D_MODEL), 0.02)
    ln2_b = nrm(ks[20], (L, D_MODEL), 0.02)

    return {"x": x, "c": c, "positions": positions,
            "w_mod": w_mod, "b_mod": b_mod, "w_in": w_in,
            "conv_w": conv_w, "conv_b": conv_b,
            "w_gate_a": w_gate_a, "b_gate_a": b_gate_a,
            "w_gate_x": w_gate_x, "b_gate_x": b_gate_x, "lru_lambda": lru_lambda,
            "g_attn_out": g_attn_out, "g_lru_out": g_lru_out, "w_out": w_out,
            "ln1_g": ln1_g, "ln1_b": ln1_b, "w_up": w_up, "w_down": w_down,
            "ln2_g": ln2_g, "ln2_b": ln2_b}


def reference(x, c, positions, w_mod, b_mod, w_in, conv_w, conv_b, w_gate_a, b_gate_a,
              w_gate_x, b_gate_x, lru_lambda, g_attn_out, g_lru_out, w_out,
              ln1_g, ln1_b, w_up, w_down, ln2_g, ln2_b):
    B, S, _ = x.shape
    alpha = _deepnorm_alpha()
    split_at = [int(v) for v in np.cumsum(SPLIT_SIZES)[:-1]]
    cos_a, sin_a = rope_tables(positions, ATTN_HEAD_DIM)
    cos_i, sin_i = rope_tables(positions, IDX_HEAD_DIM)
    c_act = jax.nn.silu(c)

    for l in range(DEPTH):
        mod = (c_act @ w_mod[l] + b_mod[l])[:, None, :]
        sh1, sc1, g1, sh2, sc2, g2 = jnp.split(mod, N_MOD, axis=-1)

        h = x * (1.0 + sc1) + sh1
        p = h @ w_in[l]
        q, k, v, qi, ki, wi, xr, yg = jnp.split(p, split_at, axis=-1)
        q = apply_rope(q.reshape(B, S, ATTN_HEADS, ATTN_HEAD_DIM), cos_a, sin_a)
        k = apply_rope(k.reshape(B, S, ATTN_HEADS, ATTN_HEAD_DIM), cos_a, sin_a)
        v = v.reshape(B, S, ATTN_HEADS, ATTN_HEAD_DIM)
        qi = apply_rope(qi.reshape(B, S, IDX_HEADS, IDX_HEAD_DIM), cos_i, sin_i)
        ki = apply_rope(ki[:, :, None, :], cos_i, sin_i)[:, :, 0, :]
        wi = wi * (IDX_HEADS ** -0.5)
        attn_out = dsa_attention(q, k, v, qi, ki, wi)

        xc = causal_depthwise_conv(xr, conv_w[l], conv_b[l])
        lru_out = rg_lru(xc, w_gate_a[l], b_gate_a[l], w_gate_x[l], b_gate_x[l], lru_lambda[l])
        lru_out = lru_out * jax.nn.gelu(yg, approximate=True)

        merged = jnp.concatenate([rms_norm(attn_out, g_attn_out[l]),
                                  rms_norm(lru_out, g_lru_out[l])], axis=-1)
        mix = merged @ w_out[l]
        x = layer_norm(alpha * x + (1.0 + g1) * mix, ln1_g[l], ln1_b[l])

        h2 = x * (1.0 + sc2) + sh2
        ff = jnp.square(jax.nn.relu(h2 @ w_up[l])) @ w_down[l]
        x = layer_norm(alpha * x + (1.0 + g2) * ff, ln2_g[l], ln2_b[l])
    return x
```

```cpp
#include <hip/hip_runtime.h>
#include <cstdio>
#include <cstdint>
#define MK_N_LAUNCHES 45
namespace pg8 {
#define PG8_LAS __attribute__((address_space(3)))
typedef unsigned short bf16_t;
typedef short bf16x8 __attribute__((ext_vector_type(8)));
typedef float f32x4 __attribute__((ext_vector_type(4)));
typedef unsigned u32x4 __attribute__((ext_vector_type(4)));
constexpr int BM = 256, BK = 64, HALF = 128, HTB = HALF * BK * 2  , STAGE_BYTES = 8 * HTB, NXCD = 8, WGM = 8;

__host__ __device__ __forceinline__ int lds_byte(int r, int c) { const int st = (r >> 4) * 2 + (c >> 5), rr = r & 15, cc = c & 31, ob = rr * 64 + cc * 2; return st * 1024 + (ob ^ (((ob >> 9) & 1) << 5)); }
__host__ __device__ __forceinline__ void stage_rc(int b, int& R, int& C) { const int st = b / 1024, sb = b % 1024, swz = sb ^ (((sb >> 9) & 1) << 5); R = (st >> 1) * 16 + swz / 64; C = (st & 1) * 32 + (swz % 64) / 2; }
__host__ __device__ __forceinline__ int perm32(int rho) { const int n = rho >> 4, i = rho & 15; return 8 * (i >> 2) + 4 * n + (i & 3); }

struct Unit { int pm, pn; };
struct Gemm { const bf16_t* A; const bf16_t* Bt; int M, N, K; };

struct StaticOrder {
    int nM, nN, nwg, G, c;
    __host__ __device__ void init(int M, int N, int G_, int c_) { nM = M / BM; nN = N / BM; nwg = nM * nN; G = G_; c = c_; }
    __host__ __device__ bool next(int i, Unit& u) const {
        const long L = (long)i * G + c; if (L >= nwg) return false;
        int wgid = (int)L; { const int q = nwg / NXCD, r = nwg % NXCD, xcd = wgid % NXCD, off = wgid / NXCD; wgid = (xcd < r ? xcd * (q + 1) : r * (q + 1) + (xcd - r) * q) + off; }
        const int nig = WGM * nN, gid = wgid / nig, fm = gid * WGM, gsz = (nM - fm) < WGM ? (nM - fm) : WGM;
        u.pm = fm + ((wgid % nig) % gsz); u.pn = (wgid % nig) / gsz; return true;
    }
    __device__ __forceinline__ void a_ready(const Unit&) const {}
    __device__ __forceinline__ void done(const Unit&) const {}
};

__device__ __forceinline__ unsigned cvt_pk_bf16(float lo, float hi) { unsigned r; asm volatile("v_cvt_pk_bf16_f32 %0, %1, %2" : "=v"(r) : "v"(lo), "v"(hi)); return r; }
typedef float f32x2 __attribute__((ext_vector_type(2)));

template <int ACT> struct EpiOutBf16 {
    static constexpr bool PERM = true, AFTER_DRAIN = false;
    bf16_t* O; int ldc;
    __device__ __forceinline__ void operator()(const f32x4 (&acc)[2][2][4][2], const Unit& u, int wr, int wc, int fr, int fq) const {
        const int row0 = u.pm * BM + wr * 64 + fr, col0 = u.pn * BM + wc * 32 + 8 * fq;
#pragma unroll
        for (int ai = 0; ai < 2; ++ai)
#pragma unroll
            for (int m = 0; m < 4; ++m) { bf16_t* rowp = O + (size_t)(row0 + ai * HALF + m * 16) * ldc + col0;
#pragma unroll
                for (int bj = 0; bj < 2; ++bj) { f32x4 v0 = acc[ai][bj][m][0], v1 = acc[ai][bj][m][1];
                    if (ACT == 1) {
#pragma unroll
                        for (int j = 0; j < 4; ++j) { const float a0 = fmaxf(v0[j], 0.f), a1 = fmaxf(v1[j], 0.f); v0[j] = a0 * a0; v1[j] = a1 * a1; } }
                    u32x4 w; w.x = cvt_pk_bf16(v0[0], v0[1]); w.y = cvt_pk_bf16(v0[2], v0[3]); w.z = cvt_pk_bf16(v1[0], v1[1]); w.w = cvt_pk_bf16(v1[2], v1[3]);
                    *(u32x4*)(rowp + bj * HALF) = w; } }
    }
};
struct EpiResid {
    static constexpr bool PERM = false, AFTER_DRAIN = false;
    const float* xin; float* out; int ldc; const float* gate; int gate_bstride; int rows_per_batch; float alpha;
    __device__ __forceinline__ void operator()(const f32x4 (&acc)[2][2][4][2], const Unit& u, int wr, int wc, int fr, int fq) const {
        const int row0 = u.pm * BM + wr * 64 + fr, col0 = u.pn * BM + wc * 32 + 4 * fq;
        const float* g = gate + (size_t)((u.pm * BM) / rows_per_batch) * gate_bstride;
        f32x4 gv[2][2];
#pragma unroll
        for (int bj = 0; bj < 2; ++bj)
#pragma unroll
            for (int n = 0; n < 2; ++n) gv[bj][n] = *(const f32x4*)(g + col0 + bj * HALF + n * 16) + 1.0f;
#pragma unroll
        for (int ai = 0; ai < 2; ++ai)
#pragma unroll
            for (int m = 0; m < 4; ++m) { const size_t off = (size_t)(row0 + ai * HALF + m * 16) * ldc + col0;
#pragma unroll
                for (int bj = 0; bj < 2; ++bj)
#pragma unroll
                    for (int n = 0; n < 2; ++n) { const f32x4 xv = *(const f32x4*)(xin + off + bj * HALF + n * 16);
                        *(f32x4*)(out + off + bj * HALF + n * 16) = xv * alpha + gv[bj][n] * acc[ai][bj][m][n]; }
                asm volatile("" ::: "memory"); }
    }
};
template <class Epi, class Sched, bool ALIGN_EPI = false, bool SP2 = false>
__device__ __forceinline__ void gemm_phase(PG8_LAS unsigned char* lds, const Gemm g, const Sched& S, const Epi& E) {
    int tid_l = threadIdx.x; asm volatile("" : "+v"(tid_l));
    const int tid = tid_l, wid = __builtin_amdgcn_readfirstlane(tid >> 6), lane = tid & 63, wr = wid >> 2, wc = wid & 3, fr = lane & 15, fq = lane >> 4;
    const int K = g.K, nt = K / BK;
    unsigned voffA[2], voffB[2];
#pragma unroll
    for (int i = 0; i < 2; ++i) { int R, C; stage_rc(tid * 16 + i * 8192, R, C); const int Rb = Epi::PERM ? ((R & ~31) + perm32(R & 31)) : R;
        voffA[i] = (unsigned)(R * K + C) * 2u; voffB[i] = (unsigned)(Rb * K + C) * 2u; }
    const size_t kstep = (size_t)(BK * 2);
    const size_t hstep = (size_t)HALF * K * 2;
    const size_t tstep = 2 * hstep;
    const unsigned ldsw = (unsigned)wid * 1024u;
    const int aoff = lds_byte(wr * 64 + fr, fq * 8), boff = lds_byte(wc * 32 + fr, fq * 8);
#define PG8_SA(b, h) (((b) * 2 + (h)) * HTB)
#define PG8_SB(b, h) ((4 + (b) * 2 + (h)) * HTB)
#define PG8_STAGE(bufoff, gbase, voff) do { _Pragma("unroll") for (int _i = 0; _i < 2; ++_i) \
        __builtin_amdgcn_global_load_lds((const unsigned*)((const char*)(gbase) + (voff)[_i]), (PG8_LAS unsigned*)(lds + (bufoff) + ldsw + _i * 8192), 16, 0, 0); } while (0)
#define PG8_LDA(dst, b, h) do { _Pragma("unroll") for (int m = 0; m < 4; ++m) _Pragma("unroll") for (int k = 0; k < 2; ++k) dst[m][k] = *(const PG8_LAS bf16x8*)(lds + PG8_SA(b, h) + aoff + m * 2048 + k * 1024); } while (0)
#define PG8_LDB(dst, b, h) do { _Pragma("unroll") for (int n = 0; n < 2; ++n) _Pragma("unroll") for (int k = 0; k < 2; ++k) dst[n][k] = *(const PG8_LAS bf16x8*)(lds + PG8_SB(b, h) + boff + n * 2048 + k * 1024); } while (0)
#define PG8_MMA(ai, bj, At, Bt) do { __builtin_amdgcn_s_setprio(1); _Pragma("unroll") for (int m = 0; m < 4; ++m) _Pragma("unroll") for (int n = 0; n < 2; ++n) _Pragma("unroll") for (int k = 0; k < 2; ++k) \
        acc[ai][bj][m][n] = __builtin_amdgcn_mfma_f32_16x16x32_bf16(Bt[n][k], At[m][k], acc[ai][bj][m][n], 0, 0, 0); __builtin_amdgcn_s_setprio(0); } while (0)
#define PG8_WAIT_V(n) asm volatile("s_waitcnt vmcnt(" #n ")" ::: "memory")
#define PG8_WAIT_L(n) asm volatile("s_waitcnt lgkmcnt(" #n ")" ::: "memory")
#define PG8_BAR __builtin_amdgcn_s_barrier()
#define PG8_SCHED __builtin_amdgcn_sched_barrier(0)
    Unit cur, nxt; int ui = 0;
    if (!S.next(0, cur)) return;
    f32x4 acc[2][2][4][2];
#pragma unroll
    for (int a = 0; a < 2; ++a)
#pragma unroll
        for (int b = 0; b < 2; ++b)
#pragma unroll
            for (int m = 0; m < 4; ++m)
#pragma unroll
                for (int n = 0; n < 2; ++n) acc[a][b][m][n] = (f32x4){0.f, 0.f, 0.f, 0.f};
    bf16x8 At[4][2], B0[2][2], B1[2][2];
    const char* cA = (const char*)g.A + (size_t)cur.pm * tstep; const char* cB = (const char*)g.Bt + (size_t)cur.pn * tstep;
    S.a_ready(cur);
    if constexpr (SP2) {
        PG8_STAGE(PG8_SB(0, 0), cB, voffB); PG8_STAGE(PG8_SB(0, 1), cB + hstep, voffB); PG8_STAGE(PG8_SA(0, 0), cA, voffA); PG8_STAGE(PG8_SA(0, 1), cA + hstep, voffA);
        if (wr == 1) PG8_BAR;
        PG8_WAIT_V(2); PG8_BAR;
        PG8_STAGE(PG8_SB(1, 0), cB + kstep, voffB); PG8_STAGE(PG8_SA(1, 0), cA + kstep, voffA); PG8_STAGE(PG8_SB(1, 1), cB + hstep + kstep, voffB);
        PG8_WAIT_V(6); PG8_BAR;
    } else {
        PG8_STAGE(PG8_SB(0, 0), cB, voffB); PG8_STAGE(PG8_SA(0, 0), cA, voffA); PG8_STAGE(PG8_SB(0, 1), cB + hstep, voffB); PG8_STAGE(PG8_SA(0, 1), cA + hstep, voffA);
        if (wr == 1) PG8_BAR;
        PG8_WAIT_V(4); PG8_BAR;
        PG8_STAGE(PG8_SB(1, 0), cB + kstep, voffB); PG8_STAGE(PG8_SA(1, 0), cA + kstep, voffA); PG8_STAGE(PG8_SB(1, 1), cB + hstep + kstep, voffB);
        PG8_WAIT_V(6); PG8_BAR;
    }
    for (;;) {
        const bool has_next = S.next(ui + 1, nxt);
        const char* nA = has_next ? (const char*)g.A + (size_t)nxt.pm * tstep : cA; const char* nB = has_next ? (const char*)g.Bt + (size_t)nxt.pn * tstep : cB;
        for (int t = 0; t < nt; t += 2) {
            const bool last = (t == nt - 2);
            const char* a1 = cA + (size_t)(t + 1) * kstep;
            const char* a2 = last ? nA : cA + (size_t)(t + 2) * kstep; const char* b2 = last ? nB : cB + (size_t)(t + 2) * kstep;
            const char* a3 = a2 + kstep; const char* b3 = b2 + kstep;
            if (last && has_next) S.a_ready(nxt);
            if constexpr (SP2) {
            PG8_LDB(B0, 0, 0); PG8_LDB(B1, 0, 1); PG8_SCHED; PG8_LDA(At, 0, 0); PG8_STAGE(PG8_SA(1, 1), a1 + hstep, voffA);
            PG8_WAIT_V(8); PG8_WAIT_L(0); PG8_BAR; PG8_MMA(0, 0, At, B0); PG8_MMA(0, 1, At, B1); PG8_BAR; PG8_SCHED;
            PG8_LDA(At, 0, 1); PG8_STAGE(PG8_SB(0, 0), b2, voffB); PG8_STAGE(PG8_SB(0, 1), b2 + hstep, voffB); PG8_STAGE(PG8_SA(0, 0), a2, voffA);
            PG8_WAIT_V(8); PG8_WAIT_L(0); PG8_BAR; PG8_MMA(1, 0, At, B0); PG8_MMA(1, 1, At, B1); PG8_BAR; PG8_SCHED;
            PG8_LDB(B0, 1, 0); PG8_LDB(B1, 1, 1); PG8_SCHED; PG8_LDA(At, 1, 0); PG8_STAGE(PG8_SA(0, 1), a2 + hstep, voffA);
            PG8_WAIT_V(8); PG8_WAIT_L(0); PG8_BAR; PG8_MMA(0, 0, At, B0); PG8_MMA(0, 1, At, B1); PG8_BAR; PG8_SCHED;
            PG8_LDA(At, 1, 1); PG8_STAGE(PG8_SB(1, 0), b3, voffB); PG8_STAGE(PG8_SB(1, 1), b3 + hstep, voffB); PG8_STAGE(PG8_SA(1, 0), a3, voffA);
            PG8_WAIT_V(8); PG8_WAIT_L(0); PG8_BAR; PG8_MMA(1, 0, At, B0); PG8_MMA(1, 1, At, B1); PG8_BAR; PG8_SCHED;
            } else {
            PG8_LDB(B0, 0, 0); PG8_SCHED; PG8_LDA(At, 0, 0); PG8_STAGE(PG8_SA(1, 1), a1 + hstep, voffA);
            PG8_WAIT_L(8); PG8_BAR; PG8_WAIT_L(0); PG8_MMA(0, 0, At, B0); PG8_BAR; PG8_SCHED;
            PG8_LDB(B1, 0, 1); PG8_STAGE(PG8_SB(0, 0), b2, voffB);
            PG8_BAR; PG8_WAIT_L(0); PG8_MMA(0, 1, At, B1); PG8_BAR;
            PG8_LDA(At, 0, 1); PG8_STAGE(PG8_SA(0, 0), a2, voffA);
            PG8_BAR; PG8_WAIT_L(0); PG8_MMA(1, 0, At, B0); PG8_BAR; PG8_SCHED;
            PG8_STAGE(PG8_SB(0, 1), b2 + hstep, voffB);
            PG8_WAIT_V(6); PG8_BAR; PG8_MMA(1, 1, At, B1); PG8_BAR;
            PG8_LDB(B0, 1, 0); PG8_SCHED; PG8_LDA(At, 1, 0); PG8_STAGE(PG8_SA(0, 1), a2 + hstep, voffA);
            PG8_WAIT_L(8); PG8_BAR; PG8_WAIT_L(0); PG8_MMA(0, 0, At, B0); PG8_BAR; PG8_SCHED;
            PG8_LDB(B1, 1, 1); PG8_STAGE(PG8_SB(1, 0), b3, voffB);
            PG8_BAR; PG8_WAIT_L(0); PG8_MMA(0, 1, At, B1); PG8_BAR;
            PG8_LDA(At, 1, 1); PG8_STAGE(PG8_SA(1, 0), a3, voffA);
            PG8_BAR; PG8_WAIT_L(0); PG8_MMA(1, 0, At, B0); PG8_BAR; PG8_SCHED;
            PG8_STAGE(PG8_SB(1, 1), b3 + hstep, voffB);
            PG8_WAIT_V(6); PG8_BAR; PG8_MMA(1, 1, At, B1); PG8_BAR;
            }
        }
        if constexpr (ALIGN_EPI) { if (wr == 0) PG8_BAR; }
        if constexpr (!Epi::AFTER_DRAIN) { E(acc, cur, wr, wc, fr, fq); S.done(cur); }
        if (!has_next) break;
#pragma unroll
        for (int a = 0; a < 2; ++a)
#pragma unroll
            for (int b = 0; b < 2; ++b)
#pragma unroll
                for (int m = 0; m < 4; ++m)
#pragma unroll
                    for (int n = 0; n < 2; ++n) acc[a][b][m][n] = (f32x4){0.f, 0.f, 0.f, 0.f};
        cur = nxt; cA = nA; cB = nB; ++ui;
        if constexpr (ALIGN_EPI) { if (wr == 1) PG8_BAR; }
    }
    PG8_WAIT_V(0);
    if constexpr (!ALIGN_EPI) { if (wr == 0) PG8_BAR; }
    PG8_BAR;
    if constexpr (Epi::AFTER_DRAIN) { E.fused(acc, cur, wr, wc, fr, fq, lds, wid, lane); S.done(cur); }
#undef PG8_SA
#undef PG8_SB
#undef PG8_STAGE
#undef PG8_LDA
#undef PG8_LDB
#undef PG8_MMA
#undef PG8_WAIT_V
#undef PG8_WAIT_L
#undef PG8_BAR
#undef PG8_SCHED
}
}
#define GAS __attribute__((address_space(1)))
#define LAS __attribute__((address_space(3)))
typedef unsigned short bf16;
typedef unsigned v4u __attribute__((ext_vector_type(4)));
typedef float f32x4 __attribute__((ext_vector_type(4)));
typedef short bf16x8 __attribute__((ext_vector_type(8)));
typedef GAS unsigned gu32;
typedef GAS unsigned long long gu64;
#define RLX_AGENT __ATOMIC_RELAXED, __HIP_MEMORY_SCOPE_AGENT
#define LDS_WAIT() asm volatile("s_waitcnt lgkmcnt(0)" ::: "memory")
#define VM_WAIT() asm volatile("s_waitcnt vmcnt(0)" ::: "memory")
__device__ __forceinline__ unsigned long long rt() { return __builtin_amdgcn_s_memrealtime(); }
__device__ __forceinline__ unsigned f2bf(float f) { unsigned u = __builtin_bit_cast(unsigned, f); return (u + 0x7fffu + ((u >> 16) & 1u)) >> 16; }
__device__ __forceinline__ unsigned pk2(float lo, float hi) { return f2bf(lo) | (f2bf(hi) << 16); }

#define XB_TMO      128
#define XB_XCNT(j)  (256  + 64 * (j))
#define XB_XSUB(j)  (1280 + 64 * (j))
#define XB_XGEN(j)  (2304 + 64 * (j))
#define XB_TOP      3328
#define XB_TOPGEN   3392
#define XCD_BAR_WORDS 3456
#define XB_SPIN_CAP (1u << 18)

__device__ __forceinline__ unsigned xb_ld(unsigned* p)              { return __hip_atomic_load(p, __ATOMIC_RELAXED, __HIP_MEMORY_SCOPE_AGENT); }
__device__ __forceinline__ unsigned xb_add(unsigned* p, unsigned v) { return __hip_atomic_fetch_add(p, v, __ATOMIC_RELAXED, __HIP_MEMORY_SCOPE_AGENT); }
__device__ __forceinline__ unsigned xb_xcc_id() { return (unsigned)__builtin_amdgcn_s_getreg((3 << 11) | 20) & 0xFu; }
#define XB_SPIN(cond, bar) do { unsigned _sp = 0; while (cond) { __builtin_amdgcn_s_sleep(1); \
    if ((++_sp & 255u) == 0u) { if (xb_ld(&(bar)[XB_TMO])) break; if (_sp > XB_SPIN_CAP) { atomicAdd(&(bar)[XB_TMO], 1u); break; } } } } while (0)

struct XcdBarrier {
    unsigned* bar; unsigned x;
    volatile LAS unsigned* st;
};

__device__ __forceinline__ XcdBarrier xcd_barrier_post(unsigned* bar, volatile LAS unsigned* st) {
    XcdBarrier b; b.bar = bar; b.x = xb_xcc_id(); b.st = st;
    if (threadIdx.x == 0) (void)xb_add(&bar[XB_XCNT(b.x)], 1u);
    return b;
}
__device__ __forceinline__ void xcd_barrier_complete(unsigned* bar, unsigned x, unsigned& nloc, unsigned& nx) {
    const unsigned G = gridDim.x * gridDim.y * gridDim.z;
    unsigned sum, cnt, mine, sp = 0u;
    for (;;) {
        sum = 0u; cnt = 0u; mine = 0u;
#pragma unroll
        for (unsigned j = 0; j < 16; ++j) { const unsigned c = xb_ld(&bar[XB_XCNT(j)]); sum += c; cnt += (c > 0u) ? 1u : 0u; mine = (j == x) ? c : mine; }
        if (sum == G) break;
        __builtin_amdgcn_s_sleep(1);
        if ((++sp & 255u) == 0u) { if (xb_ld(&bar[XB_TMO])) break; if (sp > XB_SPIN_CAP) { atomicAdd(&bar[XB_TMO], 1u); break; } }
    }
    nloc = mine > 0u ? mine : 1u; nx = cnt > 0u ? cnt : 1u;
}

__device__ __forceinline__ void xcd_barrier(const XcdBarrier& b) {
    asm volatile("s_waitcnt vmcnt(0)" ::: "memory");
    __syncthreads();
    if (threadIdx.x == 0) {
        unsigned* bar = b.bar;
        __builtin_amdgcn_s_waitcnt(0);
        unsigned nloc = b.st[0], nx = b.st[1];
        if (nloc == 0u) { xcd_barrier_complete(bar, b.x, nloc, nx); b.st[0] = nloc; b.st[1] = nx; }
        const unsigned old = xb_add(&bar[XB_XSUB(b.x)], 1u);
        const unsigned gen = old / nloc;
        if (old + 1u == (gen + 1u) * nloc) {
            __builtin_amdgcn_fence(__ATOMIC_RELEASE, "agent");
            asm volatile("s_waitcnt vmcnt(0)" ::: "memory");
            const unsigned og = xb_add(&bar[XB_TOP], 1u);
            const unsigned tg = og / nx;
            if (og + 1u == (tg + 1u) * nx) xb_add(&bar[XB_TOPGEN], 1u);
            else XB_SPIN(xb_ld(&bar[XB_TOPGEN]) == tg, bar);
            __builtin_amdgcn_fence(__ATOMIC_ACQUIRE, "agent");
            xb_add(&bar[XB_XGEN(b.x)], 1u);
            asm volatile("s_waitcnt vmcnt(0)" ::: "memory");
        } else {
            XB_SPIN(xb_ld(&bar[XB_XGEN(b.x)]) == gen, bar);
            __builtin_amdgcn_fence(__ATOMIC_ACQUIRE, "agent");
            asm volatile("s_waitcnt vmcnt(0)" ::: "memory");
        }
    }
    __syncthreads();
}

constexpr int NWAVES = 8, NTHR = NWAVES * 64;
constexpr int BATCH = 8, SEQ = 4096, DMODEL = 1024, DEPTH = 4, MTOK = BATCH * SEQ;
constexpr int AW = 512, NHEAD = 4, HD = 128, IH = 8, IDIM = 64, TOPK = 256, LW = 512, LBLK = 8, LBS = 64, FF = 4096, NMOD = 6;
constexpr int INC = 3144, INP = 3328;
constexpr int CQ = 0, CK = 512, CV = 1024, CQI = 1536, CKI = 2048, CWI = 2112, CXR = 2120, CYG = 2632;
constexpr int MODW = NMOD * DMODEL;
constexpr float LN_EPS = 1e-5f;
constexpr float ALPHA = 1.6817928305074290f;
constexpr float LOG2E = 1.4426950408889634f;
constexpr int LCH = 128, NLCH = SEQ / LCH;

constexpr size_t MiB = 1u << 20;
constexpr size_t WS_CTL = 0, CTL_ZERO_BYTES = 1 * MiB;
constexpr size_t WS_MOD = 1 * MiB;
constexpr size_t WS_GATE = 2 * MiB;
constexpr size_t WS_CARRY = 3 * MiB;
constexpr size_t WS_WI = 4 * MiB;
constexpr size_t WS_KI = 5 * MiB;
constexpr size_t WS_MASK = 9 * MiB;
constexpr size_t WS_WIN = 25 * MiB;
constexpr size_t WS_WOUT = 51 * MiB;
constexpr size_t WS_WUP = 59 * MiB;
constexpr size_t WS_WDN = 91 * MiB;
constexpr size_t WS_HA = 123 * MiB;
constexpr size_t WS_P = 187 * MiB;
constexpr size_t WS_MG = 395 * MiB;
constexpr size_t WS_HID = 187 * MiB;
constexpr size_t WS_END = 459 * MiB;
static_assert(WS_WIN + (size_t)DEPTH * INP * 1024 * 2 <= WS_WOUT && WS_P + (size_t)MTOK * INP * 2 <= WS_MG && WS_HID + (size_t)MTOK * FF * 2 <= WS_END && WS_MG + (size_t)MTOK * 1024 * 2 <= WS_END, "d_ws map");
constexpr int CW_BAR = 4096;

constexpr int RING_BYTES = 131072;
constexpr int LDSCTL_OFF = RING_BYTES, MISC_OFF = LDSCTL_OFF + 320;
constexpr int LDS_BYTES = 147456;

__device__ __constant__ float ROPE_INV[64] = {
1.000000000e+00f, 8.659643531e-01f, 7.498942614e-01f, 6.493816376e-01f, 5.623413324e-01f, 4.869675338e-01f, 4.216965139e-01f, 3.651741147e-01f, 3.162277639e-01f, 2.738419771e-01f, 2.371373773e-01f, 2.053525001e-01f, 1.778279394e-01f, 1.539926529e-01f, 1.333521307e-01f, 1.154782027e-01f, 1.000000015e-01f, 8.659642935e-02f, 7.498941571e-02f, 6.493816525e-02f, 5.623413250e-02f, 4.869675264e-02f, 4.216965288e-02f, 3.651741147e-02f, 3.162277490e-02f, 2.738419734e-02f, 2.371373773e-02f, 2.053525113e-02f, 1.778279431e-02f, 1.539926510e-02f, 1.333521493e-02f, 1.154782064e-02f, 9.999999776e-03f, 8.659643121e-03f, 7.498941850e-03f, 6.493816152e-03f, 5.623413250e-03f, 4.869675264e-03f, 4.216964822e-03f, 3.651741194e-03f, 3.162277630e-03f, 2.738419687e-03f, 2.371373586e-03f, 2.053524833e-03f, 1.778279431e-03f, 1.539926510e-03f, 1.333521446e-03f, 1.154781901e-03f, 1.000000047e-03f, 8.659643354e-04f, 7.498942432e-04f, 6.493816618e-04f, 5.623413017e-04f, 4.869675322e-04f, 4.216965172e-04f, 3.651741426e-04f, 3.162277571e-04f, 2.738419571e-04f, 2.371373703e-04f, 2.053525095e-04f, 1.778279402e-04f, 1.539926452e-04f, 1.333521504e-04f, 1.154782003e-04f };

typedef float f32x16 __attribute__((ext_vector_type(16)));
typedef unsigned u32x2 __attribute__((ext_vector_type(2)));
__device__ __forceinline__ float bf2f(unsigned short b) { return __builtin_bit_cast(float, ((unsigned)b) << 16); }
__device__ __forceinline__ unsigned cvtpk(float lo, float hi) { unsigned r; asm volatile("v_cvt_pk_bf16_f32 %0, %1, %2" : "=v"(r) : "v"(lo), "v"(hi)); return r; }
__device__ __forceinline__ float wave_sum(float v) {
#pragma unroll
    for (int o = 1; o < 64; o <<= 1) v += __shfl_xor(v, o);
    return v;
}
__device__ __forceinline__ float wave_max(float v) {
#pragma unroll
    for (int o = 1; o < 64; o <<= 1) v = fmaxf(v, __shfl_xor(v, o));
    return v;
}
__device__ __forceinline__ float wave_min(float v) {
#pragma unroll
    for (int o = 1; o < 64; o <<= 1) v = fminf(v, __shfl_xor(v, o));
    return v;
}
__device__ __forceinline__ float sigmoidf_fast(float z) { return __builtin_amdgcn_rcpf(1.0f + __builtin_amdgcn_exp2f(-z * LOG2E)); }

struct Args {
    const float* x; const float* c; const int* pos;
    const float *w_mod, *b_mod, *w_in, *conv_w, *conv_b, *wga, *bga, *wgx, *bgx, *lam, *g_attn, *g_lru, *w_out, *ln1_g, *ln1_b, *w_up, *w_down, *ln2_g, *ln2_b;
    float* out; unsigned char* ws; int ph_lo, ph_hi;
};

namespace att {
constexpr int D = 128, NW = 8, QBLK = 32, KVBLK = 64, QB = NW * QBLK;
constexpr int SHM_V = KVBLK * D * 2, SHM_K = KVBLK * D * 2;
constexpr int LDS_BYTES = 2 * SHM_V + 2 * SHM_K + NW * 64 * 4;
constexpr float SCALE = 0.08838834764831845f, THR = 8.f;
constexpr int PQ = INP, PO = DMODEL;
constexpr int MKW = SEQ / 32;
#define KSWZ(row, colB) ((row) * 256 + ((colB) ^ (((row) & 7) << 4)))
#define SBAR() __builtin_amdgcn_sched_barrier(0)
__device__ __forceinline__ int v_st(int k, int c) { const int kk = (k & ~0xC) | ((k & 4) << 1) | ((k & 8) >> 1); return ((kk >> 3) * 4 + (c >> 5)) * 512 + ((kk & 7) * 32 + (c & 31)) * 2; }
__device__ __forceinline__ int v_rd_base(int lane) { return ((lane & 3) << 3) | (((lane >> 2) & 3) << 6) | (((lane >> 4) & 1) << 5) | (((lane >> 5) & 1) << 8); }
constexpr int v_rd_off(int d0, int ks, int half) { return d0 * 512 + ks * 4096 + half * 2048; }
__device__ __forceinline__ int crow(int r, int hi) { return (r & 3) + 8 * (r >> 2) + 4 * hi; }
typedef short s16x4 __attribute__((ext_vector_type(4)));
template <class T> __device__ __forceinline__ T* uni(T* p) { const unsigned long long v = (unsigned long long)(uintptr_t)p; const unsigned lo = __builtin_amdgcn_readfirstlane((unsigned)v), hi = __builtin_amdgcn_readfirstlane((unsigned)(v >> 32)); return (T*)(GAS T*)(uintptr_t)(((unsigned long long)hi << 32) | lo); }
__device__ __forceinline__ bf16x8 load8(const bf16* p) { return *reinterpret_cast<const bf16x8*>(p); }
__device__ __forceinline__ void mask_tile(f32x16& p0, f32x16& p1, int dq) {
    const float NEG = -__builtin_inff();
#pragma unroll
    for (int r = 0; r < 16; ++r) {
        const int c = (r & 3) + 8 * (r >> 2);
        if (dq - c < 0) p0[r] = NEG;
        if (dq - c - 32 < 0) p1[r] = NEG;
    }
}
__device__ __forceinline__ void apply_bits(f32x16& p, unsigned ws) {
#ifdef ATT_NOMASK
    return;
#endif
#pragma unroll
    for (int r = 0; r < 16; ++r) { const int c = (r & 3) + 8 * (r >> 2); const unsigned m = (unsigned)(((int)(ws << (31 - c))) >> 31); const float pv = p[r]; p[r] = __uint_as_float(__float_as_uint(pv) & m); }
}
__device__ __forceinline__ void partialSM(f32x16& p0, f32x16& p1, float& m_reg, float& mn, float& alpha, unsigned w0s) {
    float pmax = p0[0];
#pragma unroll
    for (int r = 1; r < 16; ++r) pmax = fmaxf(pmax, p0[r]);
#pragma unroll
    for (int r = 0; r < 16; ++r) pmax = fmaxf(pmax, p1[r]);
    { auto rr = __builtin_amdgcn_permlane32_swap(__float_as_uint(pmax), __float_as_uint(pmax), false, false);
      pmax = fmaxf(__uint_as_float(rr[0]), __uint_as_float(rr[1])); }
    constexpr float C2 = 1.4426950408889634f * SCALE;
    if (__builtin_expect(__all((pmax - m_reg) * SCALE <= THR), 1)) { mn = m_reg; alpha = 1.f; }
    else { mn = fmaxf(m_reg, pmax); alpha = __builtin_amdgcn_exp2f((m_reg - mn) * C2); m_reg = mn; }
    const float mnL = -mn * C2;
#pragma unroll
    for (int r = 0; r < 16; ++r) p0[r] = fmaf(p0[r], C2, mnL);
#pragma unroll
    for (int r = 0; r < 16; ++r) p1[r] = fmaf(p1[r], C2, mnL);
#pragma unroll
    for (int r = 0; r < 16; ++r) p0[r] = __builtin_amdgcn_exp2f(p0[r]);
    apply_bits(p0, w0s);
}
__device__ __forceinline__ void finishSM(f32x16& p0, f32x16& p1, float alpha, float& l_reg, bf16x8& pa0, bf16x8& pa1, bf16x8& pa2, bf16x8& pa3, unsigned w1s) {
#pragma unroll
    for (int r = 0; r < 16; ++r) p1[r] = __builtin_amdgcn_exp2f(p1[r]);
    apply_bits(p1, w1s);
    float ps = 0;
#pragma unroll
    for (int r = 0; r < 16; ++r) ps += p0[r];
#pragma unroll
    for (int r = 0; r < 16; ++r) ps += p1[r];
    { auto rr = __builtin_amdgcn_permlane32_swap(__float_as_uint(ps), __float_as_uint(ps), false, false);
      ps = __uint_as_float(rr[0]) + __uint_as_float(rr[1]); }
    l_reg = l_reg * alpha + ps;
#define PK4(P, B_, OUT) do { unsigned a0 = cvtpk(P[B_+0], P[B_+1]), a1 = cvtpk(P[B_+2], P[B_+3]);                          \
        unsigned b0 = cvtpk(P[B_+4], P[B_+5]), b1 = cvtpk(P[B_+6], P[B_+7]);                                             \
        auto r0 = __builtin_amdgcn_permlane32_swap(a0, b0, false, false); auto r1 = __builtin_amdgcn_permlane32_swap(a1, b1, false, false); \
        v4u w = {r0[0], r1[0], r0[1], r1[1]}; OUT = *reinterpret_cast<bf16x8*>(&w); } while (0)
    PK4(p0, 0, pa0); PK4(p0, 8, pa1); PK4(p1, 0, pa2); PK4(p1, 8, pa3);
#undef PK4
}
template <int KB>
__device__ __forceinline__ void qkt(f32x16& p0, f32x16& p1, const char* K_lds, int r32, int hi, const bf16x8* qr) {
    p0 = f32x16{}; p1 = f32x16{};
    const char* kb[4];
#pragma unroll
    for (int dd = 0; dd < 4; ++dd) kb[dd] = K_lds + KB * SHM_K + KSWZ(r32, (dd * 16 + hi * 8) * 2);
#pragma unroll
    for (int d0 = 0; d0 < 8; ++d0) { const char* a = kb[d0 & 3] + (d0 >> 2) * 128;
        bf16x8 b0 = *reinterpret_cast<const bf16x8*>(a);
        bf16x8 b1 = *reinterpret_cast<const bf16x8*>(a + 32 * 256);
        p0 = __builtin_amdgcn_mfma_f32_32x32x16_bf16(b0, qr[d0], p0, 0, 0, 0);
        p1 = __builtin_amdgcn_mfma_f32_32x32x16_bf16(b1, qr[d0], p1, 0, 0, 0); }
}
template <int VB>
__device__ __forceinline__ void pv_tile(f32x16* o, int vb0, bf16x8 pa0, bf16x8 pa1, bf16x8 pa2, bf16x8 pa3) {
#define TRRD(dst, off) asm volatile("ds_read_b64_tr_b16 %0, %1 offset:%2" : "=&v"(dst) : "v"(vb0), "i"(off) : "memory")
#define PV_D0(d0) do { s16x4 l0, l1, l2, l3, h0, h1, h2, h3; constexpr int b_ = VB * SHM_V + v_rd_off(d0, 0, 0); \
        TRRD(l0, b_); TRRD(h0, b_ + 2048); TRRD(l1, b_ + 4096); TRRD(h1, b_ + 6144); TRRD(l2, b_ + 8192); TRRD(h2, b_ + 10240); TRRD(l3, b_ + 12288); TRRD(h3, b_ + 14336); \
        asm volatile("s_waitcnt lgkmcnt(0)" ::: "memory"); SBAR();   \
        o[d0] = __builtin_amdgcn_mfma_f32_32x32x16_bf16(pa0, (bf16x8){l0[0], l0[1], l0[2], l0[3], h0[0], h0[1], h0[2], h0[3]}, o[d0], 0, 0, 0);   \
        o[d0] = __builtin_amdgcn_mfma_f32_32x32x16_bf16(pa1, (bf16x8){l1[0], l1[1], l1[2], l1[3], h1[0], h1[1], h1[2], h1[3]}, o[d0], 0, 0, 0);   \
        o[d0] = __builtin_amdgcn_mfma_f32_32x32x16_bf16(pa2, (bf16x8){l2[0], l2[1], l2[2], l2[3], h2[0], h2[1], h2[2], h2[3]}, o[d0], 0, 0, 0);   \
        o[d0] = __builtin_amdgcn_mfma_f32_32x32x16_bf16(pa3, (bf16x8){l3[0], l3[1], l3[2], l3[3], h3[0], h3[1], h3[2], h3[3]}, o[d0], 0, 0, 0); } while (0)
    PV_D0(0); PV_D0(1); PV_D0(2); PV_D0(3);
#undef PV_D0
#undef TRRD
}
struct Bases { const char* P; char* MG; const char* MK; };
struct BlockRef { unsigned q, k, v, o, mk; int P0; };
struct Seam { bf16x8 qr[8]; bf16x8 st_v0, st_v1, st_k0, st_k1; };
#define VMW() asm volatile("s_waitcnt vmcnt(0)" ::: "memory")
#define VMWN(n) asm volatile("s_waitcnt vmcnt(%0)" :: "i"(n) : "memory")
#define SLOAD_H(Kp, Vp, k0) do { const char* kk_ = (Kp) + (size_t)(k0) * (PQ * 2); const char* vv_ = (Vp) + (size_t)(k0) * (PQ * 2);              \
                         S.st_v0 = *(const bf16x8*)(vv_ + so0); S.st_v1 = *(const bf16x8*)(vv_ + so1);              \
                         S.st_k0 = *(const bf16x8*)(kk_ + so0); S.st_k1 = *(const bf16x8*)(kk_ + so1); } while (0)
#define SWRITE_HK(bf) do { *(bf16x8*)(K_lds + (bf) * SHM_K + kws) = S.st_k0; *(bf16x8*)(K_lds + (bf) * SHM_K + kws + 32 * 256) = S.st_k1; } while (0)
#define SWRITE_HV(bf) do { *(bf16x8*)(V_lds + (bf) * SHM_V + vst0) = S.st_v0; *(bf16x8*)(V_lds + (bf) * SHM_V + vst1) = S.st_v1; } while (0)
#define SWRITE_H(bf) do { SWRITE_HV(bf); SWRITE_HK(bf); } while (0)
__device__ __forceinline__ void prime(const Bases& B, const BlockRef& cur, char* lds, Seam& S) {
    int tid_l = threadIdx.x; asm volatile("" : "+v"(tid_l));
    const int tid = tid_l, wid = __builtin_amdgcn_readfirstlane(tid >> 6), lane = tid & 63, r32 = lane & 31, hi = lane >> 5;
    const int sr = tid >> 4, sc = (tid & 15) * 8, kws = KSWZ(sr, sc * 2); char* K_lds = lds + 2 * SHM_V;
    const unsigned so0 = (unsigned)(sr * PQ + sc) * 2u, so1 = so0 + 32u * PQ * 2u;
    const unsigned qo = (unsigned)((wid * QBLK + r32) * PQ + hi * 8) * 2u;
    const char* Qb = B.P + cur.q; const char* Kb = B.P + cur.k; const char* Vb = B.P + cur.v;
#pragma unroll
    for (int d0 = 0; d0 < 8; ++d0) S.qr[d0] = *(const bf16x8*)(Qb + qo + d0 * 32);
    SLOAD_H(Kb, Vb, 0); VMW(); SWRITE_HK(0);
    __syncthreads();
}
__device__ __forceinline__ void block(const Bases& B, const BlockRef& cur, const BlockRef& nxt, char* lds, Seam& S) {
    int tid_l = threadIdx.x; asm volatile("" : "+v"(tid_l));
    const int tid = tid_l, wid = __builtin_amdgcn_readfirstlane(tid >> 6), lane = tid & 63, r32 = lane & 31, hi = lane >> 5;
    const int NT = cur.P0 / KVBLK + QB / KVBLK;
    const int qlo = cur.P0 + wid * QBLK, qm = qlo + r32 - 4 * hi;
    char* V_lds = lds; char* K_lds = lds + 2 * SHM_V;
    float* ws = (float*)(lds + 2 * SHM_V + 2 * SHM_K) + wid * 64; float* li_l = ws, * al_l = ws + 32;
    float m_reg = -1e30f, l_reg = 0; f32x16 o[4] = {};
    const int sr = tid >> 4, sc = (tid & 15) * 8, vst0 = v_st(sr, sc), vst1 = v_st(32 + sr, sc), kws = KSWZ(sr, sc * 2);
    const int vb0 = (int)(uintptr_t)V_lds + v_rd_base(lane);
    const char* Kh = B.P + cur.k; const char* Vh = B.P + cur.v;
    const unsigned so0 = (unsigned)(sr * PQ + sc) * 2u, so1 = so0 + 32u * PQ * 2u;
    const unsigned qo = (unsigned)((wid * QBLK + r32) * PQ + hi * 8) * 2u;
    const char* mkb = B.MK + cur.mk; const unsigned mo = (unsigned)(wid * QBLK + r32) * (MKW * 4u);
    const int sh4 = 4 * hi;
#define RESC(a) do { if (__any((a) < 1.f)) { if (hi == 0) al_l[r32] = (a); asm volatile("s_waitcnt lgkmcnt(0)" ::: "memory");              \
                     for (int d_ = 0; d_ < 4; ++d_) for (int r = 0; r < 16; ++r) o[d_][r] *= al_l[crow(r, hi)]; } } while (0)
#define KBASE(t) ((t) * KVBLK)
#define MASKT(P0_, P1_, t) do { const int kb_ = KBASE(t); if (kb_ + KVBLK - 1 > qlo) mask_tile(P0_, P1_, qm - kb_); } while (0)
#define MLOAD(t) (*(const u32x2*)(mkb + (size_t)(t) * 8 + mo))
    f32x16 pA0, pA1, pB0, pB1; float mnA, mnB, alA, alB; bf16x8 pa0, pa1, pa2, pa3; u32x2 mA, mB;
    SWRITE_HV(0); SBAR();
    SLOAD_H(Kh, Vh, KBASE(1));
    mA = MLOAD(0);
    SBAR(); qkt<0>(pA0, pA1, K_lds, r32, hi, S.qr);
    MASKT(pA0, pA1, 0); partialSM(pA0, pA1, m_reg, mnA, alA, mA.x >> sh4);
    VMW(); SWRITE_H(1);
    __syncthreads();
#define HALF_STEP(PX0, PX1, mnX, alX, mX, PY0, PY1, alY, mY, t, KB, VB, SB) do {                                              \
        SBAR(); mX = MLOAD(t); qkt<KB>(PX0, PX1, K_lds, r32, hi, S.qr);                                                      \
        finishSM(PY0, PY1, alY, l_reg, pa0, pa1, pa2, pa3, mY.y >> sh4); SBAR();                                              \
        if ((t) + 1 < NT) { SLOAD_H(Kh, Vh, KBASE((t) + 1)); SBAR(); }                                                        \
        pv_tile<VB>(o, vb0, pa0, pa1, pa2, pa3); MASKT(PX0, PX1, (t)); partialSM(PX0, PX1, m_reg, mnX, alX, mX.x >> sh4);    \
        __syncthreads();                                                                                                      \
        if ((t) + 1 < NT) { VMW(); SWRITE_H(SB); }                                                                            \
        RESC(alX); __syncthreads(); } while (0)
    for (int t = 1; t + 1 < NT; t += 2) {
        HALF_STEP(pB0, pB1, mnB, alB, mB, pA0, pA1, alA, mA, t, 1, 0, 0);
        HALF_STEP(pA0, pA1, mnA, alA, mA, pB0, pB1, alB, mB, t + 1, 0, 1, 1);
    }
    SBAR(); mB = MLOAD(NT - 1); qkt<1>(pB0, pB1, K_lds, r32, hi, S.qr); SBAR();
    { const char* nK = B.P + nxt.k; const char* nV = B.P + nxt.v; SLOAD_H(nK, nV, 0); } SBAR();
    { const char* nQ = B.P + nxt.q;
#pragma unroll
    for (int d0 = 0; d0 < 8; ++d0) S.qr[d0] = *(const bf16x8*)(nQ + qo + d0 * 32); }
    SBAR();
    finishSM(pA0, pA1, alA, l_reg, pa0, pa1, pa2, pa3, mA.y >> sh4); SBAR();
    pv_tile<0>(o, vb0, pa0, pa1, pa2, pa3);
    MASKT(pB0, pB1, NT - 1); partialSM(pB0, pB1, m_reg, mnB, alB, mB.x >> sh4); __syncthreads(); RESC(alB);
    finishSM(pB0, pB1, alB, l_reg, pa0, pa1, pa2, pa3, mB.y >> sh4); SBAR(); pv_tile<1>(o, vb0, pa0, pa1, pa2, pa3);
    SBAR(); VMWN(8); SWRITE_HK(0); SBAR();
    if (hi == 0) li_l[r32] = l_reg; asm volatile("s_waitcnt lgkmcnt(0)" ::: "memory");
    float rli[16];
#pragma unroll
    for (int r = 0; r < 16; ++r) rli[r] = __builtin_amdgcn_rcpf(li_l[crow(r, hi)]);
    char* Ob = B.MG + cur.o; const unsigned oo = (unsigned)((wid * QBLK) * PO + r32) * 2u;
#pragma unroll
    for (int r = 0; r < 16; ++r) { const int orow = crow(r, hi);
#pragma unroll
        for (int d0 = 0; d0 < 4; ++d0) { const float v = o[d0][r] * rli[r];
            const float vn = __shfl_xor(v, 1);
            if ((r32 & 1) == 0) *(unsigned*)(Ob + oo + (unsigned)(orow * PO + d0 * 32) * 2u) = cvtpk(v, vn); } }
    __syncthreads();
#undef RESC
#undef KBASE
#undef MASKT
#undef MLOAD
#undef HALF_STEP
}
#undef VMW
#undef VMWN
#undef SLOAD_H
#undef SWRITE_HK
#undef SWRITE_HV
#undef SWRITE_H
#undef SBAR
#undef KSWZ
}

struct Frame {
    LAS unsigned char* lds;
    gu32* ctl;
    int tid, lane, wave, vcu, G;
    float* MODV; bf16* GATE; float* CARRY; float* WI; bf16* KI; unsigned* MASK; bf16 *WIN, *WOUT, *WUP, *WDN, *HA, *P, *MG, *HID;
};

__device__ __forceinline__ void transpose_item(const float* W, int K, int N, bf16* WT, LAS float* scr, int item, int nblk, int lane) {
    const int kb = item / nblk, nb = item % nblk, k0 = 64 * kb, n0 = 32 * nb;
    const int nn = n0 + (lane & 31);
#pragma unroll 8
    for (int i = 0; i < 32; ++i) { const int kk = 2 * i + (lane >> 5); scr[kk * 33 + (lane & 31)] = (nn < N) ? W[(size_t)(k0 + kk) * N + nn] : 0.f; }
    LDS_WAIT(); asm volatile("" ::: "memory");
    const int c = lane & 7;
#pragma unroll
    for (int j = 0; j < 4; ++j) { const int n = (lane >> 3) + 8 * j; const LAS float* s = scr + (8 * c) * 33 + n;
        v4u o; o.x = pk2(s[0 * 33], s[1 * 33]); o.y = pk2(s[2 * 33], s[3 * 33]); o.z = pk2(s[4 * 33], s[5 * 33]); o.w = pk2(s[6 * 33], s[7 * 33]);
        *(GAS v4u*)(WT + (size_t)(n0 + n) * K + k0 + 8 * c) = o; }
    LDS_WAIT(); asm volatile("" ::: "memory");
}
__device__ __forceinline__ void p0_prologue(Frame& F, const Args& a) {
    LAS float* scr = (LAS float*)(F.lds + F.wave * 16384);
    const int gw = F.vcu * NWAVES + F.wave, NGW = F.G * NWAVES;
    constexpr int I_IN = (DMODEL / 64) * (INP / 32), I_OUT = (DMODEL / 64) * (DMODEL / 32), I_UP = (DMODEL / 64) * (FF / 32), I_DN = (FF / 64) * (DMODEL / 32);
    constexpr int PER_L = I_IN + I_OUT + I_UP + I_DN;
    for (int it = gw; it < DEPTH * PER_L; it += NGW) {
        const int l = it / PER_L; int r = it % PER_L;
        if (r < I_IN) { transpose_item(a.w_in + (size_t)l * DMODEL * INC, DMODEL, INC, F.WIN + (size_t)l * INP * DMODEL, scr, r, INP / 32, F.lane); continue; } r -= I_IN;
        if (r < I_OUT) { transpose_item(a.w_out + (size_t)l * DMODEL * DMODEL, DMODEL, DMODEL, F.WOUT + (size_t)l * DMODEL * DMODEL, scr, r, DMODEL / 32, F.lane); continue; } r -= I_OUT;
        if (r < I_UP) { transpose_item(a.w_up + (size_t)l * DMODEL * FF, DMODEL, FF, F.WUP + (size_t)l * FF * DMODEL, scr, r, FF / 32, F.lane); continue; } r -= I_UP;
        transpose_item(a.w_down + (size_t)l * FF * DMODEL, FF, DMODEL, F.WDN + (size_t)l * DMODEL * FF, scr, r, DMODEL / 32, F.lane);
    }
    for (int i = F.vcu * NTHR + F.tid; i < DEPTH * 2 * LBLK * 64 * 64; i += F.G * NTHR) {
        const int c = i & 63, d = (i >> 6) & 63, n = (i >> 12) & 7, g = (i >> 15) & 1, l = i >> 16;
        const float* src = g ? a.wgx : a.wga;
        F.GATE[i] = (bf16)f2bf(src[(((size_t)l * LBLK + n) * 64 + c) * 64 + d]);
    }
    __syncthreads();
    LAS float* sc = (LAS float*)F.lds;
    LAS float* red = (LAS float*)(F.lds + 32768);
    for (int i = F.tid; i < BATCH * DMODEL; i += NTHR) { const int b = i >> 10, k = i & 1023; const float v = a.c[i]; sc[k * 8 + b] = v * sigmoidf_fast(v); }
    __syncthreads();
    for (int u = F.vcu; u < DEPTH * (MODW / 64); u += F.G) {
        const int l = u / (MODW / 64), j = (u % (MODW / 64)) * 64 + F.lane;
        float acc[8];
#pragma unroll
        for (int b = 0; b < 8; ++b) acc[b] = 0.f;
        const float* wp = a.w_mod + (size_t)l * DMODEL * MODW + j;
#pragma unroll 4
        for (int kk = 0; kk < 128; ++kk) { const int k = F.wave * 128 + kk; const float wv = wp[(size_t)k * MODW];
            const f32x4 s0 = *(const LAS f32x4*)(sc + k * 8), s1 = *(const LAS f32x4*)(sc + k * 8 + 4);
            acc[0] += s0[0] * wv; acc[1] += s0[1] * wv; acc[2] += s0[2] * wv; acc[3] += s0[3] * wv;
            acc[4] += s1[0] * wv; acc[5] += s1[1] * wv; acc[6] += s1[2] * wv; acc[7] += s1[3] * wv; }
#pragma unroll
        for (int b = 0; b < 8; ++b) red[(F.wave * 8 + b) * 64 + F.lane] = acc[b];
        __syncthreads();
        float s = a.b_mod[(size_t)l * MODW + j];
#pragma unroll
        for (int w2 = 0; w2 < 8; ++w2) s += red[(w2 * 8 + F.wave) * 64 + F.lane];
        F.MODV[((size_t)l * BATCH + F.wave) * MODW + j] = s;
        __syncthreads();
    }
}

__device__ __forceinline__ void modulate_rows(Frame& F, const float* x, const float* modl, int shoff, int scoff) {
    const int gw = F.vcu * NWAVES + F.wave, NGW = F.G * NWAVES;
    for (int m = gw; m < MTOK; m += NGW) {
        const float* mb = modl + (size_t)(m / SEQ) * MODW;
#pragma unroll
        for (int j = 0; j < 4; ++j) { const int col = 4 * F.lane + 256 * j;
            const f32x4 v = *(const GAS f32x4*)(x + (size_t)m * DMODEL + col), s = *(const GAS f32x4*)(mb + scoff + col), h = *(const GAS f32x4*)(mb + shoff + col);
            const f32x4 y = v * (s + 1.0f) + h;
            u32x2 w; w.x = cvtpk(y[0], y[1]); w.y = cvtpk(y[2], y[3]);
            *(GAS u32x2*)(F.HA + (size_t)m * DMODEL + col) = w; }
    }
}
__device__ __forceinline__ void ln_rows(Frame& F, float* x, const float* g, const float* bt, const float* modl, int shoff, int scoff) {
    const int gw = F.vcu * NWAVES + F.wave, NGW = F.G * NWAVES;
    for (int m = gw; m < MTOK; m += NGW) {
        f32x4 v[4]; float s = 0.f;
#pragma unroll
        for (int j = 0; j < 4; ++j) { v[j] = *(const GAS f32x4*)(x + (size_t)m * DMODEL + 4 * F.lane + 256 * j); s += (v[j][0] + v[j][1]) + (v[j][2] + v[j][3]); }
        const float mean = wave_sum(s) * (1.f / DMODEL); float s2 = 0.f;
#pragma unroll
        for (int j = 0; j < 4; ++j) { v[j] = v[j] - mean; s2 += (v[j][0] * v[j][0] + v[j][1] * v[j][1]) + (v[j][2] * v[j][2] + v[j][3] * v[j][3]); }
        const float rstd = 1.f / sqrtf(wave_sum(s2) * (1.f / DMODEL) + LN_EPS);
        const float* mb = modl ? modl + (size_t)(m / SEQ) * MODW : nullptr;
#pragma unroll
        for (int j = 0; j < 4; ++j) { const int col = 4 * F.lane + 256 * j;
            const f32x4 gg = *(const GAS f32x4*)(g + col), bb = *(const GAS f32x4*)(bt + col);
            const f32x4 y = v[j] * rstd * gg + bb;
            *(GAS f32x4*)(x + (size_t)m * DMODEL + col) = y;
            if (modl) { const f32x4 sv = *(const GAS f32x4*)(mb + scoff + col), hv = *(const GAS f32x4*)(mb + shoff + col);
                const f32x4 h = y * (sv + 1.0f) + hv; u32x2 w; w.x = cvtpk(h[0], h[1]); w.y = cvtpk(h[2], h[3]);
                *(GAS u32x2*)(F.HA + (size_t)m * DMODEL + col) = w; } }
    }
}
__device__ __forceinline__ void rms_rows(Frame& F, const float* ga, const float* gl) {
    const int gw = F.vcu * NWAVES + F.wave, NGW = F.G * NWAVES;
    for (int m = gw; m < MTOK; m += NGW) {
#pragma unroll
        for (int hf = 0; hf < 2; ++hf) {
            bf16* p = F.MG + (size_t)m * DMODEL + hf * 512 + 8 * F.lane;
            const v4u raw = *(const GAS v4u*)p; float f[8];
#pragma unroll
            for (int i = 0; i < 4; ++i) { f[2 * i] = __builtin_bit_cast(float, raw[i] << 16); f[2 * i + 1] = __builtin_bit_cast(float, raw[i] & 0xffff0000u); }
            float ss = 0.f;
#pragma unroll
            for (int i = 0; i < 8; ++i) ss += f[i] * f[i];
            const float r = 1.f / sqrtf(wave_sum(ss) * (1.f / 512.f) + LN_EPS);
            const float* gp = (hf ? gl : ga) + 8 * F.lane;
            const f32x4 g0 = *(const GAS f32x4*)gp, g1 = *(const GAS f32x4*)(gp + 4);
            v4u o; o.x = cvtpk(f[0] * r * g0[0], f[1] * r * g0[1]); o.y = cvtpk(f[2] * r * g0[2], f[3] * r * g0[3]);
            o.z = cvtpk(f[4] * r * g1[0], f[5] * r * g1[1]); o.w = cvtpk(f[6] * r * g1[2], f[7] * r * g1[3]);
#ifdef ZERO_HALF
            if (hf == ZERO_HALF) { o.x = 0u; o.y = 0u; o.z = 0u; o.w = 0u; }
#endif
            *(GAS v4u*)p = o;
        }
    }
}
__device__ __forceinline__ void sincos_rev(float ang, float& s, float& c) {
    double rev = (double)ang * 0.15915494309189535; rev -= __builtin_rint(rev);
    const float fr = (float)rev; s = __builtin_amdgcn_sinf(fr); c = __builtin_amdgcn_cosf(fr);
}
__device__ __forceinline__ void rope_rows(Frame& F, const int* pos) {
    const int gw = F.vcu * NWAVES + F.wave, NGW = F.G * NWAVES, lane = F.lane;
    const float inva = ROPE_INV[lane], invi = ROPE_INV[2 * (lane & 31)];
    for (int m = gw; m < MTOK; m += NGW) {
        const float fpos = (float)pos[m];
        float sa, ca, si, ci; sincos_rev(fpos * inva, sa, ca); sincos_rev(fpos * invi, si, ci);
        bf16* prow = F.P + (size_t)m * INP;
#pragma unroll
        for (int hh = 0; hh < 8; ++hh) {
            bf16* p = prow + hh * 128 + lane;
            const float x1 = bf2f(p[0]), x2 = bf2f(p[64]);
            p[0] = (bf16)f2bf(x1 * ca - x2 * sa); p[64] = (bf16)f2bf(x2 * ca + x1 * sa);
        }
        const int i = lane & 31, h2 = lane >> 5;
#pragma unroll
        for (int j = 0; j < 4; ++j) {
            bf16* p = prow + CQI + (2 * j + h2) * 64 + i;
            const float x1 = bf2f(p[0]), x2 = bf2f(p[32]);
            p[0] = (bf16)f2bf(x1 * ci - x2 * si); p[32] = (bf16)f2bf(x2 * ci + x1 * si);
        }
        if (lane < 32) {
            const float x1 = bf2f(prow[CKI + i]), x2 = bf2f(prow[CKI + 32 + i]);
            F.KI[(size_t)m * 64 + i] = (bf16)f2bf(x1 * ci - x2 * si); F.KI[(size_t)m * 64 + 32 + i] = (bf16)f2bf(x2 * ci + x1 * si);
        }
        if (lane < 8) F.WI[(size_t)m * 8 + lane] = bf2f(prow[CWI + lane]) * 0.35355339059327373f;
    }
}

__device__ __forceinline__ void idx_phase(Frame& F, int l) {
    const int lane = F.lane, wid = F.wave, r32 = lane & 31, hi = lane >> 5;
    LAS float* SC = (LAS float*)F.lds;
    const float NEG = -__builtin_inff();
    for (int L = F.vcu; L < BATCH * (SEQ / 8); L += F.G) {
        const int b = L >> 9, xx = L & 511, tb = xx < 256 ? xx : 767 - xx;
        const int t0 = tb * 8; const size_t row0 = (size_t)b * SEQ + t0;
        bf16x8 af[2][4];
        {
            const int tq = 2 * ((r32 >> 2) & 1) + (r32 >> 4), hh = ((r32 >> 3) & 1) * 4 + (r32 & 3);
#pragma unroll
            for (int m = 0; m < 2; ++m) { const bf16* q = F.P + (row0 + 4 * m + tq) * INP + CQI + hh * 64 + 8 * hi;
#pragma unroll
                for (int ks = 0; ks < 4; ++ks) af[m][ks] = *(const GAS bf16x8*)(q + 16 * ks); }
        }
        LAS float* WGL = SC + 4096;
        if (F.tid < 64) WGL[F.tid] = F.WI[row0 * 8 + F.tid];
        __syncthreads();
        const int nch = ((t0 + 7) >> 8) + 1;
        float keys[64];
#pragma unroll
        for (int j = 0; j < 64; ++j) keys[j] = NEG;
#pragma unroll
        for (int ch = 0; ch < 16; ++ch) {
            if (ch < nch) {
                const int s0 = 256 * ch + 32 * wid;
                LAS float* scb = SC + (ch & 1) * 2048;
                float sc4[2][2];
                if (s0 <= t0 + 7) {
                    const bf16* kp = F.KI + ((size_t)b * SEQ + s0 + r32) * 64 + 8 * hi;
                    bf16x8 kb[4];
#pragma unroll
                    for (int ks = 0; ks < 4; ++ks) kb[ks] = *(const GAS bf16x8*)(kp + 16 * ks);
#pragma unroll
                    for (int m = 0; m < 2; ++m) { f32x16 acc = f32x16{};
#pragma unroll
                        for (int ks = 0; ks < 4; ++ks) acc = __builtin_amdgcn_mfma_f32_32x32x16_bf16(af[m][ks], kb[ks], acc, 0, 0, 0);
#pragma unroll
                        for (int ts = 0; ts < 2; ++ts) { float s = 0.f;
                            const f32x4 wa = *(const LAS f32x4*)(WGL + (4 * m + 2 * hi + ts) * 8), wb = *(const LAS f32x4*)(WGL + (4 * m + 2 * hi + ts) * 8 + 4);
#pragma unroll
                            for (int j = 0; j < 4; ++j) { s += wa[j] * fmaxf(acc[ts * 8 + j], 0.f); s += wb[j] * fmaxf(acc[ts * 8 + 4 + j], 0.f); }
                            const int t = t0 + 4 * m + 2 * hi + ts;
                            sc4[m][ts] = (s0 + r32 <= t) ? s : NEG; } }
                } else { sc4[0][0] = NEG; sc4[0][1] = NEG; sc4[1][0] = NEG; sc4[1][1] = NEG; }
#pragma unroll
                for (int m = 0; m < 2; ++m)
#pragma unroll
                    for (int ts = 0; ts < 2; ++ts) scb[(4 * m + 2 * hi + ts) * 256 + 32 * wid + r32] = sc4[m][ts];
                __syncthreads();
#pragma unroll
                for (int i = 0; i < 4; ++i) keys[4 * ch + i] = scb[wid * 256 + 64 * i + lane];
            }
        }
        const int t = t0 + wid, nj = (t >> 6) + 1;
        float theta = NEG;
        if (t >= TOPK) {
            float mx = NEG, mn = __builtin_inff();
#pragma unroll
            for (int g8 = 0; g8 < 8; ++g8) if (8 * g8 < nj) {
#pragma unroll
                for (int j = 8 * g8; j < 8 * g8 + 8; ++j) { mx = fmaxf(mx, keys[j]); mn = fminf(mn, keys[j] == NEG ? __builtin_inff() : keys[j]); } }
            mx = wave_max(mx); mn = wave_min(mn);
#define IDX_COUNT(th, out) do { int c_ = 0; _Pragma("unroll") for (int g8 = 0; g8 < 8; ++g8) { if (8 * g8 < nj) { _Pragma("unroll") for (int j = 8 * g8; j < 8 * g8 + 8; ++j) c_ += __builtin_popcountll(__builtin_amdgcn_ballot_w64(keys[j] > (th))); } __builtin_amdgcn_sched_barrier(0); } out = c_; } while (0)
            float lo = mn, hiv = mx; int clo, chi = 0;
            IDX_COUNT(lo, clo);
            if (clo <= TOPK) { theta = (clo == TOPK) ? lo : NEG; }
            else {
                theta = lo;
                for (int it = 0; it < 96; ++it) {
                    float mid;
                    if ((it & 1) == 0) { mid = lo + (hiv - lo) * ((float)(clo - TOPK) / (float)(clo - chi)); if (!(mid > lo && mid < hiv)) mid = 0.5f * (lo + hiv); }
                    else mid = 0.5f * (lo + hiv);
                    if (!(mid > lo && mid < hiv)) break;
                    int cm; IDX_COUNT(mid, cm);
                    if (cm == TOPK) { theta = mid; break; }
                    if (cm > TOPK) { lo = mid; clo = cm; theta = mid; } else { hiv = mid; chi = cm; }
                }
            }
#undef IDX_COUNT
        }
        unsigned w0 = 0u, w1 = 0u;
#pragma unroll
        for (int g8 = 0; g8 < 8; ++g8) { if (8 * g8 < nj) {
#pragma unroll
            for (int j = 8 * g8; j < 8 * g8 + 8; ++j) { const unsigned long long bm = __builtin_amdgcn_ballot_w64(keys[j] > theta);
                asm volatile("s_nop 1\n\tv_writelane_b32 %0, %2, %4\n\tv_writelane_b32 %1, %3, %4" : "+v"(w0), "+v"(w1) : "s"((unsigned)bm), "s"((unsigned)(bm >> 32)), "i"(j)); } }
            __builtin_amdgcn_sched_barrier(0); }
        u32x2 wv; wv.x = w0; wv.y = w1;
        *(GAS u32x2*)(F.MASK + ((size_t)b * SEQ + t) * (SEQ / 32) + 2 * lane) = wv;
        __syncthreads();
    }
}

template <bool PASSB>
__device__ __forceinline__ void lru_phase(Frame& F, const Args& a, int l) {
    const int lane = F.lane, wid = F.wave, r32 = lane & 31, hi = lane >> 5, c = wid * 64 + lane;
    LAS unsigned char* xt = F.lds + 36864 + wid * 4608;
    const bf16* GT = F.GATE + (size_t)l * 2 * LBLK * 64 * 64;
    for (int u = F.vcu; u < BATCH * NLCH; u += F.G) {
        const int b = u / NLCH, chunk = u % NLCH;
        const float cw0 = a.conv_w[((size_t)l * 4 + 0) * LW + c], cw1 = a.conv_w[((size_t)l * 4 + 1) * LW + c], cw2 = a.conv_w[((size_t)l * 4 + 2) * LW + c], cw3 = a.conv_w[((size_t)l * 4 + 3) * LW + c];
        const float cb = a.conv_b[(size_t)l * LW + c], ba = a.bga[(size_t)l * LW + c], bx = a.bgx[(size_t)l * LW + c];
        float sp8;
        { const float xl = -a.lam[(size_t)l * LW + c], ax = fabsf(xl), e = __builtin_amdgcn_exp2f(-ax * LOG2E);
          const float l1p = (e < 0.01f) ? e * (1.f - e * (0.5f - e * (0.33333333f - 0.25f * e))) : __builtin_amdgcn_logf(1.f + e) * 0.6931471805599453f;
          sp8 = 8.0f * (fmaxf(xl, 0.f) + l1p) * LOG2E; }
        const int tbase = chunk * LCH; const size_t rowb = (size_t)b * SEQ;
        float h = 0.f, pp = 1.f;
        if (PASSB) { for (int k = 0; k < chunk; ++k) { const float* cp = F.CARRY + (((size_t)b * NLCH + k) * LW + c) * 2; const float pk = cp[0], hk = cp[1]; h = pk * h + hk; } }
        float xm3 = 0.f, xm2 = 0.f, xm1 = 0.f;
        if (tbase > 0) { xm3 = bf2f(F.P[(rowb + tbase - 3) * INP + CXR + c]); xm2 = bf2f(F.P[(rowb + tbase - 2) * INP + CXR + c]); xm1 = bf2f(F.P[(rowb + tbase - 1) * INP + CXR + c]); }
        for (int tt = 0; tt < LCH / 32; ++tt) {
            const int t0 = tbase + 32 * tt;
            float xc[32];
            {
                float xv[32];
#pragma unroll
                for (int i = 0; i < 32; ++i) xv[i] = bf2f(F.P[(rowb + t0 + i) * INP + CXR + c]);
#pragma unroll
                for (int i = 0; i < 32; ++i) { const float a3 = (i >= 3) ? xv[i - 3] : (i == 0 ? xm3 : (i == 1 ? xm2 : xm1));
                    const float a2 = (i >= 2) ? xv[i - 2] : (i == 0 ? xm2 : xm1); const float a1 = (i >= 1) ? xv[i - 1] : xm1;
                    xc[i] = cb + cw0 * a3 + cw1 * a2 + cw2 * a1 + cw3 * xv[i]; }
                xm3 = xv[29]; xm2 = xv[30]; xm1 = xv[31];
            }
#pragma unroll
            for (int i = 0; i < 32; ++i) *(LAS unsigned short*)(xt + i * 144 + lane * 2) = (unsigned short)f2bf(xc[i]);
            LDS_WAIT();
            bf16x8 xa[4];
#pragma unroll
            for (int ks = 0; ks < 4; ++ks) xa[ks] = *(const LAS bf16x8*)(xt + r32 * 144 + (16 * ks + 8 * hi) * 2);
            LDS_WAIT();
            f32x16 C[2][2];
#pragma unroll
            for (int g = 0; g < 2; ++g) {
                bf16x8 gf[2][4];
#pragma unroll
                for (int dt = 0; dt < 2; ++dt)
#pragma unroll
                    for (int ks = 0; ks < 4; ++ks) gf[dt][ks] = *(const GAS bf16x8*)(GT + (((size_t)g * LBLK + wid) * 64 + 32 * dt + r32) * 64 + 16 * ks + 8 * hi);
#pragma unroll
                for (int dt = 0; dt < 2; ++dt) { C[g][dt] = f32x16{};
#pragma unroll
                    for (int ks = 0; ks < 4; ++ks) C[g][dt] = __builtin_amdgcn_mfma_f32_32x32x16_bf16(xa[ks], gf[dt][ks], C[g][dt], 0, 0, 0); }
                asm volatile("" ::: "memory");
            }
#pragma unroll
            for (int g = 0; g < 2; ++g)
#pragma unroll
                for (int i = 0; i < 16; ++i) { auto rr = __builtin_amdgcn_permlane32_swap(__float_as_uint(C[g][0][i]), __float_as_uint(C[g][1][i]), false, false);
                    C[g][0][i] = __uint_as_float(rr[0]); C[g][1][i] = __uint_as_float(rr[1]); }
#pragma unroll
            for (int q8 = 0; q8 < 4; ++q8) {
                float yv[8];
                if (PASSB) {
#pragma unroll
                    for (int e = 0; e < 8; ++e) yv[e] = bf2f(F.P[(rowb + t0 + 8 * q8 + e) * INP + CYG + c]);
                }
#pragma unroll
                for (int e = 0; e < 8; ++e) {
                    const int t = 8 * q8 + e, grp = e >> 2, i = 4 * q8 + (e & 3);
                    const float ra = sigmoidf_fast(C[0][grp][i] + ba), ix = sigmoidf_fast(C[1][grp][i] + bx);
                    const float av = __builtin_amdgcn_exp2f(-ra * sp8);
                    const float uu = __builtin_amdgcn_sqrtf(fmaxf(1.f - av * av, 0.f)) * ix * xc[t];
                    h = av * h + uu; pp *= av;
                    if (PASSB) { const float y = yv[e], z = 0.7978845608028654f * (y + 0.044715f * y * y * y);
                        const float o = h * y * sigmoidf_fast(2.f * z);
                        F.MG[(rowb + t0 + t) * DMODEL + AW + c] = (bf16)f2bf(o); }
                }
            }
        }
        if (!PASSB) { float* cp = F.CARRY + (((size_t)b * NLCH + chunk) * LW + c) * 2; cp[0] = pp; cp[1] = h; }
    }
}

__device__ __forceinline__ att::BlockRef att_ref(int bh, int qb) {
    const int b = bh / NHEAD, h = bh % NHEAD; att::BlockRef r;
    const unsigned row = (unsigned)(b * SEQ + qb * att::QB), row0 = (unsigned)(b * SEQ);
#define UNI_(v) ((unsigned)__builtin_amdgcn_readfirstlane((int)(v)))
    r.q = UNI_((row * INP + CQ + h * HD) * 2u); r.k = UNI_((row0 * INP + CK + h * HD) * 2u); r.v = UNI_((row0 * INP + CV + h * HD) * 2u);
    r.o = UNI_((row * DMODEL + h * HD) * 2u); r.mk = UNI_(row * (SEQ / 32) * 4u); r.P0 = __builtin_amdgcn_readfirstlane(qb * att::QB);
#undef UNI_
    return r;
}
__device__ __forceinline__ void attn_phase(Frame& F, char* lds) {
    constexpr int NQB = SEQ / att::QB, NX = NQB / 2, TOTAL = BATCH * NHEAD * NX;
    int L = F.vcu; if (L >= TOTAL) return;
    int bh = L / NX, x = L % NX, pass = 0;
    att::Bases B; B.P = (const char*)att::uni(F.P); B.MG = (char*)att::uni(F.MG); B.MK = (const char*)att::uni(F.MASK);
    att::BlockRef cur = att_ref(bh, x);
    att::Seam S;
    att::prime(B, cur, lds, S);
    for (;;) {
        const bool more_pass = pass == 0, more_item = L + F.G < TOTAL, last = !more_pass && !more_item;
        int bhn = bh, xn = x, passn = pass + 1, Ln = L;
        if (!more_pass) { passn = 0; Ln = more_item ? L + F.G : L; bhn = Ln / NX; xn = Ln % NX; }
        const att::BlockRef nxt = last ? cur : att_ref(bhn, passn ? NQB - 1 - xn : xn);
        att::block(B, cur, nxt, lds, S);
        if (last) break;
        cur = nxt; bh = bhn; x = xn; pass = passn; L = Ln;
    }
}

#ifdef PROBE_STOP
__device__ __forceinline__ void probe_idx(Frame& F, float* slot) {
    const int lane = F.lane, gw = F.vcu * NWAVES + F.wave;
    LAS float* sc = (LAS float*)(F.lds + F.wave * 16384);
    if (gw >= 128) return;
    const int b = gw & 7, t = (gw >> 3) * 257 + 200;
    if (t >= SEQ) return;
    const size_t row = (size_t)b * SEQ + t;
    float wq[8];
#pragma unroll
    for (int h = 0; h < 8; ++h) wq[h] = F.WI[row * 8 + h];
    for (int s0 = 0; s0 <= t; s0 += 64) {
        const int s = s0 + lane; float score = -__builtin_inff();
        if (s <= t) { score = 0.f;
            for (int h = 0; h < 8; ++h) { float d = 0.f;
                for (int k = 0; k < 64; ++k) d += bf2f(F.P[row * INP + CQI + h * 64 + k]) * bf2f(F.KI[((size_t)b * SEQ + s) * 64 + k]);
                score += wq[h] * fmaxf(d, 0.f); } }
        sc[s] = score;
    }
    for (int s = ((t >> 6) + 1) * 64 + lane; s < SEQ; s += 64) sc[s] = -__builtin_inff();
    LDS_WAIT(); asm volatile("" ::: "memory");
    float mism = 0.f;
    for (int s0 = 0; s0 <= t; s0 += 64) {
        const int s = s0 + lane; const float mine = sc[s]; int rank = 0;
        for (int j = 0; j <= t; ++j) { const float o = sc[j]; rank += (o > mine || (o == mine && j < s)) ? 1 : 0; }
        const bool want = (s <= t) && (t < TOPK || rank < TOPK);
        const unsigned w = F.MASK[row * 128 + (s >> 5)]; const bool got = (w >> (s & 31)) & 1u;
        if (want != got) mism += 1.f;
    }
    mism = wave_sum(mism);
    if (lane == 0) { atomicAdd(slot, mism); atomicAdd(slot + 1, (float)(t + 1 < TOPK ? t + 1 : TOPK)); }
}
__device__ __forceinline__ void probe_attn(Frame& F, float* slot) {
    const int lane = F.lane, gw = F.vcu * NWAVES + F.wave;
    LAS float* pw = (LAS float*)(F.lds + F.wave * 16384);
    if (gw >= 256) return;
    const int b = gw & 7, h = (gw >> 3) & 3, t = (gw >> 5) * 509 + 300;
    if (t >= SEQ) return;
    const size_t row = (size_t)b * SEQ + t;
    float mx = -__builtin_inff();
    for (int s0 = 0; s0 <= t; s0 += 64) { const int s = s0 + lane; float sv = -__builtin_inff();
#ifdef ATT_NOMASK
        if (s <= t) { float d = 0.f;
#else
        if (s <= t && ((F.MASK[row * 128 + (s >> 5)] >> (s & 31)) & 1u)) { float d = 0.f;
#endif
            for (int k = 0; k < 128; ++k) d += bf2f(F.P[row * INP + CQ + h * 128 + k]) * bf2f(F.P[((size_t)b * SEQ + s) * INP + CK + h * 128 + k]);
            sv = d * 0.08838834764831845f; }
        pw[s] = sv; mx = fmaxf(mx, sv); }
    mx = wave_max(mx);
    float sum = 0.f;
    for (int s0 = 0; s0 <= t; s0 += 64) { const int s = s0 + lane; const float e = __expf(pw[s] - mx); pw[s] = e; sum += e; }
    sum = wave_sum(sum);
    LDS_WAIT(); asm volatile("" ::: "memory");
    float o0 = 0.f, o1 = 0.f;
    for (int s = 0; s <= t; ++s) { const float p = pw[s]; if (p != 0.f) { o0 += p * bf2f(F.P[((size_t)b * SEQ + s) * INP + CV + h * 128 + lane]); o1 += p * bf2f(F.P[((size_t)b * SEQ + s) * INP + CV + h * 128 + 64 + lane]); } }
    o0 /= sum; o1 /= sum;
    const float g0 = bf2f(F.MG[row * DMODEL + h * 128 + lane]), g1 = bf2f(F.MG[row * DMODEL + h * 128 + 64 + lane]);
    float num = (g0 - o0) * (g0 - o0) + (g1 - o1) * (g1 - o1), den = o0 * o0 + o1 * o1;
    num = wave_sum(num); den = wave_sum(den);
    if (lane == 0) { atomicAdd(slot, num); atomicAdd(slot + 1, den); }
}
__device__ __forceinline__ void probe_lru(Frame& F, const Args& a, int l, float* slot) {
    const int lane = F.lane;
    if (F.wave >= 4 || F.vcu >= 16) return;
    const int u = F.vcu * 4 + F.wave, b = u >> 3, n = u & 7, c = n * 64 + lane;
    LAS float* W = (LAS float*)(F.lds + F.wave * 33024);
    LAS float* xs = W + 8192;
    for (int i = lane; i < 4096; i += 64) { W[i] = a.wga[((size_t)l * LBLK + n) * 4096 + i]; W[4096 + i] = a.wgx[((size_t)l * LBLK + n) * 4096 + i]; }
    LDS_WAIT(); asm volatile("" ::: "memory");
    const float cw0 = a.conv_w[((size_t)l * 4 + 0) * LW + c], cw1 = a.conv_w[((size_t)l * 4 + 1) * LW + c], cw2 = a.conv_w[((size_t)l * 4 + 2) * LW + c], cw3 = a.conv_w[((size_t)l * 4 + 3) * LW + c];
    const float cb = a.conv_b[(size_t)l * LW + c], ba = a.bga[(size_t)l * LW + c], bx = a.bgx[(size_t)l * LW + c], lam = a.lam[(size_t)l * LW + c];
    const float sp = log1pf(expf(-lam));
    float x3 = 0.f, x2 = 0.f, x1 = 0.f, h = 0.f, num = 0.f, den = 0.f;
    for (int t = 0; t < SEQ; ++t) {
        const size_t row = (size_t)b * SEQ + t;
        const float x0 = bf2f(F.P[row * INP + CXR + c]);
        const float xc = cb + cw0 * x3 + cw1 * x2 + cw2 * x1 + cw3 * x0; x3 = x2; x2 = x1; x1 = x0;
        xs[lane] = xc; LDS_WAIT(); asm volatile("" ::: "memory");
        float za = ba, zx = bx;
        for (int k = 0; k < 64; ++k) { const float xv = xs[k]; za += xv * W[k * 64 + lane]; zx += xv * W[4096 + k * 64 + lane]; }
        LDS_WAIT(); asm volatile("" ::: "memory");
        const float r = 1.f / (1.f + expf(-za)), ii = 1.f / (1.f + expf(-zx));
        const float la = -8.0f * r * sp, av = expf(la);
        h = av * h + sqrtf(fmaxf(-expm1f(2.f * la), 0.f)) * (ii * xc);
        const float y = bf2f(F.P[row * INP + CYG + c]);
        const float want = h * 0.5f * y * (1.f + tanhf(0.7978845608028654f * (y + 0.044715f * y * y * y)));
        const float got = bf2f(F.MG[row * DMODEL + AW + c]);
        num += (got - want) * (got - want); den += want * want;
    }
    num = wave_sum(num); den = wave_sum(den);
    if (lane == 0) { atomicAdd(slot, num); atomicAdd(slot + 1, den); }
}
__device__ __forceinline__ void probe_gemm(Frame& F, const bf16* A, const bf16* Bt, const bf16* O, int N, int K, int ldo, int act, float* slot) {
    const int gt = F.vcu * NTHR + F.tid; if (gt >= 65536) return;
    const unsigned hsh = (unsigned)gt * 2654435761u; const int m = (int)(hsh % (unsigned)MTOK), n = (int)((hsh >> 7) % (unsigned)N);
    float d = 0.f; for (int k = 0; k < K; ++k) d += bf2f(A[(size_t)m * K + k]) * bf2f(Bt[(size_t)n * K + k]);
    if (act == 1) { d = fmaxf(d, 0.f); d = d * d; }
    const float got = bf2f(O[(size_t)m * ldo + n]);
    float num = (got - d) * (got - d), den = d * d; num = wave_sum(num); den = wave_sum(den);
    if (F.lane == 0) { atomicAdd(slot, num); atomicAdd(slot + 1, den); }
}
#endif

#ifndef MK_N_LAUNCHES
#define MK_N_LAUNCHES 1
#endif
constexpr int PH_PER_LAYER = 11, N_PHASES = 1 + DEPTH * PH_PER_LAYER;
constexpr bool ONE_LAUNCH = (MK_N_LAUNCHES == 1);

typedef const Args __attribute__((address_space(4)))* KArgs;
template <class T> __device__ __forceinline__ T* glob(T* p) { return (T*)(GAS T*)p; }
__device__ __forceinline__ Args load_args(KArgs k) {
    Args a = *(const Args*)k;
    a.x = glob(a.x); a.c = glob(a.c); a.pos = glob(a.pos); a.w_mod = glob(a.w_mod); a.b_mod = glob(a.b_mod); a.w_in = glob(a.w_in); a.conv_w = glob(a.conv_w); a.conv_b = glob(a.conv_b);
    a.wga = glob(a.wga); a.bga = glob(a.bga); a.wgx = glob(a.wgx); a.bgx = glob(a.bgx); a.lam = glob(a.lam); a.g_attn = glob(a.g_attn); a.g_lru = glob(a.g_lru); a.w_out = glob(a.w_out);
    a.ln1_g = glob(a.ln1_g); a.ln1_b = glob(a.ln1_b); a.w_up = glob(a.w_up); a.w_down = glob(a.w_down); a.ln2_g = glob(a.ln2_g); a.ln2_b = glob(a.ln2_b); a.out = glob(a.out); a.ws = glob(a.ws);
    return a;
}

__global__ void __launch_bounds__(NTHR, 2) fwd_kernel(Args a) {
    extern __shared__ __attribute__((aligned(16))) unsigned char lds[];
    Frame F;
    F.lds = (LAS unsigned char*)lds;
    F.tid = threadIdx.x; F.lane = F.tid & 63; F.wave = __builtin_amdgcn_readfirstlane(F.tid >> 6);
    F.G = gridDim.x; { const int bx = blockIdx.x; F.vcu = (F.G % 8 == 0) ? (bx % 8) * (F.G / 8) + bx / 8 : bx; }
    F.ctl = (gu32*)(a.ws + WS_CTL);
#define REPIN() int t_ = threadIdx.x; KArgs ka_ = (KArgs)__builtin_amdgcn_kernarg_segment_ptr(); asm volatile("" : "+v"(t_), "+s"(ka_)); \
        const Args a = load_args(ka_);   \
        unsigned char* ws_ = a.ws; \
        F.tid = t_; F.lane = t_ & 63; F.wave = __builtin_amdgcn_readfirstlane(t_ >> 6); \
        F.MODV = (float*)(ws_ + WS_MOD); F.GATE = (bf16*)(ws_ + WS_GATE); F.CARRY = (float*)(ws_ + WS_CARRY); F.WI = (float*)(ws_ + WS_WI); F.KI = (bf16*)(ws_ + WS_KI); \
        F.MASK = (unsigned*)(ws_ + WS_MASK); F.WIN = (bf16*)(ws_ + WS_WIN); F.WOUT = (bf16*)(ws_ + WS_WOUT); F.WUP = (bf16*)(ws_ + WS_WUP); F.WDN = (bf16*)(ws_ + WS_WDN); \
        F.HA = (bf16*)(ws_ + WS_HA); F.P = (bf16*)(ws_ + WS_P); F.MG = (bf16*)(ws_ + WS_MG); F.HID = (bf16*)(ws_ + WS_HID)
    F.tid = threadIdx.x; F.lane = F.tid & 63; F.wave = __builtin_amdgcn_readfirstlane(F.tid >> 6);
    volatile LAS unsigned* MISC = (volatile LAS unsigned*)(F.lds + MISC_OFF);
    for (int u = F.tid; u < (LDS_BYTES - LDSCTL_OFF) / 4; u += NTHR) ((LAS unsigned*)(F.lds + LDSCTL_OFF))[u] = 0u;
    __syncthreads();
    XcdBarrier bar; bar.bar = (unsigned*)(F.ctl + CW_BAR); bar.x = 0; bar.st = nullptr;
    if (ONE_LAUNCH) bar = xcd_barrier_post((unsigned*)(F.ctl + CW_BAR), MISC + 8);
    const int lo = a.ph_lo, hi = a.ph_hi;
#define IN(k) (lo <= (k) && (k) < hi)
#define SEAM(k) do { if (ONE_LAUNCH && IN(k) && IN((k) + 1)) xcd_barrier(bar); } while (0)

    #ifndef SKIP_P0
    if (IN(0)) { REPIN(); p0_prologue(F, a); SEAM(0); }
#endif

    for (int l = 0; l < DEPTH; ++l) {
        const int pb = 1 + l * PH_PER_LAYER;
#define modl (F.MODV + (size_t)l * BATCH * MODW)
#ifndef SKIP_ROWS
        if (IN(pb + 0) && l == 0) { REPIN(); modulate_rows(F, a.x, modl, 0 * DMODEL, 1 * DMODEL); SEAM(pb + 0); }
#endif
#if !defined(SKIP_GEMM) && !defined(SKIP_G1)
        if (IN(pb + 1)) {
            REPIN();
            pg8::Gemm g{F.HA, F.WIN + (size_t)l * INP * DMODEL, MTOK, INP, DMODEL}; pg8::StaticOrder S; S.init(MTOK, INP, F.G, (int)blockIdx.x);
            pg8::EpiOutBf16<0> E{F.P, INP};
            pg8::gemm_phase<pg8::EpiOutBf16<0>, pg8::StaticOrder, true, true>(F.lds, g, S, E);
            SEAM(pb + 1);
        }
#endif
#ifndef SKIP_ROWS
        if (IN(pb + 2)) { REPIN(); rope_rows(F, a.pos); SEAM(pb + 2); }
#endif
        if (IN(pb + 3)) {
#ifndef SKIP_IDX
            { REPIN(); idx_phase(F, l); } __syncthreads();
#endif
#ifndef SKIP_LRU
            { REPIN(); lru_phase<false>(F, a, l); }
#endif
            SEAM(pb + 3); }
        if (IN(pb + 4)) {
#ifndef SKIP_ATT
            { REPIN(); attn_phase(F, (char*)lds); } __syncthreads();
#endif
#ifndef SKIP_LRU
            { REPIN(); lru_phase<true>(F, a, l); }
#endif
            SEAM(pb + 4); }
#ifndef SKIP_ROWS
        if (IN(pb + 5)) { REPIN(); rms_rows(F, a.g_attn + (size_t)l * AW, a.g_lru + (size_t)l * LW); SEAM(pb + 5); }
#endif
#if !defined(SKIP_GEMM) && !defined(SKIP_G6)
        if (IN(pb + 6)) {
            REPIN();
            pg8::Gemm g{F.MG, F.WOUT + (size_t)l * DMODEL * DMODEL, MTOK, DMODEL, DMODEL}; pg8::StaticOrder S; S.init(MTOK, DMODEL, F.G, (int)blockIdx.x);
            const float* xsrc = (l == 0) ? a.x : a.out;
            pg8::EpiResid E{xsrc, a.out, DMODEL, modl + 2 * DMODEL, MODW, SEQ, ALPHA};
            pg8::gemm_phase<pg8::EpiResid, pg8::StaticOrder, true, true>(F.lds, g, S, E);
            SEAM(pb + 6);
        }
#endif
#ifndef SKIP_ROWS
        if (IN(pb + 7)) { REPIN(); ln_rows(F, a.out, a.ln1_g + (size_t)l * DMODEL, a.ln1_b + (size_t)l * DMODEL, modl, 3 * DMODEL, 4 * DMODEL); SEAM(pb + 7); }
#endif
#if !defined(SKIP_GEMM) && !defined(SKIP_G8)
        if (IN(pb + 8)) {
            REPIN();
            pg8::Gemm g{F.HA, F.WUP + (size_t)l * FF * DMODEL, MTOK, FF, DMODEL}; pg8::StaticOrder S; S.init(MTOK, FF, F.G, (int)blockIdx.x);
            pg8::EpiOutBf16<1> E{F.HID, FF};
            pg8::gemm_phase<pg8::EpiOutBf16<1>, pg8::StaticOrder, true, true>(F.lds, g, S, E);
            SEAM(pb + 8);
        }
#endif
#if !defined(SKIP_GEMM) && !defined(SKIP_G9)
        if (IN(pb + 9)) {
            REPIN();
            pg8::Gemm g{F.HID, F.WDN + (size_t)l * DMODEL * FF, MTOK, DMODEL, FF}; pg8::StaticOrder S; S.init(MTOK, DMODEL, F.G, (int)blockIdx.x);
            pg8::EpiResid E{a.out, a.out, DMODEL, modl + 5 * DMODEL, MODW, SEQ, ALPHA};
            pg8::gemm_phase<pg8::EpiResid, pg8::StaticOrder, true, true>(F.lds, g, S, E);
            SEAM(pb + 9);
        }
#endif
#ifndef SKIP_ROWS
        if (IN(pb + 10)) {
            REPIN();
            const float* modn = (l + 1 < DEPTH) ? F.MODV + (size_t)(l + 1) * BATCH * MODW : nullptr;
            ln_rows(F, a.out, a.ln2_g + (size_t)l * DMODEL, a.ln2_b + (size_t)l * DMODEL, modn, 0 * DMODEL, 1 * DMODEL);
            SEAM(pb + 10);
        }
#endif
    }
#ifdef PROBE_STOP
    if (IN(N_PHASES)) {
        REPIN();
        const size_t gt = (size_t)F.vcu * NTHR + F.tid, gs = (size_t)F.G * NTHR;
        const size_t NA = (size_t)MTOK * 128, NB = (size_t)BATCH * NLCH * LW * 2, NT_ = (size_t)MTOK * DMODEL;
        for (size_t i = gt; i < NT_; i += gs) {
            float v;
            if (PROBE_KIND == 0) {
                if (i < 2 * NA) { const unsigned w = F.MASK[i >> 1]; v = (float)((i & 1) ? (w >> 16) : (w & 0xffffu)); }
                else if (i < 2 * NA + NB) v = F.CARRY[i - 2 * NA];
                else v = bf2f(F.P[i - 2 * NA - NB]);
            } else if (PROBE_KIND == 1) { v = bf2f(F.MG[i]); }
            else if (PROBE_KIND == 2) { v = bf2f(F.HA[i]); }
            else { v = bf2f(F.P[i]); }
            a.out[i] = v;
        }
    }
    if (IN(N_PHASES + 1)) {
        REPIN();
        float* slot = (float*)(a.ws + WS_CTL) + 8;
        const int gw = F.vcu * NWAVES + F.wave, NGW = F.G * NWAVES;
        if (PROBE_KIND == 10) {
            float bad = 0.f;
            for (int m = gw; m < MTOK; m += NGW) { const int t = m % SEQ;
                const unsigned w0 = F.MASK[(size_t)m * 128 + 2 * F.lane], w1 = F.MASK[(size_t)m * 128 + 2 * F.lane + 1];
                int pc = __builtin_popcount(w0) + __builtin_popcount(w1); int beyond = 0;
#pragma unroll
                for (int bb = 0; bb < 64; ++bb) { const int s = 64 * F.lane + bb; const unsigned bit = bb < 32 ? (w0 >> bb) & 1u : (w1 >> (bb - 32)) & 1u; if (bit && s > t) beyond = 1; }
#pragma unroll
                for (int o = 1; o < 64; o <<= 1) { pc += __shfl_xor(pc, o); beyond |= __shfl_xor(beyond, o); }
                const int want = t + 1 < TOPK ? t + 1 : TOPK;
                if (pc != want || beyond) bad += 1.f; }
            if (F.lane == 0 && bad > 0.f) atomicAdd(slot, bad * (1.0f / MTOK));
        }
        if (PROBE_KIND == 11) probe_idx(F, slot);
        if (PROBE_KIND == 12) probe_attn(F, slot);
        if (PROBE_KIND == 13) probe_lru(F, a, 0, slot);
        if (PROBE_KIND == 14) probe_gemm(F, F.HA, F.WIN, F.P, INP, DMODEL, INP, 0, slot);
        if (PROBE_KIND == 15) probe_gemm(F, F.HA, F.WUP, F.HID, FF, DMODEL, FF, 1, slot);
    }
    if (IN(N_PHASES + 2)) {
        REPIN();
        const float* sl_ = (const float*)(a.ws + WS_CTL) + 8;
        const float e = (PROBE_KIND == 10) ? sl_[0] : sl_[0] / fmaxf(sl_[1], 1e-30f);
        const float cst = sqrtf(fmaxf(e, 0.f) * 1e6f);
        for (size_t i = (size_t)F.vcu * NTHR + F.tid; i < (size_t)MTOK * DMODEL; i += (size_t)F.G * NTHR) a.out[i] = cst;
    }
#endif
#undef modl
#undef IN
#undef SEAM
#undef REPIN
}

extern "C" void kernel_launch(void* const* d_in, const int* in_sizes, int n_in, void* d_out, int out_size, void* d_ws, size_t ws_size, hipStream_t stream) {
    static int grid = 0;
    if (grid == 0) {
        if (n_in != 22 || in_sizes[0] != MTOK * DMODEL || out_size != MTOK * DMODEL || ws_size < WS_END) {
            fprintf(stderr, "kernel_launch: unexpected shapes (n_in %d, in0 %d, out %d, ws %zu; need ws >= %zu); nothing launched\n", n_in, n_in > 0 ? in_sizes[0] : -1, out_size, ws_size, (size_t)WS_END); grid = -1; return; }
        int dev = 0, cus = 0, per_cu = 0;
        if (hipGetDevice(&dev) != hipSuccess || hipDeviceGetAttribute(&cus, hipDeviceAttributeMultiprocessorCount, dev) != hipSuccess) { fprintf(stderr, "kernel_launch: device query failed\n"); grid = -1; return; }
        if (hipFuncSetAttribute((const void*)fwd_kernel, hipFuncAttributeMaxDynamicSharedMemorySize, LDS_BYTES) != hipSuccess) { fprintf(stderr, "kernel_launch: hipFuncSetAttribute failed\n"); grid = -1; return; }
        if (hipOccupancyMaxActiveBlocksPerMultiprocessor(&per_cu, (const void*)fwd_kernel, NTHR, LDS_BYTES) != hipSuccess || per_cu < 1)
            fprintf(stderr, "kernel_launch: note: occupancy query reports %d workgroups per CU\n", per_cu);
        (void)hipGetLastError();
        grid = cus;
    }
    if (grid < 0) return;
    if (hipMemsetAsync((char*)d_ws + WS_CTL, 0, CTL_ZERO_BYTES, stream) != hipSuccess) { fprintf(stderr, "kernel_launch: memset failed\n"); return; }
    Args a{};
    a.x = (const float*)d_in[0]; a.c = (const float*)d_in[1]; a.pos = (const int*)d_in[2];
    a.w_mod = (const float*)d_in[3]; a.b_mod = (const float*)d_in[4]; a.w_in = (const float*)d_in[5]; a.conv_w = (const float*)d_in[6]; a.conv_b = (const float*)d_in[7];
    a.wga = (const float*)d_in[8]; a.bga = (const float*)d_in[9]; a.wgx = (const float*)d_in[10]; a.bgx = (const float*)d_in[11]; a.lam = (const float*)d_in[12];
    a.g_attn = (const float*)d_in[13]; a.g_lru = (const float*)d_in[14]; a.w_out = (const float*)d_in[15]; a.ln1_g = (const float*)d_in[16]; a.ln1_b = (const float*)d_in[17];
    a.w_up = (const float*)d_in[18]; a.w_down = (const float*)d_in[19]; a.ln2_g = (const float*)d_in[20]; a.ln2_b = (const float*)d_in[21];
    a.out = (float*)d_out; a.ws = (unsigned char*)d_ws;
    if (ONE_LAUNCH) {
        a.ph_lo = 0; a.ph_hi = N_PHASES;
        hipLaunchKernelGGL(fwd_kernel, dim3(grid), dim3(NTHR), LDS_BYTES, stream, a);
    } else {
#ifdef PROBE_STOP
        const int np_ = PROBE_STOP;
#else
        const int np_ = N_PHASES;
#endif
        for (int p = 0; p < np_; ++p) {
            if (p >= 1 && ((p - 1) % PH_PER_LAYER) == 0 && p != 1) continue;
            a.ph_lo = p; a.ph_hi = p + 1;
            hipLaunchKernelGGL(fwd_kernel, dim3(grid), dim3(NTHR), LDS_BYTES, stream, a);
        }
    }
#ifdef PROBE_STOP
    if (PROBE_KIND < 10) { a.ph_lo = N_PHASES; a.ph_hi = N_PHASES + 1; hipLaunchKernelGGL(fwd_kernel, dim3(grid), dim3(NTHR), LDS_BYTES, stream, a); }
    else { a.ph_lo = N_PHASES + 1; a.ph_hi = N_PHASES + 2; hipLaunchKernelGGL(fwd_kernel, dim3(grid), dim3(NTHR), LDS_BYTES, stream, a);
           a.ph_lo = N_PHASES + 2; a.ph_hi = N_PHASES + 3; hipLaunchKernelGGL(fwd_kernel, dim3(grid), dim3(NTHR), LDS_BYTES, stream, a); }
#endif
    const hipError_t le = hipPeekAtLastError();
    if (le != hipSuccess) fprintf(stderr, "kernel_launch: launch failed: %s\n", hipGetErrorName(le));
}
```

```cpp
#include <hip/hip_runtime.h>
#include <cstdio>
#include <cstdint>
#define MK_N_LAUNCHES 1
namespace pg8 {
#define PG8_LAS __attribute__((address_space(3)))
typedef unsigned short bf16_t;
typedef short bf16x8 __attribute__((ext_vector_type(8)));
typedef float f32x4 __attribute__((ext_vector_type(4)));
typedef unsigned u32x4 __attribute__((ext_vector_type(4)));
constexpr int BM = 256, BK = 64, HALF = 128, HTB = HALF * BK * 2  , STAGE_BYTES = 8 * HTB, NXCD = 8, WGM = 8;

__host__ __device__ __forceinline__ int lds_byte(int r, int c) { const int st = (r >> 4) * 2 + (c >> 5), rr = r & 15, cc = c & 31, ob = rr * 64 + cc * 2; return st * 1024 + (ob ^ (((ob >> 9) & 1) << 5)); }
__host__ __device__ __forceinline__ void stage_rc(int b, int& R, int& C) { const int st = b / 1024, sb = b % 1024, swz = sb ^ (((sb >> 9) & 1) << 5); R = (st >> 1) * 16 + swz / 64; C = (st & 1) * 32 + (swz % 64) / 2; }
__host__ __device__ __forceinline__ int perm32(int rho) { const int n = rho >> 4, i = rho & 15; return 8 * (i >> 2) + 4 * n + (i & 3); }

struct Unit { int pm, pn; };
struct Gemm { const bf16_t* A; const bf16_t* Bt; int M, N, K; };

struct StaticOrder {
    int nM, nN, nwg, G, c;
    __host__ __device__ void init(int M, int N, int G_, int c_) { nM = M / BM; nN = N / BM; nwg = nM * nN; G = G_; c = c_; }
    __host__ __device__ bool next(int i, Unit& u) const {
        const long L = (long)i * G + c; if (L >= nwg) return false;
        int wgid = (int)L; { const int q = nwg / NXCD, r = nwg % NXCD, xcd = wgid % NXCD, off = wgid / NXCD; wgid = (xcd < r ? xcd * (q + 1) : r * (q + 1) + (xcd - r) * q) + off; }
        const int nig = WGM * nN, gid = wgid / nig, fm = gid * WGM, gsz = (nM - fm) < WGM ? (nM - fm) : WGM;
        u.pm = fm + ((wgid % nig) % gsz); u.pn = (wgid % nig) / gsz; return true;
    }
    __device__ __forceinline__ void a_ready(const Unit&) const {}
    __device__ __forceinline__ void done(const Unit&) const {}
};

__device__ __forceinline__ unsigned cvt_pk_bf16(float lo, float hi) { unsigned r; asm volatile("v_cvt_pk_bf16_f32 %0, %1, %2" : "=v"(r) : "v"(lo), "v"(hi)); return r; }
typedef float f32x2 __attribute__((ext_vector_type(2)));

template <int ACT> struct EpiOutBf16 {
    static constexpr bool PERM = true, AFTER_DRAIN = false;
    bf16_t* O; int ldc;
    __device__ __forceinline__ void operator()(const f32x4 (&acc)[2][2][4][2], const Unit& u, int wr, int wc, int fr, int fq) const {
        const int row0 = u.pm * BM + wr * 64 + fr, col0 = u.pn * BM + wc * 32 + 8 * fq;
#pragma unroll
        for (int ai = 0; ai < 2; ++ai)
#pragma unroll
            for (int m = 0; m < 4; ++m) { bf16_t* rowp = O + (size_t)(row0 + ai * HALF + m * 16) * ldc + col0;
#pragma unroll
                for (int bj = 0; bj < 2; ++bj) { f32x4 v0 = acc[ai][bj][m][0], v1 = acc[ai][bj][m][1];
                    if (ACT == 1) {
#pragma unroll
                        for (int j = 0; j < 4; ++j) { const float a0 = fmaxf(v0[j], 0.f), a1 = fmaxf(v1[j], 0.f); v0[j] = a0 * a0; v1[j] = a1 * a1; } }
                    u32x4 w; w.x = cvt_pk_bf16(v0[0], v0[1]); w.y = cvt_pk_bf16(v0[2], v0[3]); w.z = cvt_pk_bf16(v1[0], v1[1]); w.w = cvt_pk_bf16(v1[2], v1[3]);
                    *(u32x4*)(rowp + bj * HALF) = w; } }
    }
};
struct EpiResid {
    static constexpr bool PERM = false, AFTER_DRAIN = false;
    const float* xin; float* out; int ldc; const float* gate; int gate_bstride; int rows_per_batch; float alpha;
    __device__ __forceinline__ void operator()(const f32x4 (&acc)[2][2][4][2], const Unit& u, int wr, int wc, int fr, int fq) const {
        const int row0 = u.pm * BM + wr * 64 + fr, col0 = u.pn * BM + wc * 32 + 4 * fq;
        const float* g = gate + (size_t)((u.pm * BM) / rows_per_batch) * gate_bstride;
        f32x4 gv[2][2];
#pragma unroll
        for (int bj = 0; bj < 2; ++bj)
#pragma unroll
            for (int n = 0; n < 2; ++n) gv[bj][n] = *(const f32x4*)(g + col0 + bj * HALF + n * 16) + 1.0f;
#pragma unroll
        for (int ai = 0; ai < 2; ++ai)
#pragma unroll
            for (int m = 0; m < 4; ++m) { const size_t off = (size_t)(row0 + ai * HALF + m * 16) * ldc + col0;
#pragma unroll
                for (int bj = 0; bj < 2; ++bj)
#pragma unroll
                    for (int n = 0; n < 2; ++n) { const f32x4 xv = *(const f32x4*)(xin + off + bj * HALF + n * 16);
                        *(f32x4*)(out + off + bj * HALF + n * 16) = xv * alpha + gv[bj][n] * acc[ai][bj][m][n]; }
                asm volatile("" ::: "memory"); }
    }
};
template <class Epi, class Sched, bool ALIGN_EPI = false, bool SP2 = false>
__device__ __forceinline__ void gemm_phase(PG8_LAS unsigned char* lds, const Gemm g, const Sched& S, const Epi& E) {
    int tid_l = threadIdx.x; asm volatile("" : "+v"(tid_l));
    const int tid = tid_l, wid = __builtin_amdgcn_readfirstlane(tid >> 6), lane = tid & 63, wr = wid >> 2, wc = wid & 3, fr = lane & 15, fq = lane >> 4;
    const int K = g.K, nt = K / BK;
    unsigned voffA[2], voffB[2];
#pragma unroll
    for (int i = 0; i < 2; ++i) { int R, C; stage_rc(tid * 16 + i * 8192, R, C); const int Rb = Epi::PERM ? ((R & ~31) + perm32(R & 31)) : R;
        voffA[i] = (unsigned)(R * K + C) * 2u; voffB[i] = (unsigned)(Rb * K + C) * 2u; }
    const size_t kstep = (size_t)(BK * 2);
    const size_t hstep = (size_t)HALF * K * 2;
    const size_t tstep = 2 * hstep;
    const unsigned ldsw = (unsigned)wid * 1024u;
    const int aoff = lds_byte(wr * 64 + fr, fq * 8), boff = lds_byte(wc * 32 + fr, fq * 8);
#define PG8_SA(b, h) (((b) * 2 + (h)) * HTB)
#define PG8_SB(b, h) ((4 + (b) * 2 + (h)) * HTB)
#define PG8_STAGE(bufoff, gbase, voff) do { _Pragma("unroll") for (int _i = 0; _i < 2; ++_i) \
        __builtin_amdgcn_global_load_lds((const unsigned*)((const char*)(gbase) + (voff)[_i]), (PG8_LAS unsigned*)(lds + (bufoff) + ldsw + _i * 8192), 16, 0, 0); } while (0)
#define PG8_LDA(dst, b, h) do { _Pragma("unroll") for (int m = 0; m < 4; ++m) _Pragma("unroll") for (int k = 0; k < 2; ++k) dst[m][k] = *(const PG8_LAS bf16x8*)(lds + PG8_SA(b, h) + aoff + m * 2048 + k * 1024); } while (0)
#define PG8_LDB(dst, b, h) do { _Pragma("unroll") for (int n = 0; n < 2; ++n) _Pragma("unroll") for (int k = 0; k < 2; ++k) dst[n][k] = *(const PG8_LAS bf16x8*)(lds + PG8_SB(b, h) + boff + n * 2048 + k * 1024); } while (0)
#define PG8_MMA(ai, bj, At, Bt) do { __builtin_amdgcn_s_setprio(1); _Pragma("unroll") for (int m = 0; m < 4; ++m) _Pragma("unroll") for (int n = 0; n < 2; ++n) _Pragma("unroll") for (int k = 0; k < 2; ++k) \
        acc[ai][bj][m][n] = __builtin_amdgcn_mfma_f32_16x16x32_bf16(Bt[n][k], At[m][k], acc[ai][bj][m][n], 0, 0, 0); __builtin_amdgcn_s_setprio(0); } while (0)
#define PG8_WAIT_V(n) asm volatile("s_waitcnt vmcnt(" #n ")" ::: "memory")
#define PG8_WAIT_L(n) asm volatile("s_waitcnt lgkmcnt(" #n ")" ::: "memory")
#define PG8_BAR __builtin_amdgcn_s_barrier()
#define PG8_SCHED __builtin_amdgcn_sched_barrier(0)
    Unit cur, nxt; int ui = 0;
    if (!S.next(0, cur)) return;
    f32x4 acc[2][2][4][2];
#pragma unroll
    for (int a = 0; a < 2; ++a)
#pragma unroll
        for (int b = 0; b < 2; ++b)
#pragma unroll
            for (int m = 0; m < 4; ++m)
#pragma unroll
                for (int n = 0; n < 2; ++n) acc[a][b][m][n] = (f32x4){0.f, 0.f, 0.f, 0.f};
    bf16x8 At[4][2], B0[2][2], B1[2][2];
    const char* cA = (const char*)g.A + (size_t)cur.pm * tstep; const char* cB = (const char*)g.Bt + (size_t)cur.pn * tstep;
    S.a_ready(cur);
    if constexpr (SP2) {
        PG8_STAGE(PG8_SB(0, 0), cB, voffB); PG8_STAGE(PG8_SB(0, 1), cB + hstep, voffB); PG8_STAGE(PG8_SA(0, 0), cA, voffA); PG8_STAGE(PG8_SA(0, 1), cA + hstep, voffA);
        if (wr == 1) PG8_BAR;
        PG8_WAIT_V(2); PG8_BAR;
        PG8_STAGE(PG8_SB(1, 0), cB + kstep, voffB); PG8_STAGE(PG8_SA(1, 0), cA + kstep, voffA); PG8_STAGE(PG8_SB(1, 1), cB + hstep + kstep, voffB);
        PG8_WAIT_V(6); PG8_BAR;
    } else {
        PG8_STAGE(PG8_SB(0, 0), cB, voffB); PG8_STAGE(PG8_SA(0, 0), cA, voffA); PG8_STAGE(PG8_SB(0, 1), cB + hstep, voffB); PG8_STAGE(PG8_SA(0, 1), cA + hstep, voffA);
        if (wr == 1) PG8_BAR;
        PG8_WAIT_V(4); PG8_BAR;
        PG8_STAGE(PG8_SB(1, 0), cB + kstep, voffB); PG8_STAGE(PG8_SA(1, 0), cA + kstep, voffA); PG8_STAGE(PG8_SB(1, 1), cB + hstep + kstep, voffB);
        PG8_WAIT_V(6); PG8_BAR;
    }
    for (;;) {
        const bool has_next = S.next(ui + 1, nxt);
        const char* nA = has_next ? (const char*)g.A + (size_t)nxt.pm * tstep : cA; const char* nB = has_next ? (const char*)g.Bt + (size_t)nxt.pn * tstep : cB;
        for (int t = 0; t < nt; t += 2) {
            const bool last = (t == nt - 2);
            const char* a1 = cA + (size_t)(t + 1) * kstep;
            const char* a2 = last ? nA : cA + (size_t)(t + 2) * kstep; const char* b2 = last ? nB : cB + (size_t)(t + 2) * kstep;
            const char* a3 = a2 + kstep; const char* b3 = b2 + kstep;
            if (last && has_next) S.a_ready(nxt);
            if constexpr (SP2) {
            PG8_LDB(B0, 0, 0); PG8_LDB(B1, 0, 1); PG8_SCHED; PG8_LDA(At, 0, 0); PG8_STAGE(PG8_SA(1, 1), a1 + hstep, voffA);
            PG8_WAIT_V(8); PG8_WAIT_L(0); PG8_BAR; PG8_MMA(0, 0, At, B0); PG8_MMA(0, 1, At, B1); PG8_BAR; PG8_SCHED;
            PG8_LDA(At, 0, 1); PG8_STAGE(PG8_SB(0, 0), b2, voffB); PG8_STAGE(PG8_SB(0, 1), b2 + hstep, voffB); PG8_STAGE(PG8_SA(0, 0), a2, voffA);
            PG8_WAIT_V(8); PG8_WAIT_L(0); PG8_BAR; PG8_MMA(1, 0, At, B0); PG8_MMA(1, 1, At, B1); PG8_BAR; PG8_SCHED;
            PG8_LDB(B0, 1, 0); PG8_LDB(B1, 1, 1); PG8_SCHED; PG8_LDA(At, 1, 0); PG8_STAGE(PG8_SA(0, 1), a2 + hstep, voffA);
            PG8_WAIT_V(8); PG8_WAIT_L(0); PG8_BAR; PG8_MMA(0, 0, At, B0); PG8_MMA(0, 1, At, B1); PG8_BAR; PG8_SCHED;
            PG8_LDA(At, 1, 1); PG8_STAGE(PG8_SB(1, 0), b3, voffB); PG8_STAGE(PG8_SB(1, 1), b3 + hstep, voffB); PG8_STAGE(PG8_SA(1, 0), a3, voffA);
            PG8_WAIT_V(8); PG8_WAIT_L(0); PG8_BAR; PG8_MMA(1, 0, At, B0); PG8_MMA(1, 1, At, B1); PG8_BAR; PG8_SCHED;
            } else {
            PG8_LDB(B0, 0, 0); PG8_SCHED; PG8_LDA(At, 0, 0); PG8_STAGE(PG8_SA(1, 1), a1 + hstep, voffA);
            PG8_WAIT_L(8); PG8_BAR; PG8_WAIT_L(0); PG8_MMA(0, 0, At, B0); PG8_BAR; PG8_SCHED;
            PG8_LDB(B1, 0, 1); PG8_STAGE(PG8_SB(0, 0), b2, voffB);
            PG8_BAR; PG8_WAIT_L(0); PG8_MMA(0, 1, At, B1); PG8_BAR;
            PG8_LDA(At, 0, 1); PG8_STAGE(PG8_SA(0, 0), a2, voffA);
            PG8_BAR; PG8_WAIT_L(0); PG8_MMA(1, 0, At, B0); PG8_BAR; PG8_SCHED;
            PG8_STAGE(PG8_SB(0, 1), b2 + hstep, voffB);
            PG8_WAIT_V(6); PG8_BAR; PG8_MMA(1, 1, At, B1); PG8_BAR;
            PG8_LDB(B0, 1, 0); PG8_SCHED; PG8_LDA(At, 1, 0); PG8_STAGE(PG8_SA(0, 1), a2 + hstep, voffA);
            PG8_WAIT_L(8); PG8_BAR; PG8_WAIT_L(0); PG8_MMA(0, 0, At, B0); PG8_BAR; PG8_SCHED;
            PG8_LDB(B1, 1, 1); PG8_STAGE(PG8_SB(1, 0), b3, voffB);
            PG8_BAR; PG8_WAIT_L(0); PG8_MMA(0, 1, At, B1); PG8_BAR;
            PG8_LDA(At, 1, 1); PG8_STAGE(PG8_SA(1, 0), a3, voffA);
            PG8_BAR; PG8_WAIT_L(0); PG8_MMA(1, 0, At, B0); PG8_BAR; PG8_SCHED;
            PG8_STAGE(PG8_SB(1, 1), b3 + hstep, voffB);
            PG8_WAIT_V(6); PG8_BAR; PG8_MMA(1, 1, At, B1); PG8_BAR;
            }
        }
        if constexpr (ALIGN_EPI) { if (wr == 0) PG8_BAR; }
        if constexpr (!Epi::AFTER_DRAIN) { E(acc, cur, wr, wc, fr, fq); S.done(cur); }
        if (!has_next) break;
#pragma unroll
        for (int a = 0; a < 2; ++a)
#pragma unroll
            for (int b = 0; b < 2; ++b)
#pragma unroll
                for (int m = 0; m < 4; ++m)
#pragma unroll
                    for (int n = 0; n < 2; ++n) acc[a][b][m][n] = (f32x4){0.f, 0.f, 0.f, 0.f};
        cur = nxt; cA = nA; cB = nB; ++ui;
        if constexpr (ALIGN_EPI) { if (wr == 1) PG8_BAR; }
    }
    PG8_WAIT_V(0);
    if constexpr (!ALIGN_EPI) { if (wr == 0) PG8_BAR; }
    PG8_BAR;
    if constexpr (Epi::AFTER_DRAIN) { E.fused(acc, cur, wr, wc, fr, fq, lds, wid, lane); S.done(cur); }
#undef PG8_SA
#undef PG8_SB
#undef PG8_STAGE
#undef PG8_LDA
#undef PG8_LDB
#undef PG8_MMA
#undef PG8_WAIT_V
#undef PG8_WAIT_L
#undef PG8_BAR
#undef PG8_SCHED
}
}
#define GAS __attribute__((address_space(1)))
#define LAS __attribute__((address_space(3)))
typedef unsigned short bf16;
typedef unsigned v4u __attribute__((ext_vector_type(4)));
typedef float f32x4 __attribute__((ext_vector_type(4)));
typedef short bf16x8 __attribute__((ext_vector_type(8)));
typedef GAS unsigned gu32;
typedef GAS unsigned long long gu64;
#define RLX_AGENT __ATOMIC_RELAXED, __HIP_MEMORY_SCOPE_AGENT
#define LDS_WAIT() asm volatile("s_waitcnt lgkmcnt(0)" ::: "memory")
#define VM_WAIT() asm volatile("s_waitcnt vmcnt(0)" ::: "memory")
__device__ __forceinline__ unsigned long long rt() { return __builtin_amdgcn_s_memrealtime(); }
__device__ __forceinline__ unsigned f2bf(float f) { unsigned u = __builtin_bit_cast(unsigned, f); return (u + 0x7fffu + ((u >> 16) & 1u)) >> 16; }
__device__ __forceinline__ unsigned pk2(float lo, float hi) { return f2bf(lo) | (f2bf(hi) << 16); }

#define XB_TMO      128
#define XB_XCNT(j)  (256  + 64 * (j))
#define XB_XSUB(j)  (1280 + 64 * (j))
#define XB_XGEN(j)  (2304 + 64 * (j))
#define XB_TOP      3328
#define XB_TOPGEN   3392
#define XCD_BAR_WORDS 3456
#define XB_SPIN_CAP (1u << 18)

__device__ __forceinline__ unsigned xb_ld(unsigned* p)              { return __hip_atomic_load(p, __ATOMIC_RELAXED, __HIP_MEMORY_SCOPE_AGENT); }
__device__ __forceinline__ unsigned xb_add(unsigned* p, unsigned v) { return __hip_atomic_fetch_add(p, v, __ATOMIC_RELAXED, __HIP_MEMORY_SCOPE_AGENT); }
__device__ __forceinline__ unsigned xb_xcc_id() { return (unsigned)__builtin_amdgcn_s_getreg((3 << 11) | 20) & 0xFu; }
#define XB_SPIN(cond, bar) do { unsigned _sp = 0; while (cond) { __builtin_amdgcn_s_sleep(1); \
    if ((++_sp & 255u) == 0u) { if (xb_ld(&(bar)[XB_TMO])) break; if (_sp > XB_SPIN_CAP) { atomicAdd(&(bar)[XB_TMO], 1u); break; } } } } while (0)

struct XcdBarrier {
    unsigned* bar; unsigned x;
    volatile LAS unsigned* st;
};

__device__ __forceinline__ XcdBarrier xcd_barrier_post(unsigned* bar, volatile LAS unsigned* st) {
    XcdBarrier b; b.bar = bar; b.x = xb_xcc_id(); b.st = st;
    if (threadIdx.x == 0) (void)xb_add(&bar[XB_XCNT(b.x)], 1u);
    return b;
}
__device__ __forceinline__ void xcd_barrier_complete(unsigned* bar, unsigned x, unsigned& nloc, unsigned& nx) {
    const unsigned G = gridDim.x * gridDim.y * gridDim.z;
    unsigned sum, cnt, mine, sp = 0u;
    for (;;) {
        sum = 0u; cnt = 0u; mine = 0u;
#pragma unroll
        for (unsigned j = 0; j < 16; ++j) { const unsigned c = xb_ld(&bar[XB_XCNT(j)]); sum += c; cnt += (c > 0u) ? 1u : 0u; mine = (j == x) ? c : mine; }
        if (sum == G) break;
        __builtin_amdgcn_s_sleep(1);
        if ((++sp & 255u) == 0u) { if (xb_ld(&bar[XB_TMO])) break; if (sp > XB_SPIN_CAP) { atomicAdd(&bar[XB_TMO], 1u); break; } }
    }
    nloc = mine > 0u ? mine : 1u; nx = cnt > 0u ? cnt : 1u;
}

__device__ __forceinline__ void xcd_barrier(const XcdBarrier& b) {
    asm volatile("s_waitcnt vmcnt(0)" ::: "memory");
    __syncthreads();
    if (threadIdx.x == 0) {
        unsigned* bar = b.bar;
        __builtin_amdgcn_s_waitcnt(0);
        unsigned nloc = b.st[0], nx = b.st[1];
        if (nloc == 0u) { xcd_barrier_complete(bar, b.x, nloc, nx); b.st[0] = nloc; b.st[1] = nx; }
        const unsigned old = xb_add(&bar[XB_XSUB(b.x)], 1u);
        const unsigned gen = old / nloc;
        if (old + 1u == (gen + 1u) * nloc) {
            __builtin_amdgcn_fence(__ATOMIC_RELEASE, "agent");
            asm volatile("s_waitcnt vmcnt(0)" ::: "memory");
            const unsigned og = xb_add(&bar[XB_TOP], 1u);
            const unsigned tg = og / nx;
            if (og + 1u == (tg + 1u) * nx) xb_add(&bar[XB_TOPGEN], 1u);
            else XB_SPIN(xb_ld(&bar[XB_TOPGEN]) == tg, bar);
            __builtin_amdgcn_fence(__ATOMIC_ACQUIRE, "agent");
            xb_add(&bar[XB_XGEN(b.x)], 1u);
            asm volatile("s_waitcnt vmcnt(0)" ::: "memory");
        } else {
            XB_SPIN(xb_ld(&bar[XB_XGEN(b.x)]) == gen, bar);
            __builtin_amdgcn_fence(__ATOMIC_ACQUIRE, "agent");
            asm volatile("s_waitcnt vmcnt(0)" ::: "memory");
        }
    }
    __syncthreads();
}

constexpr int NWAVES = 8, NTHR = NWAVES * 64;
constexpr int BATCH = 8, SEQ = 4096, DMODEL = 1024, DEPTH = 4, MTOK = BATCH * SEQ;
constexpr int AW = 512, NHEAD = 4, HD = 128, IH = 8, IDIM = 64, TOPK = 256, LW = 512, LBLK = 8, LBS = 64, FF = 4096, NMOD = 6;
constexpr int INC = 3144, INP = 3328;
constexpr int CQ = 0, CK = 512, CV = 1024, CQI = 1536, CKI = 2048, CWI = 2112, CXR = 2120, CYG = 2632;
constexpr int MODW = NMOD * DMODEL;
constexpr float LN_EPS = 1e-5f;
constexpr float ALPHA = 1.6817928305074290f;
constexpr float LOG2E = 1.4426950408889634f;
constexpr int LCH = 128, NLCH = SEQ / LCH;

constexpr size_t MiB = 1u << 20;
constexpr size_t WS_CTL = 0, CTL_ZERO_BYTES = 1 * MiB;
constexpr size_t WS_MOD = 1 * MiB;
constexpr size_t WS_GATE = 2 * MiB;
constexpr size_t WS_CARRY = 3 * MiB;
constexpr size_t WS_WI = 4 * MiB;
constexpr size_t WS_KI = 5 * MiB;
constexpr size_t WS_MASK = 9 * MiB;
constexpr size_t WS_WIN = 25 * MiB;
constexpr size_t WS_WOUT = 51 * MiB;
constexpr size_t WS_WUP = 59 * MiB;
constexpr size_t WS_WDN = 91 * MiB;
constexpr size_t WS_HA = 123 * MiB;
constexpr size_t WS_P = 187 * MiB;
constexpr size_t WS_MG = 395 * MiB;
constexpr size_t WS_HID = 187 * MiB;
constexpr size_t WS_END = 459 * MiB;
static_assert(WS_WIN + (size_t)DEPTH * INP * 1024 * 2 <= WS_WOUT && WS_P + (size_t)MTOK * INP * 2 <= WS_MG && WS_HID + (size_t)MTOK * FF * 2 <= WS_END && WS_MG + (size_t)MTOK * 1024 * 2 <= WS_END, "d_ws map");
constexpr int CW_BAR = 4096;

constexpr int RING_BYTES = 131072;
constexpr int LDSCTL_OFF = RING_BYTES, MISC_OFF = LDSCTL_OFF + 320;
constexpr int LDS_BYTES = 147456;

__device__ __constant__ float ROPE_INV[64] = {
1.000000000e+00f, 8.659643531e-01f, 7.498942614e-01f, 6.493816376e-01f, 5.623413324e-01f, 4.869675338e-01f, 4.216965139e-01f, 3.651741147e-01f, 3.162277639e-01f, 2.738419771e-01f, 2.371373773e-01f, 2.053525001e-01f, 1.778279394e-01f, 1.539926529e-01f, 1.333521307e-01f, 1.154782027e-01f, 1.000000015e-01f, 8.659642935e-02f, 7.498941571e-02f, 6.493816525e-02f, 5.623413250e-02f, 4.869675264e-02f, 4.216965288e-02f, 3.651741147e-02f, 3.162277490e-02f, 2.738419734e-02f, 2.371373773e-02f, 2.053525113e-02f, 1.778279431e-02f, 1.539926510e-02f, 1.333521493e-02f, 1.154782064e-02f, 9.999999776e-03f, 8.659643121e-03f, 7.498941850e-03f, 6.493816152e-03f, 5.623413250e-03f, 4.869675264e-03f, 4.216964822e-03f, 3.651741194e-03f, 3.162277630e-03f, 2.738419687e-03f, 2.371373586e-03f, 2.053524833e-03f, 1.778279431e-03f, 1.539926510e-03f, 1.333521446e-03f, 1.154781901e-03f, 1.000000047e-03f, 8.659643354e-04f, 7.498942432e-04f, 6.493816618e-04f, 5.623413017e-04f, 4.869675322e-04f, 4.216965172e-04f, 3.651741426e-04f, 3.162277571e-04f, 2.738419571e-04f, 2.371373703e-04f, 2.053525095e-04f, 1.778279402e-04f, 1.539926452e-04f, 1.333521504e-04f, 1.154782003e-04f };

typedef float f32x16 __attribute__((ext_vector_type(16)));
typedef unsigned u32x2 __attribute__((ext_vector_type(2)));
__device__ __forceinline__ float bf2f(unsigned short b) { return __builtin_bit_cast(float, ((unsigned)b) << 16); }
__device__ __forceinline__ unsigned cvtpk(float lo, float hi) { unsigned r; asm volatile("v_cvt_pk_bf16_f32 %0, %1, %2" : "=v"(r) : "v"(lo), "v"(hi)); return r; }
__device__ __forceinline__ float wave_sum(float v) {
#pragma unroll
    for (int o = 1; o < 64; o <<= 1) v += __shfl_xor(v, o);
    return v;
}
__device__ __forceinline__ float wave_max(float v) {
#pragma unroll
    for (int o = 1; o < 64; o <<= 1) v = fmaxf(v, __shfl_xor(v, o));
    return v;
}
__device__ __forceinline__ float wave_min(float v) {
#pragma unroll
    for (int o = 1; o < 64; o <<= 1) v = fminf(v, __shfl_xor(v, o));
    return v;
}
__device__ __forceinline__ float sigmoidf_fast(float z) { return __builtin_amdgcn_rcpf(1.0f + __builtin_amdgcn_exp2f(-z * LOG2E)); }

struct Args {
    const float* x; const float* c; const int* pos;
    const float *w_mod, *b_mod, *w_in, *conv_w, *conv_b, *wga, *bga, *wgx, *bgx, *lam, *g_attn, *g_lru, *w_out, *ln1_g, *ln1_b, *w_up, *w_down, *ln2_g, *ln2_b;
    float* out; unsigned char* ws; int ph_lo, ph_hi;
};

namespace att {
constexpr int D = 128, NW = 8, QBLK = 32, KVBLK = 64, QB = NW * QBLK;
constexpr int SHM_V = KVBLK * D * 2, SHM_K = KVBLK * D * 2;
constexpr int LDS_BYTES = 2 * SHM_V + 2 * SHM_K + NW * 64 * 4;
constexpr float SCALE = 0.08838834764831845f, THR = 8.f;
constexpr int PQ = INP, PO = DMODEL;
constexpr int MKW = SEQ / 32;
#define KSWZ(row, colB) ((row) * 256 + ((colB) ^ (((row) & 7) << 4)))
#define SBAR() __builtin_amdgcn_sched_barrier(0)
__device__ __forceinline__ int v_st(int k, int c) { const int kk = (k & ~0xC) | ((k & 4) << 1) | ((k & 8) >> 1); return ((kk >> 3) * 4 + (c >> 5)) * 512 + ((kk & 7) * 32 + (c & 31)) * 2; }
__device__ __forceinline__ int v_rd_base(int lane) { return ((lane & 3) << 3) | (((lane >> 2) & 3) << 6) | (((lane >> 4) & 1) << 5) | (((lane >> 5) & 1) << 8); }
constexpr int v_rd_off(int d0, int ks, int half) { return d0 * 512 + ks * 4096 + half * 2048; }
__device__ __forceinline__ int crow(int r, int hi) { return (r & 3) + 8 * (r >> 2) + 4 * hi; }
typedef short s16x4 __attribute__((ext_vector_type(4)));
template <class T> __device__ __forceinline__ T* uni(T* p) { const unsigned long long v = (unsigned long long)(uintptr_t)p; const unsigned lo = __builtin_amdgcn_readfirstlane((unsigned)v), hi = __builtin_amdgcn_readfirstlane((unsigned)(v >> 32)); return (T*)(GAS T*)(uintptr_t)(((unsigned long long)hi << 32) | lo); }
__device__ __forceinline__ bf16x8 load8(const bf16* p) { return *reinterpret_cast<const bf16x8*>(p); }
__device__ __forceinline__ void mask_tile(f32x16& p0, f32x16& p1, int dq) {
    const float NEG = -__builtin_inff();
#pragma unroll
    for (int r = 0; r < 16; ++r) {
        const int c = (r & 3) + 8 * (r >> 2);
        if (dq - c < 0) p0[r] = NEG;
        if (dq - c - 32 < 0) p1[r] = NEG;
    }
}
__device__ __forceinline__ void apply_bits(f32x16& p, unsigned ws) {
#ifdef ATT_NOMASK
    return;
#endif
#pragma unroll
    for (int r = 0; r < 16; ++r) { const int c = (r & 3) + 8 * (r >> 2); const unsigned m = (unsigned)(((int)(ws << (31 - c))) >> 31); const float pv = p[r]; p[r] = __uint_as_float(__float_as_uint(pv) & m); }
}
__device__ __forceinline__ void partialSM(f32x16& p0, f32x16& p1, float& m_reg, float& mn, float& alpha, unsigned w0s) {
    float pmax = p0[0];
#pragma unroll
    for (int r = 1; r < 16; ++r) pmax = fmaxf(pmax, p0[r]);
#pragma unroll
    for (int r = 0; r < 16; ++r) pmax = fmaxf(pmax, p1[r]);
    { auto rr = __builtin_amdgcn_permlane32_swap(__float_as_uint(pmax), __float_as_uint(pmax), false, false);
      pmax = fmaxf(__uint_as_float(rr[0]), __uint_as_float(rr[1])); }
    constexpr float C2 = 1.4426950408889634f * SCALE;
    if (__builtin_expect(__all((pmax - m_reg) * SCALE <= THR), 1)) { mn = m_reg; alpha = 1.f; }
    else { mn = fmaxf(m_reg, pmax); alpha = __builtin_amdgcn_exp2f((m_reg - mn) * C2); m_reg = mn; }
    const float mnL = -mn * C2;
#pragma unroll
    for (int r = 0; r < 16; ++r) p0[r] = fmaf(p0[r], C2, mnL);
#pragma unroll
    for (int r = 0; r < 16; ++r) p1[r] = fmaf(p1[r], C2, mnL);
#pragma unroll
    for (int r = 0; r < 16; ++r) p0[r] = __builtin_amdgcn_exp2f(p0[r]);
    apply_bits(p0, w0s);
}
__device__ __forceinline__ void finishSM(f32x16& p0, f32x16& p1, float alpha, float& l_reg, bf16x8& pa0, bf16x8& pa1, bf16x8& pa2, bf16x8& pa3, unsigned w1s) {
#pragma unroll
    for (int r = 0; r < 16; ++r) p1[r] = __builtin_amdgcn_exp2f(p1[r]);
    apply_bits(p1, w1s);
    float ps = 0;
#pragma unroll
    for (int r = 0; r < 16; ++r) ps += p0[r];
#pragma unroll
    for (int r = 0; r < 16; ++r) ps += p1[r];
    { auto rr = __builtin_amdgcn_permlane32_swap(__float_as_uint(ps), __float_as_uint(ps), false, false);
      ps = __uint_as_float(rr[0]) + __uint_as_float(rr[1]); }
    l_reg = l_reg * alpha + ps;
#define PK4(P, B_, OUT) do { unsigned a0 = cvtpk(P[B_+0], P[B_+1]), a1 = cvtpk(P[B_+2], P[B_+3]);                          \
        unsigned b0 = cvtpk(P[B_+4], P[B_+5]), b1 = cvtpk(P[B_+6], P[B_+7]);                                             \
        auto r0 = __builtin_amdgcn_permlane32_swap(a0, b0, false, false); auto r1 = __builtin_amdgcn_permlane32_swap(a1, b1, false, false); \
        v4u w = {r0[0], r1[0], r0[1], r1[1]}; OUT = *reinterpret_cast<bf16x8*>(&w); } while (0)
    PK4(p0, 0, pa0); PK4(p0, 8, pa1); PK4(p1, 0, pa2); PK4(p1, 8, pa3);
#undef PK4
}
template <int KB>
__device__ __forceinline__ void qkt(f32x16& p0, f32x16& p1, const char* K_lds, int r32, int hi, const bf16x8* qr) {
    p0 = f32x16{}; p1 = f32x16{};
    const char* kb[4];
#pragma unroll
    for (int dd = 0; dd < 4; ++dd) kb[dd] = K_lds + KB * SHM_K + KSWZ(r32, (dd * 16 + hi * 8) * 2);
#pragma unroll
    for (int d0 = 0; d0 < 8; ++d0) { const char* a = kb[d0 & 3] + (d0 >> 2) * 128;
        bf16x8 b0 = *reinterpret_cast<const bf16x8*>(a);
        bf16x8 b1 = *reinterpret_cast<const bf16x8*>(a + 32 * 256);
        p0 = __builtin_amdgcn_mfma_f32_32x32x16_bf16(b0, qr[d0], p0, 0, 0, 0);
        p1 = __builtin_amdgcn_mfma_f32_32x32x16_bf16(b1, qr[d0], p1, 0, 0, 0); }
}
template <int VB>
__device__ __forceinline__ void pv_tile(f32x16* o, int vb0, bf16x8 pa0, bf16x8 pa1, bf16x8 pa2, bf16x8 pa3) {
#define TRRD(dst, off) asm volatile("ds_read_b64_tr_b16 %0, %1 offset:%2" : "=&v"(dst) : "v"(vb0), "i"(off) : "memory")
#define PV_D0(d0) do { s16x4 l0, l1, l2, l3, h0, h1, h2, h3; constexpr int b_ = VB * SHM_V + v_rd_off(d0, 0, 0); \
        TRRD(l0, b_); TRRD(h0, b_ + 2048); TRRD(l1, b_ + 4096); TRRD(h1, b_ + 6144); TRRD(l2, b_ + 8192); TRRD(h2, b_ + 10240); TRRD(l3, b_ + 12288); TRRD(h3, b_ + 14336); \
        asm volatile("s_waitcnt lgkmcnt(0)" ::: "memory"); SBAR();   \
        o[d0] = __builtin_amdgcn_mfma_f32_32x32x16_bf16(pa0, (bf16x8){l0[0], l0[1], l0[2], l0[3], h0[0], h0[1], h0[2], h0[3]}, o[d0], 0, 0, 0);   \
        o[d0] = __builtin_amdgcn_mfma_f32_32x32x16_bf16(pa1, (bf16x8){l1[0], l1[1], l1[2], l1[3], h1[0], h1[1], h1[2], h1[3]}, o[d0], 0, 0, 0);   \
        o[d0] = __builtin_amdgcn_mfma_f32_32x32x16_bf16(pa2, (bf16x8){l2[0], l2[1], l2[2], l2[3], h2[0], h2[1], h2[2], h2[3]}, o[d0], 0, 0, 0);   \
        o[d0] = __builtin_amdgcn_mfma_f32_32x32x16_bf16(pa3, (bf16x8){l3[0], l3[1], l3[2], l3[3], h3[0], h3[1], h3[2], h3[3]}, o[d0], 0, 0, 0); } while (0)
    PV_D0(0); PV_D0(1); PV_D0(2); PV_D0(3);
#undef PV_D0
#undef TRRD
}
struct Bases { const char* P; char* MG; const char* MK; };
struct BlockRef { unsigned q, k, v, o, mk; int P0; };
struct Seam { bf16x8 qr[8]; bf16x8 st_v0, st_v1, st_k0, st_k1; };
#define VMW() asm volatile("s_waitcnt vmcnt(0)" ::: "memory")
#define VMWN(n) asm volatile("s_waitcnt vmcnt(%0)" :: "i"(n) : "memory")
#define SLOAD_H(Kp, Vp, k0) do { const char* kk_ = (Kp) + (size_t)(k0) * (PQ * 2); const char* vv_ = (Vp) + (size_t)(k0) * (PQ * 2);              \
                         S.st_v0 = *(const bf16x8*)(vv_ + so0); S.st_v1 = *(const bf16x8*)(vv_ + so1);              \
                         S.st_k0 = *(const bf16x8*)(kk_ + so0); S.st_k1 = *(const bf16x8*)(kk_ + so1); } while (0)
#define SWRITE_HK(bf) do { *(bf16x8*)(K_lds + (bf) * SHM_K + kws) = S.st_k0; *(bf16x8*)(K_lds + (bf) * SHM_K + kws + 32 * 256) = S.st_k1; } while (0)
#define SWRITE_HV(bf) do { *(bf16x8*)(V_lds + (bf) * SHM_V + vst0) = S.st_v0; *(bf16x8*)(V_lds + (bf) * SHM_V + vst1) = S.st_v1; } while (0)
#define SWRITE_H(bf) do { SWRITE_HV(bf); SWRITE_HK(bf); } while (0)
__device__ __forceinline__ void prime(const Bases& B, const BlockRef& cur, char* lds, Seam& S) {
    int tid_l = threadIdx.x; asm volatile("" : "+v"(tid_l));
    const int tid = tid_l, wid = __builtin_amdgcn_readfirstlane(tid >> 6), lane = tid & 63, r32 = lane & 31, hi = lane >> 5;
    const int sr = tid >> 4, sc = (tid & 15) * 8, kws = KSWZ(sr, sc * 2); char* K_lds = lds + 2 * SHM_V;
    const unsigned so0 = (unsigned)(sr * PQ + sc) * 2u, so1 = so0 + 32u * PQ * 2u;
    const unsigned qo = (unsigned)((wid * QBLK + r32) * PQ + hi * 8) * 2u;
    const char* Qb = B.P + cur.q; const char* Kb = B.P + cur.k; const char* Vb = B.P + cur.v;
#pragma unroll
    for (int d0 = 0; d0 < 8; ++d0) S.qr[d0] = *(const bf16x8*)(Qb + qo + d0 * 32);
    SLOAD_H(Kb, Vb, 0); VMW(); SWRITE_HK(0);
    __syncthreads();
}
__device__ __forceinline__ void block(const Bases& B, const BlockRef& cur, const BlockRef& nxt, char* lds, Seam& S) {
    int tid_l = threadIdx.x; asm volatile("" : "+v"(tid_l));
    const int tid = tid_l, wid = __builtin_amdgcn_readfirstlane(tid >> 6), lane = tid & 63, r32 = lane & 31, hi = lane >> 5;
    const int NT = cur.P0 / KVBLK + QB / KVBLK;
    const int qlo = cur.P0 + wid * QBLK, qm = qlo + r32 - 4 * hi;
    char* V_lds = lds; char* K_lds = lds + 2 * SHM_V;
    float* ws = (float*)(lds + 2 * SHM_V + 2 * SHM_K) + wid * 64; float* li_l = ws, * al_l = ws + 32;
    float m_reg = -1e30f, l_reg = 0; f32x16 o[4] = {};
    const int sr = tid >> 4, sc = (tid & 15) * 8, vst0 = v_st(sr, sc), vst1 = v_st(32 + sr, sc), kws = KSWZ(sr, sc * 2);
    const int vb0 = (int)(uintptr_t)V_lds + v_rd_base(lane);
    const char* Kh = B.P + cur.k; const char* Vh = B.P + cur.v;
    const unsigned so0 = (unsigned)(sr * PQ + sc) * 2u, so1 = so0 + 32u * PQ * 2u;
    const unsigned qo = (unsigned)((wid * QBLK + r32) * PQ + hi * 8) * 2u;
    const char* mkb = B.MK + cur.mk; const unsigned mo = (unsigned)(wid * QBLK + r32) * (MKW * 4u);
    const int sh4 = 4 * hi;
#define RESC(a) do { if (__any((a) < 1.f)) { if (hi == 0) al_l[r32] = (a); asm volatile("s_waitcnt lgkmcnt(0)" ::: "memory");              \
                     for (int d_ = 0; d_ < 4; ++d_) for (int r = 0; r < 16; ++r) o[d_][r] *= al_l[crow(r, hi)]; } } while (0)
#define KBASE(t) ((t) * KVBLK)
#define MASKT(P0_, P1_, t) do { const int kb_ = KBASE(t); if (kb_ + KVBLK - 1 > qlo) mask_tile(P0_, P1_, qm - kb_); } while (0)
#define MLOAD(t) (*(const u32x2*)(mkb + (size_t)(t) * 8 + mo))
    f32x16 pA0, pA1, pB0, pB1; float mnA, mnB, alA, alB; bf16x8 pa0, pa1, pa2, pa3; u32x2 mA, mB;
    SWRITE_HV(0); SBAR();
    SLOAD_H(Kh, Vh, KBASE(1));
    mA = MLOAD(0);
    SBAR(); qkt<0>(pA0, pA1, K_lds, r32, hi, S.qr);
    MASKT(pA0, pA1, 0); partialSM(pA0, pA1, m_reg, mnA, alA, mA.x >> sh4);
    VMW(); SWRITE_H(1);
    __syncthreads();
#define HALF_STEP(PX0, PX1, mnX, alX, mX, PY0, PY1, alY, mY, t, KB, VB, SB) do {                                              \
        SBAR(); mX = MLOAD(t); qkt<KB>(PX0, PX1, K_lds, r32, hi, S.qr);                                                      \
        finishSM(PY0, PY1, alY, l_reg, pa0, pa1, pa2, pa3, mY.y >> sh4); SBAR();                                              \
        if ((t) + 1 < NT) { SLOAD_H(Kh, Vh, KBASE((t) + 1)); SBAR(); }                                                        \
        pv_tile<VB>(o, vb0, pa0, pa1, pa2, pa3); MASKT(PX0, PX1, (t)); partialSM(PX0, PX1, m_reg, mnX, alX, mX.x >> sh4);    \
        __syncthreads();                                                                                                      \
        if ((t) + 1 < NT) { VMW(); SWRITE_H(SB); }                                                                            \
        RESC(alX); __syncthreads(); } while (0)
    for (int t = 1; t + 1 < NT; t += 2) {
        HALF_STEP(pB0, pB1, mnB, alB, mB, pA0, pA1, alA, mA, t, 1, 0, 0);
        HALF_STEP(pA0, pA1, mnA, alA, mA, pB0, pB1, alB, mB, t + 1, 0, 1, 1);
    }
    SBAR(); mB = MLOAD(NT - 1); qkt<1>(pB0, pB1, K_lds, r32, hi, S.qr); SBAR();
    { const char* nK = B.P + nxt.k; const char* nV = B.P + nxt.v; SLOAD_H(nK, nV, 0); } SBAR();
    { const char* nQ = B.P + nxt.q;
#pragma unroll
    for (int d0 = 0; d0 < 8; ++d0) S.qr[d0] = *(const bf16x8*)(nQ + qo + d0 * 32); }
    SBAR();
    finishSM(pA0, pA1, alA, l_reg, pa0, pa1, pa2, pa3, mA.y >> sh4); SBAR();
    pv_tile<0>(o, vb0, pa0, pa1, pa2, pa3);
    MASKT(pB0, pB1, NT - 1); partialSM(pB0, pB1, m_reg, mnB, alB, mB.x >> sh4); __syncthreads(); RESC(alB);
    finishSM(pB0, pB1, alB, l_reg, pa0, pa1, pa2, pa3, mB.y >> sh4); SBAR(); pv_tile<1>(o, vb0, pa0, pa1, pa2, pa3);
    SBAR(); VMWN(8); SWRITE_HK(0); SBAR();
    if (hi == 0) li_l[r32] = l_reg; asm volatile("s_waitcnt lgkmcnt(0)" ::: "memory");
    float rli[16];
#pragma unroll
    for (int r = 0; r < 16; ++r) rli[r] = __builtin_amdgcn_rcpf(li_l[crow(r, hi)]);
    char* Ob = B.MG + cur.o; const unsigned oo = (unsigned)((wid * QBLK) * PO + r32) * 2u;
#pragma unroll
    for (int r = 0; r < 16; ++r) { const int orow = crow(r, hi);
#pragma unroll
        for (int d0 = 0; d0 < 4; ++d0) { const float v = o[d0][r] * rli[r];
            const float vn = __shfl_xor(v, 1);
            if ((r32 & 1) == 0) *(unsigned*)(Ob + oo + (unsigned)(orow * PO + d0 * 32) * 2u) = cvtpk(v, vn); } }
    __syncthreads();
#undef RESC
#undef KBASE
#undef MASKT
#undef MLOAD
#undef HALF_STEP
}
#undef VMW
#undef VMWN
#undef SLOAD_H
#undef SWRITE_HK
#undef SWRITE_HV
#undef SWRITE_H
#undef SBAR
#undef KSWZ
}

struct Frame {
    LAS unsigned char* lds;
    gu32* ctl;
    int tid, lane, wave, vcu, G;
    float* MODV; bf16* GATE; float* CARRY; float* WI; bf16* KI; unsigned* MASK; bf16 *WIN, *WOUT, *WUP, *WDN, *HA, *P, *MG, *HID;
};

__device__ __forceinline__ void transpose_item(const float* W, int K, int N, bf16* WT, LAS float* scr, int item, int nblk, int lane) {
    const int kb = item / nblk, nb = item % nblk, k0 = 64 * kb, n0 = 32 * nb;
    const int nn = n0 + (lane & 31);
#pragma unroll 8
    for (int i = 0; i < 32; ++i) { const int kk = 2 * i + (lane >> 5); scr[kk * 33 + (lane & 31)] = (nn < N) ? W[(size_t)(k0 + kk) * N + nn] : 0.f; }
    LDS_WAIT(); asm volatile("" ::: "memory");
    const int c = lane & 7;
#pragma unroll
    for (int j = 0; j < 4; ++j) { const int n = (lane >> 3) + 8 * j; const LAS float* s = scr + (8 * c) * 33 + n;
        v4u o; o.x = pk2(s[0 * 33], s[1 * 33]); o.y = pk2(s[2 * 33], s[3 * 33]); o.z = pk2(s[4 * 33], s[5 * 33]); o.w = pk2(s[6 * 33], s[7 * 33]);
        *(GAS v4u*)(WT + (size_t)(n0 + n) * K + k0 + 8 * c) = o; }
    LDS_WAIT(); asm volatile("" ::: "memory");
}
__device__ __forceinline__ void p0_prologue(Frame& F, const Args& a) {
    LAS float* scr = (LAS float*)(F.lds + F.wave * 16384);
    const int gw = F.vcu * NWAVES + F.wave, NGW = F.G * NWAVES;
    constexpr int I_IN = (DMODEL / 64) * (INP / 32), I_OUT = (DMODEL / 64) * (DMODEL / 32), I_UP = (DMODEL / 64) * (FF / 32), I_DN = (FF / 64) * (DMODEL / 32);
    constexpr int PER_L = I_IN + I_OUT + I_UP + I_DN;
    for (int it = gw; it < DEPTH * PER_L; it += NGW) {
        const int l = it / PER_L; int r = it % PER_L;
        if (r < I_IN) { transpose_item(a.w_in + (size_t)l * DMODEL * INC, DMODEL, INC, F.WIN + (size_t)l * INP * DMODEL, scr, r, INP / 32, F.lane); continue; } r -= I_IN;
        if (r < I_OUT) { transpose_item(a.w_out + (size_t)l * DMODEL * DMODEL, DMODEL, DMODEL, F.WOUT + (size_t)l * DMODEL * DMODEL, scr, r, DMODEL / 32, F.lane); continue; } r -= I_OUT;
        if (r < I_UP) { transpose_item(a.w_up + (size_t)l * DMODEL * FF, DMODEL, FF, F.WUP + (size_t)l * FF * DMODEL, scr, r, FF / 32, F.lane); continue; } r -= I_UP;
        transpose_item(a.w_down + (size_t)l * FF * DMODEL, FF, DMODEL, F.WDN + (size_t)l * DMODEL * FF, scr, r, DMODEL / 32, F.lane);
    }
    for (int i = F.vcu * NTHR + F.tid; i < DEPTH * 2 * LBLK * 64 * 64; i += F.G * NTHR) {
        const int c = i & 63, d = (i >> 6) & 63, n = (i >> 12) & 7, g = (i >> 15) & 1, l = i >> 16;
        const float* src = g ? a.wgx : a.wga;
        F.GATE[i] = (bf16)f2bf(src[(((size_t)l * LBLK + n) * 64 + c) * 64 + d]);
    }
    __syncthreads();
    LAS float* sc = (LAS float*)F.lds;
    LAS float* red = (LAS float*)(F.lds + 32768);
    for (int i = F.tid; i < BATCH * DMODEL; i += NTHR) { const int b = i >> 10, k = i & 1023; const float v = a.c[i]; sc[k * 8 + b] = v * sigmoidf_fast(v); }
    __syncthreads();
    for (int u = F.vcu; u < DEPTH * (MODW / 64); u += F.G) {
        const int l = u / (MODW / 64), j = (u % (MODW / 64)) * 64 + F.lane;
        float acc[8];
#pragma unroll
        for (int b = 0; b < 8; ++b) acc[b] = 0.f;
        const float* wp = a.w_mod + (size_t)l * DMODEL * MODW + j;
#pragma unroll 4
        for (int kk = 0; kk < 128; ++kk) { const int k = F.wave * 128 + kk; const float wv = wp[(size_t)k * MODW];
            const f32x4 s0 = *(const LAS f32x4*)(sc + k * 8), s1 = *(const LAS f32x4*)(sc + k * 8 + 4);
            acc[0] += s0[0] * wv; acc[1] += s0[1] * wv; acc[2] += s0[2] * wv; acc[3] += s0[3] * wv;
            acc[4] += s1[0] * wv; acc[5] += s1[1] * wv; acc[6] += s1[2] * wv; acc[7] += s1[3] * wv; }
#pragma unroll
        for (int b = 0; b < 8; ++b) red[(F.wave * 8 + b) * 64 + F.lane] = acc[b];
        __syncthreads();
        float s = a.b_mod[(size_t)l * MODW + j];
#pragma unroll
        for (int w2 = 0; w2 < 8; ++w2) s += red[(w2 * 8 + F.wave) * 64 + F.lane];
        F.MODV[((size_t)l * BATCH + F.wave) * MODW + j] = s;
        __syncthreads();
    }
}

__device__ __forceinline__ void modulate_rows(Frame& F, const float* x, const float* modl, int shoff, int scoff) {
    const int gw = F.vcu * NWAVES + F.wave, NGW = F.G * NWAVES;
    for (int m = gw; m < MTOK; m += NGW) {
        const float* mb = modl + (size_t)(m / SEQ) * MODW;
#pragma unroll
        for (int j = 0; j < 4; ++j) { const int col = 4 * F.lane + 256 * j;
            const f32x4 v = *(const GAS f32x4*)(x + (size_t)m * DMODEL + col), s = *(const GAS f32x4*)(mb + scoff + col), h = *(const GAS f32x4*)(mb + shoff + col);
            const f32x4 y = v * (s + 1.0f) + h;
            u32x2 w; w.x = cvtpk(y[0], y[1]); w.y = cvtpk(y[2], y[3]);
            *(GAS u32x2*)(F.HA + (size_t)m * DMODEL + col) = w; }
    }
}
__device__ __forceinline__ void ln_rows(Frame& F, float* x, const float* g, const float* bt, const float* modl, int shoff, int scoff) {
    const int gw = F.vcu * NWAVES + F.wave, NGW = F.G * NWAVES;
    for (int m = gw; m < MTOK; m += NGW) {
        f32x4 v[4]; float s = 0.f;
#pragma unroll
        for (int j = 0; j < 4; ++j) { v[j] = *(const GAS f32x4*)(x + (size_t)m * DMODEL + 4 * F.lane + 256 * j); s += (v[j][0] + v[j][1]) + (v[j][2] + v[j][3]); }
        const float mean = wave_sum(s) * (1.f / DMODEL); float s2 = 0.f;
#pragma unroll
        for (int j = 0; j < 4; ++j) { v[j] = v[j] - mean; s2 += (v[j][0] * v[j][0] + v[j][1] * v[j][1]) + (v[j][2] * v[j][2] + v[j][3] * v[j][3]); }
        const float rstd = 1.f / sqrtf(wave_sum(s2) * (1.f / DMODEL) + LN_EPS);
        const float* mb = modl ? modl + (size_t)(m / SEQ) * MODW : nullptr;
#pragma unroll
        for (int j = 0; j < 4; ++j) { const int col = 4 * F.lane + 256 * j;
            const f32x4 gg = *(const GAS f32x4*)(g + col), bb = *(const GAS f32x4*)(bt + col);
            const f32x4 y = v[j] * rstd * gg + bb;
            *(GAS f32x4*)(x + (size_t)m * DMODEL + col) = y;
            if (modl) { const f32x4 sv = *(const GAS f32x4*)(mb + scoff + col), hv = *(const GAS f32x4*)(mb + shoff + col);
                const f32x4 h = y * (sv + 1.0f) + hv; u32x2 w; w.x = cvtpk(h[0], h[1]); w.y = cvtpk(h[2], h[3]);
                *(GAS u32x2*)(F.HA + (size_t)m * DMODEL + col) = w; } }
    }
}
__device__ __forceinline__ void rms_rows(Frame& F, const float* ga, const float* gl) {
    const int gw = F.vcu * NWAVES + F.wave, NGW = F.G * NWAVES;
    for (int m = gw; m < MTOK; m += NGW) {
#pragma unroll
        for (int hf = 0; hf < 2; ++hf) {
            bf16* p = F.MG + (size_t)m * DMODEL + hf * 512 + 8 * F.lane;
            const v4u raw = *(const GAS v4u*)p; float f[8];
#pragma unroll
            for (int i = 0; i < 4; ++i) { f[2 * i] = __builtin_bit_cast(float, raw[i] << 16); f[2 * i + 1] = __builtin_bit_cast(float, raw[i] & 0xffff0000u); }
            float ss = 0.f;
#pragma unroll
            for (int i = 0; i < 8; ++i) ss += f[i] * f[i];
            const float r = 1.f / sqrtf(wave_sum(ss) * (1.f / 512.f) + LN_EPS);
            const float* gp = (hf ? gl : ga) + 8 * F.lane;
            const f32x4 g0 = *(const GAS f32x4*)gp, g1 = *(const GAS f32x4*)(gp + 4);
            v4u o; o.x = cvtpk(f[0] * r * g0[0], f[1] * r * g0[1]); o.y = cvtpk(f[2] * r * g0[2], f[3] * r * g0[3]);
            o.z = cvtpk(f[4] * r * g1[0], f[5] * r * g1[1]); o.w = cvtpk(f[6] * r * g1[2], f[7] * r * g1[3]);
#ifdef ZERO_HALF
            if (hf == ZERO_HALF) { o.x = 0u; o.y = 0u; o.z = 0u; o.w = 0u; }
#endif
            *(GAS v4u*)p = o;
        }
    }
}
__device__ __forceinline__ void sincos_rev(float ang, float& s, float& c) {
    double rev = (double)ang * 0.15915494309189535; rev -= __builtin_rint(rev);
    const float fr = (float)rev; s = __builtin_amdgcn_sinf(fr); c = __builtin_amdgcn_cosf(fr);
}
__device__ __forceinline__ void rope_rows(Frame& F, const int* pos) {
    const int gw = F.vcu * NWAVES + F.wave, NGW = F.G * NWAVES, lane = F.lane;
    const float inva = ROPE_INV[lane], invi = ROPE_INV[2 * (lane & 31)];
    for (int m = gw; m < MTOK; m += NGW) {
        const float fpos = (float)pos[m];
        float sa, ca, si, ci; sincos_rev(fpos * inva, sa, ca); sincos_rev(fpos * invi, si, ci);
        bf16* prow = F.P + (size_t)m * INP;
#pragma unroll
        for (int hh = 0; hh < 8; ++hh) {
            bf16* p = prow + hh * 128 + lane;
            const float x1 = bf2f(p[0]), x2 = bf2f(p[64]);
            p[0] = (bf16)f2bf(x1 * ca - x2 * sa); p[64] = (bf16)f2bf(x2 * ca + x1 * sa);
        }
        const int i = lane & 31, h2 = lane >> 5;
#pragma unroll
        for (int j = 0; j < 4; ++j) {
            bf16* p = prow + CQI + (2 * j + h2) * 64 + i;
            const float x1 = bf2f(p[0]), x2 = bf2f(p[32]);
            p[0] = (bf16)f2bf(x1 * ci - x2 * si); p[32] = (bf16)f2bf(x2 * ci + x1 * si);
        }
        if (lane < 32) {
            const float x1 = bf2f(prow[CKI + i]), x2 = bf2f(prow[CKI + 32 + i]);
            F.KI[(size_t)m * 64 + i] = (bf16)f2bf(x1 * ci - x2 * si); F.KI[(size_t)m * 64 + 32 + i] = (bf16)f2bf(x2 * ci + x1 * si);
        }
        if (lane < 8) F.WI[(size_t)m * 8 + lane] = bf2f(prow[CWI + lane]) * 0.35355339059327373f;
    }
}

__device__ __forceinline__ void idx_phase(Frame& F, int l) {
    const int lane = F.lane, wid = F.wave, r32 = lane & 31, hi = lane >> 5;
    LAS float* SC = (LAS float*)F.lds;
    const float NEG = -__builtin_inff();
    for (int L = F.vcu; L < BATCH * (SEQ / 8); L += F.G) {
        const int b = L >> 9, xx = L & 511, tb = xx < 256 ? xx : 767 - xx;
        const int t0 = tb * 8; const size_t row0 = (size_t)b * SEQ + t0;
        bf16x8 af[2][4];
        {
            const int tq = 2 * ((r32 >> 2) & 1) + (r32 >> 4), hh = ((r32 >> 3) & 1) * 4 + (r32 & 3);
#pragma unroll
            for (int m = 0; m < 2; ++m) { const bf16* q = F.P + (row0 + 4 * m + tq) * INP + CQI + hh * 64 + 8 * hi;
#pragma unroll
                for (int ks = 0; ks < 4; ++ks) af[m][ks] = *(const GAS bf16x8*)(q + 16 * ks); }
        }
        LAS float* WGL = SC + 4096;
        if (F.tid < 64) WGL[F.tid] = F.WI[row0 * 8 + F.tid];
        __syncthreads();
        const int nch = ((t0 + 7) >> 8) + 1;
        float keys[64];
#pragma unroll
        for (int j = 0; j < 64; ++j) keys[j] = NEG;
#pragma unroll
        for (int ch = 0; ch < 16; ++ch) {
            if (ch < nch) {
                const int s0 = 256 * ch + 32 * wid;
                LAS float* scb = SC + (ch & 1) * 2048;
                float sc4[2][2];
                if (s0 <= t0 + 7) {
                    const bf16* kp = F.KI + ((size_t)b * SEQ + s0 + r32) * 64 + 8 * hi;
                    bf16x8 kb[4];
#pragma unroll
                    for (int ks = 0; ks < 4; ++ks) kb[ks] = *(const GAS bf16x8*)(kp + 16 * ks);
#pragma unroll
                    for (int m = 0; m < 2; ++m) { f32x16 acc = f32x16{};
#pragma unroll
                        for (int ks = 0; ks < 4; ++ks) acc = __builtin_amdgcn_mfma_f32_32x32x16_bf16(af[m][ks], kb[ks], acc, 0, 0, 0);
#pragma unroll
                        for (int ts = 0; ts < 2; ++ts) { float s = 0.f;
                            const f32x4 wa = *(const LAS f32x4*)(WGL + (4 * m + 2 * hi + ts) * 8), wb = *(const LAS f32x4*)(WGL + (4 * m + 2 * hi + ts) * 8 + 4);
#pragma unroll
                            for (int j = 0; j < 4; ++j) { s += wa[j] * fmaxf(acc[ts * 8 + j], 0.f); s += wb[j] * fmaxf(acc[ts * 8 + 4 + j], 0.f); }
                            const int t = t0 + 4 * m + 2 * hi + ts;
                            sc4[m][ts] = (s0 + r32 <= t) ? s : NEG; } }
                } else { sc4[0][0] = NEG; sc4[0][1] = NEG; sc4[1][0] = NEG; sc4[1][1] = NEG; }
#pragma unroll
                for (int m = 0; m < 2; ++m)
#pragma unroll
                    for (int ts = 0; ts < 2; ++ts) scb[(4 * m + 2 * hi + ts) * 256 + 32 * wid + r32] = sc4[m][ts];
                __syncthreads();
#pragma unroll
                for (int i = 0; i < 4; ++i) keys[4 * ch + i] = scb[wid * 256 + 64 * i + lane];
            }
        }
        const int t = t0 + wid, nj = (t >> 6) + 1;
        float theta = NEG;
        if (t >= TOPK) {
            float mx = NEG, mn = __builtin_inff();
#pragma unroll
            for (int g8 = 0; g8 < 8; ++g8) if (8 * g8 < nj) {
#pragma unroll
                for (int j = 8 * g8; j < 8 * g8 + 8; ++j) { mx = fmaxf(mx, keys[j]); mn = fminf(mn, keys[j] == NEG ? __builtin_inff() : keys[j]); } }
            mx = wave_max(mx); mn = wave_min(mn);
#define IDX_COUNT(th, out) do { int c_ = 0; _Pragma("unroll") for (int g8 = 0; g8 < 8; ++g8) { if (8 * g8 < nj) { _Pragma("unroll") for (int j = 8 * g8; j < 8 * g8 + 8; ++j) c_ += __builtin_popcountll(__builtin_amdgcn_ballot_w64(keys[j] > (th))); } __builtin_amdgcn_sched_barrier(0); } out = c_; } while (0)
            float lo = mn, hiv = mx; int clo, chi = 0;
            IDX_COUNT(lo, clo);
            if (clo <= TOPK) { theta = (clo == TOPK) ? lo : NEG; }
            else {
                theta = lo;
                for (int it = 0; it < 96; ++it) {
                    float mid;
                    if ((it & 1) == 0) { mid = lo + (hiv - lo) * ((float)(clo - TOPK) / (float)(clo - chi)); if (!(mid > lo && mid < hiv)) mid = 0.5f * (lo + hiv); }
                    else mid = 0.5f * (lo + hiv);
                    if (!(mid > lo && mid < hiv)) break;
                    int cm; IDX_COUNT(mid, cm);
                    if (cm == TOPK) { theta = mid; break; }
                    if (cm > TOPK) { lo = mid; clo = cm; theta = mid; } else { hiv = mid; chi = cm; }
                }
            }
#undef IDX_COUNT
        }
        unsigned w0 = 0u, w1 = 0u;
#pragma unroll
        for (int g8 = 0; g8 < 8; ++g8) { if (8 * g8 < nj) {
#pragma unroll
            for (int j = 8 * g8; j < 8 * g8 + 8; ++j) { const unsigned long long bm = __builtin_amdgcn_ballot_w64(keys[j] > theta);
                asm volatile("s_nop 1\n\tv_writelane_b32 %0, %2, %4\n\tv_writelane_b32 %1, %3, %4" : "+v"(w0), "+v"(w1) : "s"((unsigned)bm), "s"((unsigned)(bm >> 32)), "i"(j)); } }
            __builtin_amdgcn_sched_barrier(0); }
        u32x2 wv; wv.x = w0; wv.y = w1;
        *(GAS u32x2*)(F.MASK + ((size_t)b * SEQ + t) * (SEQ / 32) + 2 * lane) = wv;
        __syncthreads();
    }
}

template <bool PASSB>
__device__ __forceinline__ void lru_phase(Frame& F, const Args& a, int l) {
    const int lane = F.lane, wid = F.wave, r32 = lane & 31, hi = lane >> 5, c = wid * 64 + lane;
    LAS unsigned char* xt = F.lds + 36864 + wid * 4608;
    const bf16* GT = F.GATE + (size_t)l * 2 * LBLK * 64 * 64;
    for (int u = F.vcu; u < BATCH * NLCH; u += F.G) {
        const int b = u / NLCH, chunk = u % NLCH;
        const float cw0 = a.conv_w[((size_t)l * 4 + 0) * LW + c], cw1 = a.conv_w[((size_t)l * 4 + 1) * LW + c], cw2 = a.conv_w[((size_t)l * 4 + 2) * LW + c], cw3 = a.conv_w[((size_t)l * 4 + 3) * LW + c];
        const float cb = a.conv_b[(size_t)l * LW + c], ba = a.bga[(size_t)l * LW + c], bx = a.bgx[(size_t)l * LW + c];
        float sp8;
        { const float xl = -a.lam[(size_t)l * LW + c], ax = fabsf(xl), e = __builtin_amdgcn_exp2f(-ax * LOG2E);
          const float l1p = (e < 0.01f) ? e * (1.f - e * (0.5f - e * (0.33333333f - 0.25f * e))) : __builtin_amdgcn_logf(1.f + e) * 0.6931471805599453f;
          sp8 = 8.0f * (fmaxf(xl, 0.f) + l1p) * LOG2E; }
        const int tbase = chunk * LCH; const size_t rowb = (size_t)b * SEQ;
        float h = 0.f, pp = 1.f;
        if (PASSB) { for (int k = 0; k < chunk; ++k) { const float* cp = F.CARRY + (((size_t)b * NLCH + k) * LW + c) * 2; const float pk = cp[0], hk = cp[1]; h = pk * h + hk; } }
        float xm3 = 0.f, xm2 = 0.f, xm1 = 0.f;
        if (tbase > 0) { xm3 = bf2f(F.P[(rowb + tbase - 3) * INP + CXR + c]); xm2 = bf2f(F.P[(rowb + tbase - 2) * INP + CXR + c]); xm1 = bf2f(F.P[(rowb + tbase - 1) * INP + CXR + c]); }
        for (int tt = 0; tt < LCH / 32; ++tt) {
            const int t0 = tbase + 32 * tt;
            float xc[32];
            {
                float xv[32];
#pragma unroll
                for (int i = 0; i < 32; ++i) xv[i] = bf2f(F.P[(rowb + t0 + i) * INP + CXR + c]);
#pragma unroll
                for (int i = 0; i < 32; ++i) { const float a3 = (i >= 3) ? xv[i - 3] : (i == 0 ? xm3 : (i == 1 ? xm2 : xm1));
                    const float a2 = (i >= 2) ? xv[i - 2] : (i == 0 ? xm2 : xm1); const float a1 = (i >= 1) ? xv[i - 1] : xm1;
                    xc[i] = cb + cw0 * a3 + cw1 * a2 + cw2 * a1 + cw3 * xv[i]; }
                xm3 = xv[29]; xm2 = xv[30]; xm1 = xv[31];
            }
#pragma unroll
            for (int i = 0; i < 32; ++i) *(LAS unsigned short*)(xt + i * 144 + lane * 2) = (unsigned short)f2bf(xc[i]);
            LDS_WAIT();
            bf16x8 xa[4];
#pragma unroll
            for (int ks = 0; ks < 4; ++ks) xa[ks] = *(const LAS bf16x8*)(xt + r32 * 144 + (16 * ks + 8 * hi) * 2);
            LDS_WAIT();
            f32x16 C[2][2];
#pragma unroll
            for (int g = 0; g < 2; ++g) {
                bf16x8 gf[2][4];
#pragma unroll
                for (int dt = 0; dt < 2; ++dt)
#pragma unroll
                    for (int ks = 0; ks < 4; ++ks) gf[dt][ks] = *(const GAS bf16x8*)(GT + (((size_t)g * LBLK + wid) * 64 + 32 * dt + r32) * 64 + 16 * ks + 8 * hi);
#pragma unroll
                for (int dt = 0; dt < 2; ++dt) { C[g][dt] = f32x16{};
#pragma unroll
                    for (int ks = 0; ks < 4; ++ks) C[g][dt] = __builtin_amdgcn_mfma_f32_32x32x16_bf16(xa[ks], gf[dt][ks], C[g][dt], 0, 0, 0); }
                asm volatile("" ::: "memory");
            }
#pragma unroll
            for (int g = 0; g < 2; ++g)
#pragma unroll
                for (int i = 0; i < 16; ++i) { auto rr = __builtin_amdgcn_permlane32_swap(__float_as_uint(C[g][0][i]), __float_as_uint(C[g][1][i]), false, false);
                    C[g][0][i] = __uint_as_float(rr[0]); C[g][1][i] = __uint_as_float(rr[1]); }
#pragma unroll
            for (int q8 = 0; q8 < 4; ++q8) {
                float yv[8];
                if (PASSB) {
#pragma unroll
                    for (int e = 0; e < 8; ++e) yv[e] = bf2f(F.P[(rowb + t0 + 8 * q8 + e) * INP + CYG + c]);
                }
#pragma unroll
                for (int e = 0; e < 8; ++e) {
                    const int t = 8 * q8 + e, grp = e >> 2, i = 4 * q8 + (e & 3);
                    const float ra = sigmoidf_fast(C[0][grp][i] + ba), ix = sigmoidf_fast(C[1][grp][i] + bx);
                    const float av = __builtin_amdgcn_exp2f(-ra * sp8);
                    const float uu = __builtin_amdgcn_sqrtf(fmaxf(1.f - av * av, 0.f)) * ix * xc[t];
                    h = av * h + uu; pp *= av;
                    if (PASSB) { const float y = yv[e], z = 0.7978845608028654f * (y + 0.044715f * y * y * y);
                        const float o = h * y * sigmoidf_fast(2.f * z);
                        F.MG[(rowb + t0 + t) * DMODEL + AW + c] = (bf16)f2bf(o); }
                }
            }
        }
        if (!PASSB) { float* cp = F.CARRY + (((size_t)b * NLCH + chunk) * LW + c) * 2; cp[0] = pp; cp[1] = h; }
    }
}

__device__ __forceinline__ att::BlockRef att_ref(int bh, int qb) {
    const int b = bh / NHEAD, h = bh % NHEAD; att::BlockRef r;
    const unsigned row = (unsigned)(b * SEQ + qb * att::QB), row0 = (unsigned)(b * SEQ);
#define UNI_(v) ((unsigned)__builtin_amdgcn_readfirstlane((int)(v)))
    r.q = UNI_((row * INP + CQ + h * HD) * 2u); r.k = UNI_((row0 * INP + CK + h * HD) * 2u); r.v = UNI_((row0 * INP + CV + h * HD) * 2u);
    r.o = UNI_((row * DMODEL + h * HD) * 2u); r.mk = UNI_(row * (SEQ / 32) * 4u); r.P0 = __builtin_amdgcn_readfirstlane(qb * att::QB);
#undef UNI_
    return r;
}
__device__ __forceinline__ void attn_phase(Frame& F, char* lds) {
    constexpr int NQB = SEQ / att::QB, NX = NQB / 2, TOTAL = BATCH * NHEAD * NX;
    int L = F.vcu; if (L >= TOTAL) return;
    int bh = L / NX, x = L % NX, pass = 0;
    att::Bases B; B.P = (const char*)att::uni(F.P); B.MG = (char*)att::uni(F.MG); B.MK = (const char*)att::uni(F.MASK);
    att::BlockRef cur = att_ref(bh, x);
    att::Seam S;
    att::prime(B, cur, lds, S);
    for (;;) {
        const bool more_pass = pass == 0, more_item = L + F.G < TOTAL, last = !more_pass && !more_item;
        int bhn = bh, xn = x, passn = pass + 1, Ln = L;
        if (!more_pass) { passn = 0; Ln = more_item ? L + F.G : L; bhn = Ln / NX; xn = Ln % NX; }
        const att::BlockRef nxt = last ? cur : att_ref(bhn, passn ? NQB - 1 - xn : xn);
        att::block(B, cur, nxt, lds, S);
        if (last) break;
        cur = nxt; bh = bhn; x = xn; pass = passn; L = Ln;
    }
}

#ifdef PROBE_STOP
__device__ __forceinline__ void probe_idx(Frame& F, float* slot) {
    const int lane = F.lane, gw = F.vcu * NWAVES + F.wave;
    LAS float* sc = (LAS float*)(F.lds + F.wave * 16384);
    if (gw >= 128) return;
    const int b = gw & 7, t = (gw >> 3) * 257 + 200;
    if (t >= SEQ) return;
    const size_t row = (size_t)b * SEQ + t;
    float wq[8];
#pragma unroll
    for (int h = 0; h < 8; ++h) wq[h] = F.WI[row * 8 + h];
    for (int s0 = 0; s0 <= t; s0 += 64) {
        const int s = s0 + lane; float score = -__builtin_inff();
        if (s <= t) { score = 0.f;
            for (int h = 0; h < 8; ++h) { float d = 0.f;
                for (int k = 0; k < 64; ++k) d += bf2f(F.P[row * INP + CQI + h * 64 + k]) * bf2f(F.KI[((size_t)b * SEQ + s) * 64 + k]);
                score += wq[h] * fmaxf(d, 0.f); } }
        sc[s] = score;
    }
    for (int s = ((t >> 6) + 1) * 64 + lane; s < SEQ; s += 64) sc[s] = -__builtin_inff();
    LDS_WAIT(); asm volatile("" ::: "memory");
    float mism = 0.f;
    for (int s0 = 0; s0 <= t; s0 += 64) {
        const int s = s0 + lane; const float mine = sc[s]; int rank = 0;
        for (int j = 0; j <= t; ++j) { const float o = sc[j]; rank += (o > mine || (o == mine && j < s)) ? 1 : 0; }
        const bool want = (s <= t) && (t < TOPK || rank < TOPK);
        const unsigned w = F.MASK[row * 128 + (s >> 5)]; const bool got = (w >> (s & 31)) & 1u;
        if (want != got) mism += 1.f;
    }
    mism = wave_sum(mism);
    if (lane == 0) { atomicAdd(slot, mism); atomicAdd(slot + 1, (float)(t + 1 < TOPK ? t + 1 : TOPK)); }
}
__device__ __forceinline__ void probe_attn(Frame& F, float* slot) {
    const int lane = F.lane, gw = F.vcu * NWAVES + F.wave;
    LAS float* pw = (LAS float*)(F.lds + F.wave * 16384);
    if (gw >= 256) return;
    const int b = gw & 7, h = (gw >> 3) & 3, t = (gw >> 5) * 509 + 300;
    if (t >= SEQ) return;
    const size_t row = (size_t)b * SEQ + t;
    float mx = -__builtin_inff();
    for (int s0 = 0; s0 <= t; s0 += 64) { const int s = s0 + lane; float sv = -__builtin_inff();
#ifdef ATT_NOMASK
        if (s <= t) { float d = 0.f;
#else
        if (s <= t && ((F.MASK[row * 128 + (s >> 5)] >> (s & 31)) & 1u)) { float d = 0.f;
#endif
            for (int k = 0; k < 128; ++k) d += bf2f(F.P[row * INP + CQ + h * 128 + k]) * bf2f(F.P[((size_t)b * SEQ + s) * INP + CK + h * 128 + k]);
            sv = d * 0.08838834764831845f; }
        pw[s] = sv; mx = fmaxf(mx, sv); }
    mx = wave_max(mx);
    float sum = 0.f;
    for (int s0 = 0; s0 <= t; s0 += 64) { const int s = s0 + lane; const float e = __expf(pw[s] - mx); pw[s] = e; sum += e; }
    sum = wave_sum(sum);
    LDS_WAIT(); asm volatile("" ::: "memory");
    float o0 = 0.f, o1 = 0.f;
    for (int s = 0; s <= t; ++s) { const float p = pw[s]; if (p != 0.f) { o0 += p * bf2f(F.P[((size_t)b * SEQ + s) * INP + CV + h * 128 + lane]); o1 += p * bf2f(F.P[((size_t)b * SEQ + s) * INP + CV + h * 128 + 64 + lane]); } }
    o0 /= sum; o1 /= sum;
    const float g0 = bf2f(F.MG[row * DMODEL + h * 128 + lane]), g1 = bf2f(F.MG[row * DMODEL + h * 128 + 64 + lane]);
    float num = (g0 - o0) * (g0 - o0) + (g1 - o1) * (g1 - o1), den = o0 * o0 + o1 * o1;
    num = wave_sum(num); den = wave_sum(den);
    if (lane == 0) { atomicAdd(slot, num); atomicAdd(slot + 1, den); }
}
__device__ __forceinline__ void probe_lru(Frame& F, const Args& a, int l, float* slot) {
    const int lane = F.lane;
    if (F.wave >= 4 || F.vcu >= 16) return;
    const int u = F.vcu * 4 + F.wave, b = u >> 3, n = u & 7, c = n * 64 + lane;
    LAS float* W = (LAS float*)(F.lds + F.wave * 33024);
    LAS float* xs = W + 8192;
    for (int i = lane; i < 4096; i += 64) { W[i] = a.wga[((size_t)l * LBLK + n) * 4096 + i]; W[4096 + i] = a.wgx[((size_t)l * LBLK + n) * 4096 + i]; }
    LDS_WAIT(); asm volatile("" ::: "memory");
    const float cw0 = a.conv_w[((size_t)l * 4 + 0) * LW + c], cw1 = a.conv_w[((size_t)l * 4 + 1) * LW + c], cw2 = a.conv_w[((size_t)l * 4 + 2) * LW + c], cw3 = a.conv_w[((size_t)l * 4 + 3) * LW + c];
    const float cb = a.conv_b[(size_t)l * LW + c], ba = a.bga[(size_t)l * LW + c], bx = a.bgx[(size_t)l * LW + c], lam = a.lam[(size_t)l * LW + c];
    const float sp = log1pf(expf(-lam));
    float x3 = 0.f, x2 = 0.f, x1 = 0.f, h = 0.f, num = 0.f, den = 0.f;
    for (int t = 0; t < SEQ; ++t) {
        const size_t row = (size_t)b * SEQ + t;
        const float x0 = bf2f(F.P[row * INP + CXR + c]);
        const float xc = cb + cw0 * x3 + cw1 * x2 + cw2 * x1 + cw3 * x0; x3 = x2; x2 = x1; x1 = x0;
        xs[lane] = xc; LDS_WAIT(); asm volatile("" ::: "memory");
        float za = ba, zx = bx;
        for (int k = 0; k < 64; ++k) { const float xv = xs[k]; za += xv * W[k * 64 + lane]; zx += xv * W[4096 + k * 64 + lane]; }
        LDS_WAIT(); asm volatile("" ::: "memory");
        const float r = 1.f / (1.f + expf(-za)), ii = 1.f / (1.f + expf(-zx));
        const float la = -8.0f * r * sp, av = expf(la);
        h = av * h + sqrtf(fmaxf(-expm1f(2.f * la), 0.f)) * (ii * xc);
        const float y = bf2f(F.P[row * INP + CYG + c]);
        const float want = h * 0.5f * y * (1.f + tanhf(0.7978845608028654f * (y + 0.044715f * y * y * y)));
        const float got = bf2f(F.MG[row * DMODEL + AW + c]);
        num += (got - want) * (got - want); den += want * want;
    }
    num = wave_sum(num); den = wave_sum(den);
    if (lane == 0) { atomicAdd(slot, num); atomicAdd(slot + 1, den); }
}
__device__ __forceinline__ void probe_gemm(Frame& F, const bf16* A, const bf16* Bt, const bf16* O, int N, int K, int ldo, int act, float* slot) {
    const int gt = F.vcu * NTHR + F.tid; if (gt >= 65536) return;
    const unsigned hsh = (unsigned)gt * 2654435761u; const int m = (int)(hsh % (unsigned)MTOK), n = (int)((hsh >> 7) % (unsigned)N);
    float d = 0.f; for (int k = 0; k < K; ++k) d += bf2f(A[(size_t)m * K + k]) * bf2f(Bt[(size_t)n * K + k]);
    if (act == 1) { d = fmaxf(d, 0.f); d = d * d; }
    const float got = bf2f(O[(size_t)m * ldo + n]);
    float num = (got - d) * (got - d), den = d * d; num = wave_sum(num); den = wave_sum(den);
    if (F.lane == 0) { atomicAdd(slot, num); atomicAdd(slot + 1, den); }
}
#endif

#ifndef MK_N_LAUNCHES
#define MK_N_LAUNCHES 1
#endif
constexpr int PH_PER_LAYER = 11, N_PHASES = 1 + DEPTH * PH_PER_LAYER;
constexpr bool ONE_LAUNCH = (MK_N_LAUNCHES == 1);

typedef const Args __attribute__((address_space(4)))* KArgs;
template <class T> __device__ __forceinline__ T* glob(T* p) { return (T*)(GAS T*)p; }
__device__ __forceinline__ Args load_args(KArgs k) {
    Args a = *(const Args*)k;
    a.x = glob(a.x); a.c = glob(a.c); a.pos = glob(a.pos); a.w_mod = glob(a.w_mod); a.b_mod = glob(a.b_mod); a.w_in = glob(a.w_in); a.conv_w = glob(a.conv_w); a.conv_b = glob(a.conv_b);
    a.wga = glob(a.wga); a.bga = glob(a.bga); a.wgx = glob(a.wgx); a.bgx = glob(a.bgx); a.lam = glob(a.lam); a.g_attn = glob(a.g_attn); a.g_lru = glob(a.g_lru); a.w_out = glob(a.w_out);
    a.ln1_g = glob(a.ln1_g); a.ln1_b = glob(a.ln1_b); a.w_up = glob(a.w_up); a.w_down = glob(a.w_down); a.ln2_g = glob(a.ln2_g); a.ln2_b = glob(a.ln2_b); a.out = glob(a.out); a.ws = glob(a.ws);
    return a;
}

__global__ void __launch_bounds__(NTHR, 2) fwd_kernel(Args a) {
    extern __shared__ __attribute__((aligned(16))) unsigned char lds[];
    Frame F;
    F.lds = (LAS unsigned char*)lds;
    F.tid = threadIdx.x; F.lane = F.tid & 63; F.wave = __builtin_amdgcn_readfirstlane(F.tid >> 6);
    F.G = gridDim.x; { const int bx = blockIdx.x; F.vcu = (F.G % 8 == 0) ? (bx % 8) * (F.G / 8) + bx / 8 : bx; }
    F.ctl = (gu32*)(a.ws + WS_CTL);
#define REPIN() int t_ = threadIdx.x; KArgs ka_ = (KArgs)__builtin_amdgcn_kernarg_segment_ptr(); asm volatile("" : "+v"(t_), "+s"(ka_)); \
        const Args a = load_args(ka_);   \
        unsigned char* ws_ = a.ws; \
        F.tid = t_; F.lane = t_ & 63; F.wave = __builtin_amdgcn_readfirstlane(t_ >> 6); \
        F.MODV = (float*)(ws_ + WS_MOD); F.GATE = (bf16*)(ws_ + WS_GATE); F.CARRY = (float*)(ws_ + WS_CARRY); F.WI = (float*)(ws_ + WS_WI); F.KI = (bf16*)(ws_ + WS_KI); \
        F.MASK = (unsigned*)(ws_ + WS_MASK); F.WIN = (bf16*)(ws_ + WS_WIN); F.WOUT = (bf16*)(ws_ + WS_WOUT); F.WUP = (bf16*)(ws_ + WS_WUP); F.WDN = (bf16*)(ws_ + WS_WDN); \
        F.HA = (bf16*)(ws_ + WS_HA); F.P = (bf16*)(ws_ + WS_P); F.MG = (bf16*)(ws_ + WS_MG); F.HID = (bf16*)(ws_ + WS_HID)
    F.tid = threadIdx.x; F.lane = F.tid & 63; F.wave = __builtin_amdgcn_readfirstlane(F.tid >> 6);
    volatile LAS unsigned* MISC = (volatile LAS unsigned*)(F.lds + MISC_OFF);
    for (int u = F.tid; u < (LDS_BYTES - LDSCTL_OFF) / 4; u += NTHR) ((LAS unsigned*)(F.lds + LDSCTL_OFF))[u] = 0u;
    __syncthreads();
    XcdBarrier bar; bar.bar = (unsigned*)(F.ctl + CW_BAR); bar.x = 0; bar.st = nullptr;
    if (ONE_LAUNCH) bar = xcd_barrier_post((unsigned*)(F.ctl + CW_BAR), MISC + 8);
    const int lo = a.ph_lo, hi = a.ph_hi;
#define IN(k) (lo <= (k) && (k) < hi)
#define SEAM(k) do { if (ONE_LAUNCH && IN(k) && IN((k) + 1)) xcd_barrier(bar); } while (0)

    #ifndef SKIP_P0
    if (IN(0)) { REPIN(); p0_prologue(F, a); SEAM(0); }
#endif

    for (int l = 0; l < DEPTH; ++l) {
        const int pb = 1 + l * PH_PER_LAYER;
#define modl (F.MODV + (size_t)l * BATCH * MODW)
#ifndef SKIP_ROWS
        if (IN(pb + 0) && l == 0) { REPIN(); modulate_rows(F, a.x, modl, 0 * DMODEL, 1 * DMODEL); SEAM(pb + 0); }
#endif
#if !defined(SKIP_GEMM) && !defined(SKIP_G1)
        if (IN(pb + 1)) {
            REPIN();
            pg8::Gemm g{F.HA, F.WIN + (size_t)l * INP * DMODEL, MTOK, INP, DMODEL}; pg8::StaticOrder S; S.init(MTOK, INP, F.G, (int)blockIdx.x);
            pg8::EpiOutBf16<0> E{F.P, INP};
            pg8::gemm_phase<pg8::EpiOutBf16<0>, pg8::StaticOrder, true, true>(F.lds, g, S, E);
            SEAM(pb + 1);
        }
#endif
#ifndef SKIP_ROWS
        if (IN(pb + 2)) { REPIN(); rope_rows(F, a.pos); SEAM(pb + 2); }
#endif
        if (IN(pb + 3)) {
#ifndef SKIP_IDX
            { REPIN(); idx_phase(F, l); } __syncthreads();
#endif
#ifndef SKIP_LRU
            { REPIN(); lru_phase<false>(F, a, l); }
#endif
            SEAM(pb + 3); }
        if (IN(pb + 4)) {
#ifndef SKIP_ATT
            { REPIN(); attn_phase(F, (char*)lds); } __syncthreads();
#endif
#ifndef SKIP_LRU
            { REPIN(); lru_phase<true>(F, a, l); }
#endif
            SEAM(pb + 4); }
#ifndef SKIP_ROWS
        if (IN(pb + 5)) { REPIN(); rms_rows(F, a.g_attn + (size_t)l * AW, a.g_lru + (size_t)l * LW); SEAM(pb + 5); }
#endif
#if !defined(SKIP_GEMM) && !defined(SKIP_G6)
        if (IN(pb + 6)) {
            REPIN();
            pg8::Gemm g{F.MG, F.WOUT + (size_t)l * DMODEL * DMODEL, MTOK, DMODEL, DMODEL}; pg8::StaticOrder S; S.init(MTOK, DMODEL, F.G, (int)blockIdx.x);
            const float* xsrc = (l == 0) ? a.x : a.out;
            pg8::EpiResid E{xsrc, a.out, DMODEL, modl + 2 * DMODEL, MODW, SEQ, ALPHA};
            pg8::gemm_phase<pg8::EpiResid, pg8::StaticOrder, true, true>(F.lds, g, S, E);
            SEAM(pb + 6);
        }
#endif
#ifndef SKIP_ROWS
        if (IN(pb + 7)) { REPIN(); ln_rows(F, a.out, a.ln1_g + (size_t)l * DMODEL, a.ln1_b + (size_t)l * DMODEL, modl, 3 * DMODEL, 4 * DMODEL); SEAM(pb + 7); }
#endif
#if !defined(SKIP_GEMM) && !defined(SKIP_G8)
        if (IN(pb + 8)) {
            REPIN();
            pg8::Gemm g{F.HA, F.WUP + (size_t)l * FF * DMODEL, MTOK, FF, DMODEL}; pg8::StaticOrder S; S.init(MTOK, FF, F.G, (int)blockIdx.x);
            pg8::EpiOutBf16<1> E{F.HID, FF};
            pg8::gemm_phase<pg8::EpiOutBf16<1>, pg8::StaticOrder, true, true>(F.lds, g, S, E);
            SEAM(pb + 8);
        }
#endif
#if !defined(SKIP_GEMM) && !defined(SKIP_G9)
        if (IN(pb + 9)) {
            REPIN();
            pg8::Gemm g{F.HID, F.WDN + (size_t)l * DMODEL * FF, MTOK, DMODEL, FF}; pg8::StaticOrder S; S.init(MTOK, DMODEL, F.G, (int)blockIdx.x);
            pg8::EpiResid E{a.out, a.out, DMODEL, modl + 5 * DMODEL, MODW, SEQ, ALPHA};
            pg8::gemm_phase<pg8::EpiResid, pg8::StaticOrder, true, true>(F.lds, g, S, E);
            SEAM(pb + 9);
        }
#endif
#ifndef SKIP_ROWS
        if (IN(pb + 10)) {
            REPIN();
            const float* modn = (l + 1 < DEPTH) ? F.MODV + (size_t)(l + 1) * BATCH * MODW : nullptr;
            ln_rows(F, a.out, a.ln2_g + (size_t)l * DMODEL, a.ln2_b + (size_t)l * DMODEL, modn, 0 * DMODEL, 1 * DMODEL);
            SEAM(pb + 10);
        }
#endif
    }
#ifdef PROBE_STOP
    if (IN(N_PHASES)) {
        REPIN();
        const size_t gt = (size_t)F.vcu * NTHR + F.tid, gs = (size_t)F.G * NTHR;
        const size_t NA = (size_t)MTOK * 128, NB = (size_t)BATCH * NLCH * LW * 2, NT_ = (size_t)MTOK * DMODEL;
        for (size_t i = gt; i < NT_; i += gs) {
            float v;
            if (PROBE_KIND == 0) {
                if (i < 2 * NA) { const unsigned w = F.MASK[i >> 1]; v = (float)((i & 1) ? (w >> 16) : (w & 0xffffu)); }
                else if (i < 2 * NA + NB) v = F.CARRY[i - 2 * NA];
                else v = bf2f(F.P[i - 2 * NA - NB]);
            } else if (PROBE_KIND == 1) { v = bf2f(F.MG[i]); }
            else if (PROBE_KIND == 2) { v = bf2f(F.HA[i]); }
            else { v = bf2f(F.P[i]); }
            a.out[i] = v;
        }
    }
    if (IN(N_PHASES + 1)) {
        REPIN();
        float* slot = (float*)(a.ws + WS_CTL) + 8;
        const int gw = F.vcu * NWAVES + F.wave, NGW = F.G * NWAVES;
        if (PROBE_KIND == 10) {
            float bad = 0.f;
            for (int m = gw; m < MTOK; m += NGW) { const int t = m % SEQ;
                const unsigned w0 = F.MASK[(size_t)m * 128 + 2 * F.lane], w1 = F.MASK[(size_t)m * 128 + 2 * F.lane + 1];
                int pc = __builtin_popcount(w0) + __builtin_popcount(w1); int beyond = 0;
#pragma unroll
                for (int bb = 0; bb < 64; ++bb) { const int s = 64 * F.lane + bb; const unsigned bit = bb < 32 ? (w0 >> bb) & 1u : (w1 >> (bb - 32)) & 1u; if (bit && s > t) beyond = 1; }
#pragma unroll
                for (int o = 1; o < 64; o <<= 1) { pc += __shfl_xor(pc, o); beyond |= __shfl_xor(beyond, o); }
                const int want = t + 1 < TOPK ? t + 1 : TOPK;
                if (pc != want || beyond) bad += 1.f; }
            if (F.lane == 0 && bad > 0.f) atomicAdd(slot, bad * (1.0f / MTOK));
        }
        if (PROBE_KIND == 11) probe_idx(F, slot);
        if (PROBE_KIND == 12) probe_attn(F, slot);
        if (PROBE_KIND == 13) probe_lru(F, a, 0, slot);
        if (PROBE_KIND == 14) probe_gemm(F, F.HA, F.WIN, F.P, INP, DMODEL, INP, 0, slot);
        if (PROBE_KIND == 15) probe_gemm(F, F.HA, F.WUP, F.HID, FF, DMODEL, FF, 1, slot);
    }
    if (IN(N_PHASES + 2)) {
        REPIN();
        const float* sl_ = (const float*)(a.ws + WS_CTL) + 8;
        const float e = (PROBE_KIND == 10) ? sl_[0] : sl_[0] / fmaxf(sl_[1], 1e-30f);
        const float cst = sqrtf(fmaxf(e, 0.f) * 1e6f);
        for (size_t i = (size_t)F.vcu * NTHR + F.tid; i < (size_t)MTOK * DMODEL; i += (size_t)F.G * NTHR) a.out[i] = cst;
    }
#endif
#undef modl
#undef IN
#undef SEAM
#undef REPIN
}

extern "C" void kernel_launch(void* const* d_in, const int* in_sizes, int n_in, void* d_out, int out_size, void* d_ws, size_t ws_size, hipStream_t stream) {
    static int grid = 0;
    if (grid == 0) {
        if (n_in != 22 || in_sizes[0] != MTOK * DMODEL || out_size != MTOK * DMODEL || ws_size < WS_END) {
            fprintf(stderr, "kernel_launch: unexpected shapes (n_in %d, in0 %d, out %d, ws %zu; need ws >= %zu); nothing launched\n", n_in, n_in > 0 ? in_sizes[0] : -1, out_size, ws_size, (size_t)WS_END); grid = -1; return; }
        int dev = 0, cus = 0, per_cu = 0;
        if (hipGetDevice(&dev) != hipSuccess || hipDeviceGetAttribute(&cus, hipDeviceAttributeMultiprocessorCount, dev) != hipSuccess) { fprintf(stderr, "kernel_launch: device query failed\n"); grid = -1; return; }
        if (hipFuncSetAttribute((const void*)fwd_kernel, hipFuncAttributeMaxDynamicSharedMemorySize, LDS_BYTES) != hipSuccess) { fprintf(stderr, "kernel_launch: hipFuncSetAttribute failed\n"); grid = -1; return; }
        if (hipOccupancyMaxActiveBlocksPerMultiprocessor(&per_cu, (const void*)fwd_kernel, NTHR, LDS_BYTES) != hipSuccess || per_cu < 1)
            fprintf(stderr, "kernel_launch: note: occupancy query reports %d workgroups per CU\n", per_cu);
        (void)hipGetLastError();
        grid = cus;
    }
    if (grid < 0) return;
    if (hipMemsetAsync((char*)d_ws + WS_CTL, 0, CTL_ZERO_BYTES, stream) != hipSuccess) { fprintf(stderr, "kernel_launch: memset failed\n"); return; }
    Args a{};
    a.x = (const float*)d_in[0]; a.c = (const float*)d_in[1]; a.pos = (const int*)d_in[2];
    a.w_mod = (const float*)d_in[3]; a.b_mod = (const float*)d_in[4]; a.w_in = (const float*)d_in[5]; a.conv_w = (const float*)d_in[6]; a.conv_b = (const float*)d_in[7];
    a.wga = (const float*)d_in[8]; a.bga = (const float*)d_in[9]; a.wgx = (const float*)d_in[10]; a.bgx = (const float*)d_in[11]; a.lam = (const float*)d_in[12];
    a.g_attn = (const float*)d_in[13]; a.g_lru = (const float*)d_in[14]; a.w_out = (const float*)d_in[15]; a.ln1_g = (const float*)d_in[16]; a.ln1_b = (const float*)d_in[17];
    a.w_up = (const float*)d_in[18]; a.w_down = (const float*)d_in[19]; a.ln2_g = (const float*)d_in[20]; a.ln2_b = (const float*)d_in[21];
    a.out = (float*)d_out; a.ws = (unsigned char*)d_ws;
    if (ONE_LAUNCH) {
        a.ph_lo = 0; a.ph_hi = N_PHASES;
        hipLaunchKernelGGL(fwd_kernel, dim3(grid), dim3(NTHR), LDS_BYTES, stream, a);
    } else {
#ifdef PROBE_STOP
        const int np_ = PROBE_STOP;
#else
        const int np_ = N_PHASES;
#endif
        for (int p = 0; p < np_; ++p) {
            if (p >= 1 && ((p - 1) % PH_PER_LAYER) == 0 && p != 1) continue;
            a.ph_lo = p; a.ph_hi = p + 1;
            hipLaunchKernelGGL(fwd_kernel, dim3(grid), dim3(NTHR), LDS_BYTES, stream, a);
        }
    }
#ifdef PROBE_STOP
    if (PROBE_KIND < 10) { a.ph_lo = N_PHASES; a.ph_hi = N_PHASES + 1; hipLaunchKernelGGL(fwd_kernel, dim3(grid), dim3(NTHR), LDS_BYTES, stream, a); }
    else { a.ph_lo = N_PHASES + 1; a.ph_hi = N_PHASES + 2; hipLaunchKernelGGL(fwd_kernel, dim3(grid), dim3(NTHR), LDS_BYTES, stream, a);
           a.ph_lo = N_PHASES + 2; a.ph_hi = N_PHASES + 3; hipLaunchKernelGGL(fwd_kernel, dim3(grid), dim3(NTHR), LDS_BYTES, stream, a); }
#endif
    const hipError_t le = hipPeekAtLastError();
    if (le != hipSuccess) fprintf(stderr, "kernel_launch: launch failed: %s\n", hipGetErrorName(le));
}
```

```cpp
#include <hip/hip_runtime.h>
#include <cstdio>
#include <cstdint>
#define MK_N_LAUNCHES 1
namespace pg8 {
#define PG8_LAS __attribute__((address_space(3)))
typedef unsigned short bf16_t;
typedef short bf16x8 __attribute__((ext_vector_type(8)));
typedef float f32x4 __attribute__((ext_vector_type(4)));
typedef unsigned u32x4 __attribute__((ext_vector_type(4)));
constexpr int BM = 256, BK = 64, HALF = 128, HTB = HALF * BK * 2  , STAGE_BYTES = 8 * HTB, NXCD = 8, WGM = 8;

__host__ __device__ __forceinline__ int lds_byte(int r, int c) { const int st = (r >> 4) * 2 + (c >> 5), rr = r & 15, cc = c & 31, ob = rr * 64 + cc * 2; return st * 1024 + (ob ^ (((ob >> 9) & 1) << 5)); }
__host__ __device__ __forceinline__ void stage_rc(int b, int& R, int& C) { const int st = b / 1024, sb = b % 1024, swz = sb ^ (((sb >> 9) & 1) << 5); R = (st >> 1) * 16 + swz / 64; C = (st & 1) * 32 + (swz % 64) / 2; }
__host__ __device__ __forceinline__ int perm32(int rho) { const int n = rho >> 4, i = rho & 15; return 8 * (i >> 2) + 4 * n + (i & 3); }

struct Unit { int pm, pn; };
struct Gemm { const bf16_t* A; const bf16_t* Bt; int M, N, K; };

struct StaticOrder {
    int nM, nN, nwg, G, c;
    __host__ __device__ void init(int M, int N, int G_, int c_) { nM = M / BM; nN = N / BM; nwg = nM * nN; G = G_; c = c_; }
    __host__ __device__ bool next(int i, Unit& u) const {
        const long L = (long)i * G + c; if (L >= nwg) return false;
        int wgid = (int)L; { const int q = nwg / NXCD, r = nwg % NXCD, xcd = wgid % NXCD, off = wgid / NXCD; wgid = (xcd < r ? xcd * (q + 1) : r * (q + 1) + (xcd - r) * q) + off; }
        const int nig = WGM * nN, gid = wgid / nig, fm = gid * WGM, gsz = (nM - fm) < WGM ? (nM - fm) : WGM;
        u.pm = fm + ((wgid % nig) % gsz); u.pn = (wgid % nig) / gsz; return true;
    }
    __device__ __forceinline__ void a_ready(const Unit&) const {}
    __device__ __forceinline__ void done(const Unit&) const {}
};

__device__ __forceinline__ unsigned cvt_pk_bf16(float lo, float hi) { unsigned r; asm volatile("v_cvt_pk_bf16_f32 %0, %1, %2" : "=v"(r) : "v"(lo), "v"(hi)); return r; }
typedef float f32x2 __attribute__((ext_vector_type(2)));

template <int ACT> struct EpiOutBf16 {
    static constexpr bool PERM = true, AFTER_DRAIN = false;
    bf16_t* O; int ldc;
    __device__ __forceinline__ void operator()(const f32x4 (&acc)[2][2][4][2], const Unit& u, int wr, int wc, int fr, int fq) const {
        const int row0 = u.pm * BM + wr * 64 + fr, col0 = u.pn * BM + wc * 32 + 8 * fq;
#pragma unroll
        for (int ai = 0; ai < 2; ++ai)
#pragma unroll
            for (int m = 0; m < 4; ++m) { bf16_t* rowp = O + (size_t)(row0 + ai * HALF + m * 16) * ldc + col0;
#pragma unroll
                for (int bj = 0; bj < 2; ++bj) { f32x4 v0 = acc[ai][bj][m][0], v1 = acc[ai][bj][m][1];
                    if (ACT == 1) {
#pragma unroll
                        for (int j = 0; j < 4; ++j) { const float a0 = fmaxf(v0[j], 0.f), a1 = fmaxf(v1[j], 0.f); v0[j] = a0 * a0; v1[j] = a1 * a1; } }
                    u32x4 w; w.x = cvt_pk_bf16(v0[0], v0[1]); w.y = cvt_pk_bf16(v0[2], v0[3]); w.z = cvt_pk_bf16(v1[0], v1[1]); w.w = cvt_pk_bf16(v1[2], v1[3]);
                    *(u32x4*)(rowp + bj * HALF) = w; } }
    }
};
struct EpiResid {
    static constexpr bool PERM = false, AFTER_DRAIN = false;
    const float* xin; float* out; int ldc; const float* gate; int gate_bstride; int rows_per_batch; float alpha;
    const float* stat; const float* lng; const float* lnb;
    __device__ __forceinline__ void operator()(const f32x4 (&acc)[2][2][4][2], const Unit& u, int wr, int wc, int fr, int fq) const {
        const int row0 = u.pm * BM + wr * 64 + fr, col0 = u.pn * BM + wc * 32 + 4 * fq;
        const float* g = gate + (size_t)((u.pm * BM) / rows_per_batch) * gate_bstride;
#pragma unroll
        for (int bj = 0; bj < 2; ++bj)
#pragma unroll
            for (int n = 0; n < 2; ++n) {
                const int cc = col0 + bj * HALF + n * 16;
                const f32x4 gv = *(const f32x4*)(g + cc) + 1.0f;
                f32x4 lg = {1.f, 1.f, 1.f, 1.f}, lb = {0.f, 0.f, 0.f, 0.f};
                if (stat) { lg = *(const f32x4*)(lng + cc); lb = *(const f32x4*)(lnb + cc); }
#pragma unroll
                for (int ai = 0; ai < 2; ++ai)
#pragma unroll
                    for (int m = 0; m < 4; ++m) { const int row = row0 + ai * HALF + m * 16; const size_t off = (size_t)row * ldc + cc;
                        f32x4 xv = *(const f32x4*)(xin + off);
                        if (stat) { const float mean = stat[2 * row], rstd = stat[2 * row + 1]; xv = (xv - mean) * rstd * lg + lb; }
                        *(f32x4*)(out + off) = xv * alpha + gv * acc[ai][bj][m][n]; }
                asm volatile("" ::: "memory"); }
    }
};
template <class Epi, class Sched, bool ALIGN_EPI = false, bool SP2 = false>
__device__ __forceinline__ void gemm_phase(PG8_LAS unsigned char* lds, const Gemm g, const Sched& S, const Epi& E) {
    int tid_l = threadIdx.x; asm volatile("" : "+v"(tid_l));
    const int tid = tid_l, wid = __builtin_amdgcn_readfirstlane(tid >> 6), lane = tid & 63, wr = wid >> 2, wc = wid & 3, fr = lane & 15, fq = lane >> 4;
    const int K = g.K, nt = K / BK;
    unsigned voffA[2], voffB[2];
#pragma unroll
    for (int i = 0; i < 2; ++i) { int R, C; stage_rc(tid * 16 + i * 8192, R, C); const int Rb = Epi::PERM ? ((R & ~31) + perm32(R & 31)) : R;
        voffA[i] = (unsigned)(R * K + C) * 2u; voffB[i] = (unsigned)(Rb * K + C) * 2u; }
    const size_t kstep = (size_t)(BK * 2);
    const size_t hstep = (size_t)HALF * K * 2;
    const size_t tstep = 2 * hstep;
    const unsigned ldsw = (unsigned)wid * 1024u;
    const int aoff = lds_byte(wr * 64 + fr, fq * 8), boff = lds_byte(wc * 32 + fr, fq * 8);
#define PG8_SA(b, h) (((b) * 2 + (h)) * HTB)
#define PG8_SB(b, h) ((4 + (b) * 2 + (h)) * HTB)
#define PG8_STAGE(bufoff, gbase, voff) do { _Pragma("unroll") for (int _i = 0; _i < 2; ++_i) \
        __builtin_amdgcn_global_load_lds((const unsigned*)((const char*)(gbase) + (voff)[_i]), (PG8_LAS unsigned*)(lds + (bufoff) + ldsw + _i * 8192), 16, 0, 0); } while (0)
#define PG8_LDA(dst, b, h) do { _Pragma("unroll") for (int m = 0; m < 4; ++m) _Pragma("unroll") for (int k = 0; k < 2; ++k) dst[m][k] = *(const PG8_LAS bf16x8*)(lds + PG8_SA(b, h) + aoff + m * 2048 + k * 1024); } while (0)
#define PG8_LDB(dst, b, h) do { _Pragma("unroll") for (int n = 0; n < 2; ++n) _Pragma("unroll") for (int k = 0; k < 2; ++k) dst[n][k] = *(const PG8_LAS bf16x8*)(lds + PG8_SB(b, h) + boff + n * 2048 + k * 1024); } while (0)
#define PG8_MMA(ai, bj, At, Bt) do { __builtin_amdgcn_s_setprio(1); _Pragma("unroll") for (int m = 0; m < 4; ++m) _Pragma("unroll") for (int n = 0; n < 2; ++n) _Pragma("unroll") for (int k = 0; k < 2; ++k) \
        acc[ai][bj][m][n] = __builtin_amdgcn_mfma_f32_16x16x32_bf16(Bt[n][k], At[m][k], acc[ai][bj][m][n], 0, 0, 0); __builtin_amdgcn_s_setprio(0); } while (0)
#define PG8_WAIT_V(n) asm volatile("s_waitcnt vmcnt(" #n ")" ::: "memory")
#define PG8_WAIT_L(n) asm volatile("s_waitcnt lgkmcnt(" #n ")" ::: "memory")
#define PG8_BAR __builtin_amdgcn_s_barrier()
#define PG8_SCHED __builtin_amdgcn_sched_barrier(0)
    Unit cur, nxt; int ui = 0;
    if (!S.next(0, cur)) return;
    f32x4 acc[2][2][4][2];
#pragma unroll
    for (int a = 0; a < 2; ++a)
#pragma unroll
        for (int b = 0; b < 2; ++b)
#pragma unroll
            for (int m = 0; m < 4; ++m)
#pragma unroll
                for (int n = 0; n < 2; ++n) acc[a][b][m][n] = (f32x4){0.f, 0.f, 0.f, 0.f};
    bf16x8 At[4][2], B0[2][2], B1[2][2];
    const char* cA = (const char*)g.A + (size_t)cur.pm * tstep; const char* cB = (const char*)g.Bt + (size_t)cur.pn * tstep;
    S.a_ready(cur);
    if constexpr (SP2) {
        PG8_STAGE(PG8_SB(0, 0), cB, voffB); PG8_STAGE(PG8_SB(0, 1), cB + hstep, voffB); PG8_STAGE(PG8_SA(0, 0), cA, voffA); PG8_STAGE(PG8_SA(0, 1), cA + hstep, voffA);
        if (wr == 1) PG8_BAR;
        PG8_WAIT_V(2); PG8_BAR;
        PG8_STAGE(PG8_SB(1, 0), cB + kstep, voffB); PG8_STAGE(PG8_SA(1, 0), cA + kstep, voffA); PG8_STAGE(PG8_SB(1, 1), cB + hstep + kstep, voffB);
        PG8_WAIT_V(6); PG8_BAR;
    } else {
        PG8_STAGE(PG8_SB(0, 0), cB, voffB); PG8_STAGE(PG8_SA(0, 0), cA, voffA); PG8_STAGE(PG8_SB(0, 1), cB + hstep, voffB); PG8_STAGE(PG8_SA(0, 1), cA + hstep, voffA);
        if (wr == 1) PG8_BAR;
        PG8_WAIT_V(4); PG8_BAR;
        PG8_STAGE(PG8_SB(1, 0), cB + kstep, voffB); PG8_STAGE(PG8_SA(1, 0), cA + kstep, voffA); PG8_STAGE(PG8_SB(1, 1), cB + hstep + kstep, voffB);
        PG8_WAIT_V(6); PG8_BAR;
    }
    for (;;) {
        const bool has_next = S.next(ui + 1, nxt);
        const char* nA = has_next ? (const char*)g.A + (size_t)nxt.pm * tstep : cA; const char* nB = has_next ? (const char*)g.Bt + (size_t)nxt.pn * tstep : cB;
        for (int t = 0; t < nt; t += 2) {
            const bool last = (t == nt - 2);
            const char* a1 = cA + (size_t)(t + 1) * kstep;
            const char* a2 = last ? nA : cA + (size_t)(t + 2) * kstep; const char* b2 = last ? nB : cB + (size_t)(t + 2) * kstep;
            const char* a3 = a2 + kstep; const char* b3 = b2 + kstep;
            if (last && has_next) S.a_ready(nxt);
            if constexpr (SP2) {
            PG8_LDB(B0, 0, 0); PG8_LDB(B1, 0, 1); PG8_SCHED; PG8_LDA(At, 0, 0); PG8_STAGE(PG8_SA(1, 1), a1 + hstep, voffA);
            PG8_WAIT_V(8); PG8_WAIT_L(0); PG8_BAR; PG8_MMA(0, 0, At, B0); PG8_MMA(0, 1, At, B1); PG8_BAR; PG8_SCHED;
            PG8_LDA(At, 0, 1); PG8_STAGE(PG8_SB(0, 0), b2, voffB); PG8_STAGE(PG8_SB(0, 1), b2 + hstep, voffB); PG8_STAGE(PG8_SA(0, 0), a2, voffA);
            PG8_WAIT_V(8); PG8_WAIT_L(0); PG8_BAR; PG8_MMA(1, 0, At, B0); PG8_MMA(1, 1, At, B1); PG8_BAR; PG8_SCHED;
            PG8_LDB(B0, 1, 0); PG8_LDB(B1, 1, 1); PG8_SCHED; PG8_LDA(At, 1, 0); PG8_STAGE(PG8_SA(0, 1), a2 + hstep, voffA);
            PG8_WAIT_V(8); PG8_WAIT_L(0); PG8_BAR; PG8_MMA(0, 0, At, B0); PG8_MMA(0, 1, At, B1); PG8_BAR; PG8_SCHED;
            PG8_LDA(At, 1, 1); PG8_STAGE(PG8_SB(1, 0), b3, voffB); PG8_STAGE(PG8_SB(1, 1), b3 + hstep, voffB); PG8_STAGE(PG8_SA(1, 0), a3, voffA);
            PG8_WAIT_V(8); PG8_WAIT_L(0); PG8_BAR; PG8_MMA(1, 0, At, B0); PG8_MMA(1, 1, At, B1); PG8_BAR; PG8_SCHED;
            } else {
            PG8_LDB(B0, 0, 0); PG8_SCHED; PG8_LDA(At, 0, 0); PG8_STAGE(PG8_SA(1, 1), a1 + hstep, voffA);
            PG8_WAIT_L(8); PG8_BAR; PG8_WAIT_L(0); PG8_MMA(0, 0, At, B0); PG8_BAR; PG8_SCHED;
            PG8_LDB(B1, 0, 1); PG8_STAGE(PG8_SB(0, 0), b2, voffB);
            PG8_BAR; PG8_WAIT_L(0); PG8_MMA(0, 1, At, B1); PG8_BAR;
            PG8_LDA(At, 0, 1); PG8_STAGE(PG8_SA(0, 0), a2, voffA);
            PG8_BAR; PG8_WAIT_L(0); PG8_MMA(1, 0, At, B0); PG8_BAR; PG8_SCHED;
            PG8_STAGE(PG8_SB(0, 1), b2 + hstep, voffB);
            PG8_WAIT_V(6); PG8_BAR; PG8_MMA(1, 1, At, B1); PG8_BAR;
            PG8_LDB(B0, 1, 0); PG8_SCHED; PG8_LDA(At, 1, 0); PG8_STAGE(PG8_SA(0, 1), a2 + hstep, voffA);
            PG8_WAIT_L(8); PG8_BAR; PG8_WAIT_L(0); PG8_MMA(0, 0, At, B0); PG8_BAR; PG8_SCHED;
            PG8_LDB(B1, 1, 1); PG8_STAGE(PG8_SB(1, 0), b3, voffB);
            PG8_BAR; PG8_WAIT_L(0); PG8_MMA(0, 1, At, B1); PG8_BAR;
            PG8_LDA(At, 1, 1); PG8_STAGE(PG8_SA(1, 0), a3, voffA);
            PG8_BAR; PG8_WAIT_L(0); PG8_MMA(1, 0, At, B0); PG8_BAR; PG8_SCHED;
            PG8_STAGE(PG8_SB(1, 1), b3 + hstep, voffB);
            PG8_WAIT_V(6); PG8_BAR; PG8_MMA(1, 1, At, B1); PG8_BAR;
            }
        }
        if constexpr (ALIGN_EPI) { if (wr == 0) PG8_BAR; }
        if constexpr (!Epi::AFTER_DRAIN) { E(acc, cur, wr, wc, fr, fq); S.done(cur); }
        if (!has_next) break;
#pragma unroll
        for (int a = 0; a < 2; ++a)
#pragma unroll
            for (int b = 0; b < 2; ++b)
#pragma unroll
                for (int m = 0; m < 4; ++m)
#pragma unroll
                    for (int n = 0; n < 2; ++n) acc[a][b][m][n] = (f32x4){0.f, 0.f, 0.f, 0.f};
        cur = nxt; cA = nA; cB = nB; ++ui;
        if constexpr (ALIGN_EPI) { if (wr == 1) PG8_BAR; }
    }
    PG8_WAIT_V(0);
    if constexpr (!ALIGN_EPI) { if (wr == 0) PG8_BAR; }
    PG8_BAR;
    if constexpr (Epi::AFTER_DRAIN) { E.fused(acc, cur, wr, wc, fr, fq, lds, wid, lane); S.done(cur); }
#undef PG8_SA
#undef PG8_SB
#undef PG8_STAGE
#undef PG8_LDA
#undef PG8_LDB
#undef PG8_MMA
#undef PG8_WAIT_V
#undef PG8_WAIT_L
#undef PG8_BAR
#undef PG8_SCHED
}
}
#define GAS __attribute__((address_space(1)))
#define LAS __attribute__((address_space(3)))
typedef unsigned short bf16;
typedef unsigned v4u __attribute__((ext_vector_type(4)));
typedef float f32x4 __attribute__((ext_vector_type(4)));
typedef short bf16x8 __attribute__((ext_vector_type(8)));
typedef GAS unsigned gu32;
typedef GAS unsigned long long gu64;
#define RLX_AGENT __ATOMIC_RELAXED, __HIP_MEMORY_SCOPE_AGENT
#define LDS_WAIT() asm volatile("s_waitcnt lgkmcnt(0)" ::: "memory")
#define VM_WAIT() asm volatile("s_waitcnt vmcnt(0)" ::: "memory")
__device__ __forceinline__ unsigned long long rt() { return __builtin_amdgcn_s_memrealtime(); }
__device__ __forceinline__ unsigned f2bf(float f) { unsigned u = __builtin_bit_cast(unsigned, f); return (u + 0x7fffu + ((u >> 16) & 1u)) >> 16; }
__device__ __forceinline__ unsigned pk2(float lo, float hi) { return f2bf(lo) | (f2bf(hi) << 16); }

#define XB_TMO      128
#define XB_XCNT(j)  (256  + 64 * (j))
#define XB_XSUB(j)  (1280 + 64 * (j))
#define XB_XGEN(j)  (2304 + 64 * (j))
#define XB_TOP      3328
#define XB_TOPGEN   3392
#define XCD_BAR_WORDS 3456
#define XB_SPIN_CAP (1u << 18)

__device__ __forceinline__ unsigned xb_ld(unsigned* p)              { return __hip_atomic_load(p, __ATOMIC_RELAXED, __HIP_MEMORY_SCOPE_AGENT); }
__device__ __forceinline__ unsigned xb_add(unsigned* p, unsigned v) { return __hip_atomic_fetch_add(p, v, __ATOMIC_RELAXED, __HIP_MEMORY_SCOPE_AGENT); }
__device__ __forceinline__ unsigned xb_xcc_id() { return (unsigned)__builtin_amdgcn_s_getreg((3 << 11) | 20) & 0xFu; }
#define XB_SPIN(cond, bar) do { unsigned _sp = 0; while (cond) { __builtin_amdgcn_s_sleep(1); \
    if ((++_sp & 255u) == 0u) { if (xb_ld(&(bar)[XB_TMO])) break; if (_sp > XB_SPIN_CAP) { atomicAdd(&(bar)[XB_TMO], 1u); break; } } } } while (0)

struct XcdBarrier {
    unsigned* bar; unsigned x;
    volatile LAS unsigned* st;
};

__device__ __forceinline__ XcdBarrier xcd_barrier_post(unsigned* bar, volatile LAS unsigned* st) {
    XcdBarrier b; b.bar = bar; b.x = xb_xcc_id(); b.st = st;
    if (threadIdx.x == 0) (void)xb_add(&bar[XB_XCNT(b.x)], 1u);
    return b;
}
__device__ __forceinline__ void xcd_barrier_complete(unsigned* bar, unsigned x, unsigned& nloc, unsigned& nx) {
    const unsigned G = gridDim.x * gridDim.y * gridDim.z;
    unsigned sum, cnt, mine, sp = 0u;
    for (;;) {
        sum = 0u; cnt = 0u; mine = 0u;
#pragma unroll
        for (unsigned j = 0; j < 16; ++j) { const unsigned c = xb_ld(&bar[XB_XCNT(j)]); sum += c; cnt += (c > 0u) ? 1u : 0u; mine = (j == x) ? c : mine; }
        if (sum == G) break;
        __builtin_amdgcn_s_sleep(1);
        if ((++sp & 255u) == 0u) { if (xb_ld(&bar[XB_TMO])) break; if (sp > XB_SPIN_CAP) { atomicAdd(&bar[XB_TMO], 1u); break; } }
    }
    nloc = mine > 0u ? mine : 1u; nx = cnt > 0u ? cnt : 1u;
}

__device__ __forceinline__ void xcd_barrier(const XcdBarrier& b) {
    asm volatile("s_waitcnt vmcnt(0)" ::: "memory");
    __syncthreads();
    if (threadIdx.x == 0) {
        unsigned* bar = b.bar;
        __builtin_amdgcn_s_waitcnt(0);
        unsigned nloc = b.st[0], nx = b.st[1];
        if (nloc == 0u) { xcd_barrier_complete(bar, b.x, nloc, nx); b.st[0] = nloc; b.st[1] = nx; }
        const unsigned old = xb_add(&bar[XB_XSUB(b.x)], 1u);
        const unsigned gen = old / nloc;
        if (old + 1u == (gen + 1u) * nloc) {
            __builtin_amdgcn_fence(__ATOMIC_RELEASE, "agent");
            asm volatile("s_waitcnt vmcnt(0)" ::: "memory");
            const unsigned og = xb_add(&bar[XB_TOP], 1u);
            const unsigned tg = og / nx;
            if (og + 1u == (tg + 1u) * nx) xb_add(&bar[XB_TOPGEN], 1u);
            else XB_SPIN(xb_ld(&bar[XB_TOPGEN]) == tg, bar);
            __builtin_amdgcn_fence(__ATOMIC_ACQUIRE, "agent");
            xb_add(&bar[XB_XGEN(b.x)], 1u);
            asm volatile("s_waitcnt vmcnt(0)" ::: "memory");
        } else {
            XB_SPIN(xb_ld(&bar[XB_XGEN(b.x)]) == gen, bar);
            __builtin_amdgcn_fence(__ATOMIC_ACQUIRE, "agent");
            asm volatile("s_waitcnt vmcnt(0)" ::: "memory");
        }
    }
    __syncthreads();
}

constexpr int NWAVES = 8, NTHR = NWAVES * 64;
constexpr int BATCH = 8, SEQ = 4096, DMODEL = 1024, DEPTH = 4, MTOK = BATCH * SEQ;
constexpr int AW = 512, NHEAD = 4, HD = 128, IH = 8, IDIM = 64, TOPK = 256, LW = 512, LBLK = 8, LBS = 64, FF = 4096, NMOD = 6;
constexpr int INC = 3144, INP = 3328;
constexpr int CQ = 0, CK = 512, CV = 1024, CQI = 1536, CKI = 2048, CWI = 2112, CXR = 2120, CYG = 2632;
constexpr int MODW = NMOD * DMODEL;
constexpr float LN_EPS = 1e-5f;
constexpr float ALPHA = 1.6817928305074290f;
constexpr float LOG2E = 1.4426950408889634f;
constexpr int LCH = 128, NLCH = SEQ / LCH;

constexpr size_t MiB = 1u << 20;
constexpr size_t WS_CTL = 0, CTL_ZERO_BYTES = 1 * MiB;
constexpr size_t WS_MOD = 1 * MiB;
constexpr size_t WS_GATE = 2 * MiB;
constexpr size_t WS_STAT = 2 * MiB + 512 * 1024;
constexpr size_t WS_CARRY = 3 * MiB;
constexpr size_t WS_WI = 4 * MiB;
constexpr size_t WS_KI = 5 * MiB;
constexpr size_t WS_MASK = 9 * MiB;
constexpr size_t WS_WIN = 25 * MiB;
constexpr size_t WS_WOUT = 51 * MiB;
constexpr size_t WS_WUP = 59 * MiB;
constexpr size_t WS_WDN = 91 * MiB;
constexpr size_t WS_HA = 123 * MiB;
constexpr size_t WS_P = 187 * MiB;
constexpr size_t WS_MG = 395 * MiB;
constexpr size_t WS_HID = 187 * MiB;
constexpr size_t WS_END = 459 * MiB;
static_assert(WS_WIN + (size_t)DEPTH * INP * 1024 * 2 <= WS_WOUT && WS_P + (size_t)MTOK * INP * 2 <= WS_MG && WS_HID + (size_t)MTOK * FF * 2 <= WS_END && WS_MG + (size_t)MTOK * 1024 * 2 <= WS_END, "d_ws map");
constexpr int CW_BAR = 4096;

constexpr int RING_BYTES = 131072;
constexpr int LDSCTL_OFF = RING_BYTES, MISC_OFF = LDSCTL_OFF + 320;
constexpr int LDS_BYTES = 147456;

__device__ __constant__ float ROPE_INV[64] = {
1.000000000e+00f, 8.659643531e-01f, 7.498942614e-01f, 6.493816376e-01f, 5.623413324e-01f, 4.869675338e-01f, 4.216965139e-01f, 3.651741147e-01f, 3.162277639e-01f, 2.738419771e-01f, 2.371373773e-01f, 2.053525001e-01f, 1.778279394e-01f, 1.539926529e-01f, 1.333521307e-01f, 1.154782027e-01f, 1.000000015e-01f, 8.659642935e-02f, 7.498941571e-02f, 6.493816525e-02f, 5.623413250e-02f, 4.869675264e-02f, 4.216965288e-02f, 3.651741147e-02f, 3.162277490e-02f, 2.738419734e-02f, 2.371373773e-02f, 2.053525113e-02f, 1.778279431e-02f, 1.539926510e-02f, 1.333521493e-02f, 1.154782064e-02f, 9.999999776e-03f, 8.659643121e-03f, 7.498941850e-03f, 6.493816152e-03f, 5.623413250e-03f, 4.869675264e-03f, 4.216964822e-03f, 3.651741194e-03f, 3.162277630e-03f, 2.738419687e-03f, 2.371373586e-03f, 2.053524833e-03f, 1.778279431e-03f, 1.539926510e-03f, 1.333521446e-03f, 1.154781901e-03f, 1.000000047e-03f, 8.659643354e-04f, 7.498942432e-04f, 6.493816618e-04f, 5.623413017e-04f, 4.869675322e-04f, 4.216965172e-04f, 3.651741426e-04f, 3.162277571e-04f, 2.738419571e-04f, 2.371373703e-04f, 2.053525095e-04f, 1.778279402e-04f, 1.539926452e-04f, 1.333521504e-04f, 1.154782003e-04f };

typedef float f32x16 __attribute__((ext_vector_type(16)));
typedef unsigned u32x2 __attribute__((ext_vector_type(2)));
typedef float f32x2 __attribute__((ext_vector_type(2)));
__device__ __forceinline__ float bf2f(unsigned short b) { return __builtin_bit_cast(float, ((unsigned)b) << 16); }
__device__ __forceinline__ unsigned cvtpk(float lo, float hi) { unsigned r; asm volatile("v_cvt_pk_bf16_f32 %0, %1, %2" : "=v"(r) : "v"(lo), "v"(hi)); return r; }
__device__ __forceinline__ float wave_sum(float v) {
#pragma unroll
    for (int o = 1; o < 64; o <<= 1) v += __shfl_xor(v, o);
    return v;
}
__device__ __forceinline__ float wave_max(float v) {
#pragma unroll
    for (int o = 1; o < 64; o <<= 1) v = fmaxf(v, __shfl_xor(v, o));
    return v;
}
__device__ __forceinline__ float wave_min(float v) {
#pragma unroll
    for (int o = 1; o < 64; o <<= 1) v = fminf(v, __shfl_xor(v, o));
    return v;
}
__device__ __forceinline__ float sigmoidf_fast(float z) { return __builtin_amdgcn_rcpf(1.0f + __builtin_amdgcn_exp2f(-z * LOG2E)); }

struct Args {
    const float* x; const float* c; const int* pos;
    const float *w_mod, *b_mod, *w_in, *conv_w, *conv_b, *wga, *bga, *wgx, *bgx, *lam, *g_attn, *g_lru, *w_out, *ln1_g, *ln1_b, *w_up, *w_down, *ln2_g, *ln2_b;
    float* out; unsigned char* ws; int ph_lo, ph_hi;
};

namespace att {
constexpr int D = 128, NW = 8, QBLK = 32, KVBLK = 64, QB = NW * QBLK;
constexpr int SHM_V = KVBLK * D * 2, SHM_K = KVBLK * D * 2;
constexpr int LDS_BYTES = 2 * SHM_V + 2 * SHM_K + NW * 64 * 4;
constexpr float SCALE = 0.08838834764831845f, THR = 8.f;
constexpr int PQ = INP, PO = DMODEL;
constexpr int MKW = SEQ / 32;
#define KSWZ(row, colB) ((row) * 256 + ((colB) ^ (((row) & 7) << 4)))
#define SBAR() __builtin_amdgcn_sched_barrier(0)
__device__ __forceinline__ int v_st(int k, int c) { const int kk = (k & ~0xC) | ((k & 4) << 1) | ((k & 8) >> 1); return ((kk >> 3) * 4 + (c >> 5)) * 512 + ((kk & 7) * 32 + (c & 31)) * 2; }
__device__ __forceinline__ int v_rd_base(int lane) { return ((lane & 3) << 3) | (((lane >> 2) & 3) << 6) | (((lane >> 4) & 1) << 5) | (((lane >> 5) & 1) << 8); }
constexpr int v_rd_off(int d0, int ks, int half) { return d0 * 512 + ks * 4096 + half * 2048; }
__device__ __forceinline__ int crow(int r, int hi) { return (r & 3) + 8 * (r >> 2) + 4 * hi; }
typedef short s16x4 __attribute__((ext_vector_type(4)));
template <class T> __device__ __forceinline__ T* uni(T* p) { const unsigned long long v = (unsigned long long)(uintptr_t)p; const unsigned lo = __builtin_amdgcn_readfirstlane((unsigned)v), hi = __builtin_amdgcn_readfirstlane((unsigned)(v >> 32)); return (T*)(GAS T*)(uintptr_t)(((unsigned long long)hi << 32) | lo); }
__device__ __forceinline__ bf16x8 load8(const bf16* p) { return *reinterpret_cast<const bf16x8*>(p); }
__device__ __forceinline__ void mask_tile(f32x16& p0, f32x16& p1, int dq) {
    const float NEG = -__builtin_inff();
#pragma unroll
    for (int r = 0; r < 16; ++r) {
        const int c = (r & 3) + 8 * (r >> 2);
        if (dq - c < 0) p0[r] = NEG;
        if (dq - c - 32 < 0) p1[r] = NEG;
    }
}
__device__ __forceinline__ void apply_bits(f32x16& p, unsigned ws) {
#ifdef ATT_NOMASK
    return;
#endif
#pragma unroll
    for (int r = 0; r < 16; ++r) { const int c = (r & 3) + 8 * (r >> 2); const unsigned m = (unsigned)(((int)(ws << (31 - c))) >> 31); const float pv = p[r]; p[r] = __uint_as_float(__float_as_uint(pv) & m); }
}
__device__ __forceinline__ void partialSM(f32x16& p0, f32x16& p1, float& m_reg, float& mn, float& alpha, unsigned w0s) {
    float pmax = p0[0];
#pragma unroll
    for (int r = 1; r < 16; ++r) pmax = fmaxf(pmax, p0[r]);
#pragma unroll
    for (int r = 0; r < 16; ++r) pmax = fmaxf(pmax, p1[r]);
    { auto rr = __builtin_amdgcn_permlane32_swap(__float_as_uint(pmax), __float_as_uint(pmax), false, false);
      pmax = fmaxf(__uint_as_float(rr[0]), __uint_as_float(rr[1])); }
    constexpr float C2 = 1.4426950408889634f * SCALE;
    if (__builtin_expect(__all((pmax - m_reg) * SCALE <= THR), 1)) { mn = m_reg; alpha = 1.f; }
    else { mn = fmaxf(m_reg, pmax); alpha = __builtin_amdgcn_exp2f((m_reg - mn) * C2); m_reg = mn; }
    const float mnL = -mn * C2;
#pragma unroll
    for (int r = 0; r < 16; ++r) p0[r] = fmaf(p0[r], C2, mnL);
#pragma unroll
    for (int r = 0; r < 16; ++r) p1[r] = fmaf(p1[r], C2, mnL);
#pragma unroll
    for (int r = 0; r < 16; ++r) p0[r] = __builtin_amdgcn_exp2f(p0[r]);
    apply_bits(p0, w0s);
}
__device__ __forceinline__ void finishSM(f32x16& p0, f32x16& p1, float alpha, float& l_reg, bf16x8& pa0, bf16x8& pa1, bf16x8& pa2, bf16x8& pa3, unsigned w1s) {
#pragma unroll
    for (int r = 0; r < 16; ++r) p1[r] = __builtin_amdgcn_exp2f(p1[r]);
    apply_bits(p1, w1s);
    float ps = 0;
#pragma unroll
    for (int r = 0; r < 16; ++r) ps += p0[r];
#pragma unroll
    for (int r = 0; r < 16; ++r) ps += p1[r];
    { auto rr = __builtin_amdgcn_permlane32_swap(__float_as_uint(ps), __float_as_uint(ps), false, false);
      ps = __uint_as_float(rr[0]) + __uint_as_float(rr[1]); }
    l_reg = l_reg * alpha + ps;
#define PK4(P, B_, OUT) do { unsigned a0 = cvtpk(P[B_+0], P[B_+1]), a1 = cvtpk(P[B_+2], P[B_+3]);                          \
        unsigned b0 = cvtpk(P[B_+4], P[B_+5]), b1 = cvtpk(P[B_+6], P[B_+7]);                                             \
        auto r0 = __builtin_amdgcn_permlane32_swap(a0, b0, false, false); auto r1 = __builtin_amdgcn_permlane32_swap(a1, b1, false, false); \
        v4u w = {r0[0], r1[0], r0[1], r1[1]}; OUT = *reinterpret_cast<bf16x8*>(&w); } while (0)
    PK4(p0, 0, pa0); PK4(p0, 8, pa1); PK4(p1, 0, pa2); PK4(p1, 8, pa3);
#undef PK4
}
template <int KB>
__device__ __forceinline__ void qkt(f32x16& p0, f32x16& p1, const char* K_lds, int r32, int hi, const bf16x8* qr) {
    p0 = f32x16{}; p1 = f32x16{};
    const char* kb[4];
#pragma unroll
    for (int dd = 0; dd < 4; ++dd) kb[dd] = K_lds + KB * SHM_K + KSWZ(r32, (dd * 16 + hi * 8) * 2);
#pragma unroll
    for (int d0 = 0; d0 < 8; ++d0) { const char* a = kb[d0 & 3] + (d0 >> 2) * 128;
        bf16x8 b0 = *reinterpret_cast<const bf16x8*>(a);
        bf16x8 b1 = *reinterpret_cast<const bf16x8*>(a + 32 * 256);
        p0 = __builtin_amdgcn_mfma_f32_32x32x16_bf16(b0, qr[d0], p0, 0, 0, 0);
        p1 = __builtin_amdgcn_mfma_f32_32x32x16_bf16(b1, qr[d0], p1, 0, 0, 0); }
}
template <int VB>
__device__ __forceinline__ void pv_tile(f32x16* o, int vb0, bf16x8 pa0, bf16x8 pa1, bf16x8 pa2, bf16x8 pa3) {
#define TRRD(dst, off) asm volatile("ds_read_b64_tr_b16 %0, %1 offset:%2" : "=&v"(dst) : "v"(vb0), "i"(off) : "memory")
#define PV_D0(d0) do { s16x4 l0, l1, l2, l3, h0, h1, h2, h3; constexpr int b_ = VB * SHM_V + v_rd_off(d0, 0, 0); \
        TRRD(l0, b_); TRRD(h0, b_ + 2048); TRRD(l1, b_ + 4096); TRRD(h1, b_ + 6144); TRRD(l2, b_ + 8192); TRRD(h2, b_ + 10240); TRRD(l3, b_ + 12288); TRRD(h3, b_ + 14336); \
        asm volatile("s_waitcnt lgkmcnt(0)" ::: "memory"); SBAR();   \
        o[d0] = __builtin_amdgcn_mfma_f32_32x32x16_bf16(pa0, (bf16x8){l0[0], l0[1], l0[2], l0[3], h0[0], h0[1], h0[2], h0[3]}, o[d0], 0, 0, 0);   \
        o[d0] = __builtin_amdgcn_mfma_f32_32x32x16_bf16(pa1, (bf16x8){l1[0], l1[1], l1[2], l1[3], h1[0], h1[1], h1[2], h1[3]}, o[d0], 0, 0, 0);   \
        o[d0] = __builtin_amdgcn_mfma_f32_32x32x16_bf16(pa2, (bf16x8){l2[0], l2[1], l2[2], l2[3], h2[0], h2[1], h2[2], h2[3]}, o[d0], 0, 0, 0);   \
        o[d0] = __builtin_amdgcn_mfma_f32_32x32x16_bf16(pa3, (bf16x8){l3[0], l3[1], l3[2], l3[3], h3[0], h3[1], h3[2], h3[3]}, o[d0], 0, 0, 0); } while (0)
    PV_D0(0); PV_D0(1); PV_D0(2); PV_D0(3);
#undef PV_D0
#undef TRRD
}
struct Bases { const char* P; char* MG; const char* MK; };
struct BlockRef { unsigned q, k, v, o, mk; int P0; };
struct Seam { bf16x8 qr[8]; bf16x8 st_v0, st_v1, st_k0, st_k1; };
#define VMW() asm volatile("s_waitcnt vmcnt(0)" ::: "memory")
#define VMWN(n) asm volatile("s_waitcnt vmcnt(%0)" :: "i"(n) : "memory")
#define SLOAD_H(Kp, Vp, k0) do { const char* kk_ = (Kp) + (size_t)(k0) * (PQ * 2); const char* vv_ = (Vp) + (size_t)(k0) * (PQ * 2);              \
                         S.st_v0 = *(const bf16x8*)(vv_ + so0); S.st_v1 = *(const bf16x8*)(vv_ + so1);              \
                         S.st_k0 = *(const bf16x8*)(kk_ + so0); S.st_k1 = *(const bf16x8*)(kk_ + so1); } while (0)
#define SWRITE_HK(bf) do { *(bf16x8*)(K_lds + (bf) * SHM_K + kws) = S.st_k0; *(bf16x8*)(K_lds + (bf) * SHM_K + kws + 32 * 256) = S.st_k1; } while (0)
#define SWRITE_HV(bf) do { *(bf16x8*)(V_lds + (bf) * SHM_V + vst0) = S.st_v0; *(bf16x8*)(V_lds + (bf) * SHM_V + vst1) = S.st_v1; } while (0)
#define SWRITE_H(bf) do { SWRITE_HV(bf); SWRITE_HK(bf); } while (0)
__device__ __forceinline__ void prime(const Bases& B, const BlockRef& cur, char* lds, Seam& S) {
    int tid_l = threadIdx.x; asm volatile("" : "+v"(tid_l));
    const int tid = tid_l, wid = __builtin_amdgcn_readfirstlane(tid >> 6), lane = tid & 63, r32 = lane & 31, hi = lane >> 5;
    const int sr = tid >> 4, sc = (tid & 15) * 8, kws = KSWZ(sr, sc * 2); char* K_lds = lds + 2 * SHM_V;
    const unsigned so0 = (unsigned)(sr * PQ + sc) * 2u, so1 = so0 + 32u * PQ * 2u;
    const unsigned qo = (unsigned)((wid * QBLK + r32) * PQ + hi * 8) * 2u;
    const char* Qb = B.P + cur.q; const char* Kb = B.P + cur.k; const char* Vb = B.P + cur.v;
#pragma unroll
    for (int d0 = 0; d0 < 8; ++d0) S.qr[d0] = *(const bf16x8*)(Qb + qo + d0 * 32);
    SLOAD_H(Kb, Vb, 0); VMW(); SWRITE_HK(0);
    __syncthreads();
}
__device__ __forceinline__ void block(const Bases& B, const BlockRef& cur, const BlockRef& nxt, char* lds, Seam& S) {
    int tid_l = threadIdx.x; asm volatile("" : "+v"(tid_l));
    const int tid = tid_l, wid = __builtin_amdgcn_readfirstlane(tid >> 6), lane = tid & 63, r32 = lane & 31, hi = lane >> 5;
    const int NT = cur.P0 / KVBLK + QB / KVBLK;
    const int qlo = cur.P0 + wid * QBLK, qm = qlo + r32 - 4 * hi;
    char* V_lds = lds; char* K_lds = lds + 2 * SHM_V;
    float* ws = (float*)(lds + 2 * SHM_V + 2 * SHM_K) + wid * 64; float* li_l = ws, * al_l = ws + 32;
    float m_reg = -1e30f, l_reg = 0; f32x16 o[4] = {};
    const int sr = tid >> 4, sc = (tid & 15) * 8, vst0 = v_st(sr, sc), vst1 = v_st(32 + sr, sc), kws = KSWZ(sr, sc * 2);
    const int vb0 = (int)(uintptr_t)V_lds + v_rd_base(lane);
    const char* Kh = B.P + cur.k; const char* Vh = B.P + cur.v;
    const unsigned so0 = (unsigned)(sr * PQ + sc) * 2u, so1 = so0 + 32u * PQ * 2u;
    const unsigned qo = (unsigned)((wid * QBLK + r32) * PQ + hi * 8) * 2u;
    const char* mkb = B.MK + cur.mk; const unsigned mo = (unsigned)(wid * QBLK + r32) * (MKW * 4u);
    const int sh4 = 4 * hi;
#define RESC(a) do { if (__any((a) < 1.f)) { if (hi == 0) al_l[r32] = (a); asm volatile("s_waitcnt lgkmcnt(0)" ::: "memory");              \
                     for (int d_ = 0; d_ < 4; ++d_) for (int r = 0; r < 16; ++r) o[d_][r] *= al_l[crow(r, hi)]; } } while (0)
#define KBASE(t) ((t) * KVBLK)
#define MASKT(P0_, P1_, t) do { const int kb_ = KBASE(t); if (kb_ + KVBLK - 1 > qlo) mask_tile(P0_, P1_, qm - kb_); } while (0)
#define MLOAD(t) (*(const u32x2*)(mkb + (size_t)(t) * 8 + mo))
    f32x16 pA0, pA1, pB0, pB1; float mnA, mnB, alA, alB; bf16x8 pa0, pa1, pa2, pa3; u32x2 mA, mB;
    SWRITE_HV(0); SBAR();
    SLOAD_H(Kh, Vh, KBASE(1));
    mA = MLOAD(0);
    SBAR(); qkt<0>(pA0, pA1, K_lds, r32, hi, S.qr);
    MASKT(pA0, pA1, 0); partialSM(pA0, pA1, m_reg, mnA, alA, mA.x >> sh4);
    VMW(); SWRITE_H(1);
    __syncthreads();
#define HALF_STEP(PX0, PX1, mnX, alX, mX, PY0, PY1, alY, mY, t, KB, VB, SB) do {                                              \
        SBAR(); mX = MLOAD(t); qkt<KB>(PX0, PX1, K_lds, r32, hi, S.qr);                                                      \
        finishSM(PY0, PY1, alY, l_reg, pa0, pa1, pa2, pa3, mY.y >> sh4); SBAR();                                              \
        if ((t) + 1 < NT) { SLOAD_H(Kh, Vh, KBASE((t) + 1)); SBAR(); }                                                        \
        pv_tile<VB>(o, vb0, pa0, pa1, pa2, pa3); MASKT(PX0, PX1, (t)); partialSM(PX0, PX1, m_reg, mnX, alX, mX.x >> sh4);    \
        __syncthreads();                                                                                                      \
        if ((t) + 1 < NT) { VMW(); SWRITE_H(SB); }                                                                            \
        RESC(alX); __syncthreads(); } while (0)
    for (int t = 1; t + 1 < NT; t += 2) {
        HALF_STEP(pB0, pB1, mnB, alB, mB, pA0, pA1, alA, mA, t, 1, 0, 0);
        HALF_STEP(pA0, pA1, mnA, alA, mA, pB0, pB1, alB, mB, t + 1, 0, 1, 1);
    }
    SBAR(); mB = MLOAD(NT - 1); qkt<1>(pB0, pB1, K_lds, r32, hi, S.qr); SBAR();
    { const char* nK = B.P + nxt.k; const char* nV = B.P + nxt.v; SLOAD_H(nK, nV, 0); } SBAR();
    { const char* nQ = B.P + nxt.q;
#pragma unroll
    for (int d0 = 0; d0 < 8; ++d0) S.qr[d0] = *(const bf16x8*)(nQ + qo + d0 * 32); }
    SBAR();
    finishSM(pA0, pA1, alA, l_reg, pa0, pa1, pa2, pa3, mA.y >> sh4); SBAR();
    pv_tile<0>(o, vb0, pa0, pa1, pa2, pa3);
    MASKT(pB0, pB1, NT - 1); partialSM(pB0, pB1, m_reg, mnB, alB, mB.x >> sh4); __syncthreads(); RESC(alB);
    finishSM(pB0, pB1, alB, l_reg, pa0, pa1, pa2, pa3, mB.y >> sh4); SBAR(); pv_tile<1>(o, vb0, pa0, pa1, pa2, pa3);
    SBAR(); VMWN(8); SWRITE_HK(0); SBAR();
    if (hi == 0) li_l[r32] = l_reg; asm volatile("s_waitcnt lgkmcnt(0)" ::: "memory");
    float rli[16];
#pragma unroll
    for (int r = 0; r < 16; ++r) rli[r] = __builtin_amdgcn_rcpf(li_l[crow(r, hi)]);
    char* Ob = B.MG + cur.o; const unsigned oo = (unsigned)((wid * QBLK) * PO + r32) * 2u;
#pragma unroll
    for (int r = 0; r < 16; ++r) { const int orow = crow(r, hi);
#pragma unroll
        for (int d0 = 0; d0 < 4; ++d0) { const float v = o[d0][r] * rli[r];
            const float vn = __shfl_xor(v, 1);
            if ((r32 & 1) == 0) *(unsigned*)(Ob + oo + (unsigned)(orow * PO + d0 * 32) * 2u) = cvtpk(v, vn); } }
    __syncthreads();
#undef RESC
#undef KBASE
#undef MASKT
#undef MLOAD
#undef HALF_STEP
}
#undef VMW
#undef VMWN
#undef SLOAD_H
#undef SWRITE_HK
#undef SWRITE_HV
#undef SWRITE_H
#undef SBAR
#undef KSWZ
}

struct Frame {
    LAS unsigned char* lds;
    gu32* ctl;
    int tid, lane, wave, vcu, G;
    float* MODV; float* STAT; bf16* GATE; float* CARRY; float* WI; bf16* KI; unsigned* MASK; bf16 *WIN, *WOUT, *WUP, *WDN, *HA, *P, *MG, *HID;
};

__device__ __forceinline__ void transpose_item(const float* W, int K, int N, bf16* WT, LAS float* scr, int item, int nblk, int lane) {
    const int kb = item / nblk, nb = item % nblk, k0 = 64 * kb, n0 = 32 * nb;
    const int nn = n0 + (lane & 31);
#pragma unroll 8
    for (int i = 0; i < 32; ++i) { const int kk = 2 * i + (lane >> 5); scr[kk * 33 + (lane & 31)] = (nn < N) ? W[(size_t)(k0 + kk) * N + nn] : 0.f; }
    LDS_WAIT(); asm volatile("" ::: "memory");
    const int c = lane & 7;
#pragma unroll
    for (int j = 0; j < 4; ++j) { const int n = (lane >> 3) + 8 * j; const LAS float* s = scr + (8 * c) * 33 + n;
        v4u o; o.x = pk2(s[0 * 33], s[1 * 33]); o.y = pk2(s[2 * 33], s[3 * 33]); o.z = pk2(s[4 * 33], s[5 * 33]); o.w = pk2(s[6 * 33], s[7 * 33]);
        *(GAS v4u*)(WT + (size_t)(n0 + n) * K + k0 + 8 * c) = o; }
    LDS_WAIT(); asm volatile("" ::: "memory");
}
__device__ __forceinline__ void p0_prologue(Frame& F, const Args& a) {
    LAS float* scr = (LAS float*)(F.lds + F.wave * 16384);
    const int gw = F.vcu * NWAVES + F.wave, NGW = F.G * NWAVES;
    constexpr int I_IN = (DMODEL / 64) * (INP / 32), I_OUT = (DMODEL / 64) * (DMODEL / 32), I_UP = (DMODEL / 64) * (FF / 32), I_DN = (FF / 64) * (DMODEL / 32);
    constexpr int PER_L = I_IN + I_OUT + I_UP + I_DN;
    for (int it = gw; it < DEPTH * PER_L; it += NGW) {
        const int l = it / PER_L; int r = it % PER_L;
        if (r < I_IN) { transpose_item(a.w_in + (size_t)l * DMODEL * INC, DMODEL, INC, F.WIN + (size_t)l * INP * DMODEL, scr, r, INP / 32, F.lane); continue; } r -= I_IN;
        if (r < I_OUT) { transpose_item(a.w_out + (size_t)l * DMODEL * DMODEL, DMODEL, DMODEL, F.WOUT + (size_t)l * DMODEL * DMODEL, scr, r, DMODEL / 32, F.lane); continue; } r -= I_OUT;
        if (r < I_UP) { transpose_item(a.w_up + (size_t)l * DMODEL * FF, DMODEL, FF, F.WUP + (size_t)l * FF * DMODEL, scr, r, FF / 32, F.lane); continue; } r -= I_UP;
        transpose_item(a.w_down + (size_t)l * FF * DMODEL, FF, DMODEL, F.WDN + (size_t)l * DMODEL * FF, scr, r, DMODEL / 32, F.lane);
    }
    for (int i = F.vcu * NTHR + F.tid; i < DEPTH * 2 * LBLK * 64 * 64; i += F.G * NTHR) {
        const int c = i & 63, d = (i >> 6) & 63, n = (i >> 12) & 7, g = (i >> 15) & 1, l = i >> 16;
        const float* src = g ? a.wgx : a.wga;
        F.GATE[i] = (bf16)f2bf(src[(((size_t)l * LBLK + n) * 64 + c) * 64 + d]);
    }
    __syncthreads();
    LAS float* sc = (LAS float*)F.lds;
    LAS float* red = (LAS float*)(F.lds + 32768);
    for (int i = F.tid; i < BATCH * DMODEL; i += NTHR) { const int b = i >> 10, k = i & 1023; const float v = a.c[i]; sc[k * 8 + b] = v * sigmoidf_fast(v); }
    __syncthreads();
    for (int u = F.vcu; u < DEPTH * (MODW / 64); u += F.G) {
        const int l = u / (MODW / 64), j = (u % (MODW / 64)) * 64 + F.lane;
        float acc[8];
#pragma unroll
        for (int b = 0; b < 8; ++b) acc[b] = 0.f;
        const float* wp = a.w_mod + (size_t)l * DMODEL * MODW + j;
#pragma unroll 4
        for (int kk = 0; kk < 128; ++kk) { const int k = F.wave * 128 + kk; const float wv = wp[(size_t)k * MODW];
            const f32x4 s0 = *(const LAS f32x4*)(sc + k * 8), s1 = *(const LAS f32x4*)(sc + k * 8 + 4);
            acc[0] += s0[0] * wv; acc[1] += s0[1] * wv; acc[2] += s0[2] * wv; acc[3] += s0[3] * wv;
            acc[4] += s1[0] * wv; acc[5] += s1[1] * wv; acc[6] += s1[2] * wv; acc[7] += s1[3] * wv; }
#pragma unroll
        for (int b = 0; b < 8; ++b) red[(F.wave * 8 + b) * 64 + F.lane] = acc[b];
        __syncthreads();
        float s = a.b_mod[(size_t)l * MODW + j];
#pragma unroll
        for (int w2 = 0; w2 < 8; ++w2) s += red[(w2 * 8 + F.wave) * 64 + F.lane];
        F.MODV[((size_t)l * BATCH + F.wave) * MODW + j] = s;
        __syncthreads();
    }
}

__device__ __forceinline__ void modulate_rows(Frame& F, const float* x, const float* modl, int shoff, int scoff) {
    const int gw = F.vcu * NWAVES + F.wave, NGW = F.G * NWAVES;
    for (int m = gw; m < MTOK; m += NGW) {
        const float* mb = modl + (size_t)(m / SEQ) * MODW;
#pragma unroll
        for (int j = 0; j < 4; ++j) { const int col = 4 * F.lane + 256 * j;
            const f32x4 v = *(const GAS f32x4*)(x + (size_t)m * DMODEL + col), s = *(const GAS f32x4*)(mb + scoff + col), h = *(const GAS f32x4*)(mb + shoff + col);
            const f32x4 y = v * (s + 1.0f) + h;
            u32x2 w; w.x = cvtpk(y[0], y[1]); w.y = cvtpk(y[2], y[3]);
            *(GAS u32x2*)(F.HA + (size_t)m * DMODEL + col) = w; }
    }
}
__device__ __forceinline__ void ln_rows(Frame& F, float* x, float* STAT, const float* g, const float* bt, const float* modl, int shoff, int scoff, bool write_x) {
    const int gw = F.vcu * NWAVES + F.wave, NGW = F.G * NWAVES;
    for (int m = gw; m < MTOK; m += NGW) {
        f32x4 v[4]; float s = 0.f;
#pragma unroll
        for (int j = 0; j < 4; ++j) { v[j] = *(const GAS f32x4*)(x + (size_t)m * DMODEL + 4 * F.lane + 256 * j); s += (v[j][0] + v[j][1]) + (v[j][2] + v[j][3]); }
        const float mean = wave_sum(s) * (1.f / DMODEL); float s2 = 0.f;
#pragma unroll
        for (int j = 0; j < 4; ++j) { v[j] = v[j] - mean; s2 += (v[j][0] * v[j][0] + v[j][1] * v[j][1]) + (v[j][2] * v[j][2] + v[j][3] * v[j][3]); }
        const float rstd = 1.f / sqrtf(wave_sum(s2) * (1.f / DMODEL) + LN_EPS);
        if (F.lane == 0) { f32x2 st; st[0] = mean; st[1] = rstd; *(GAS f32x2*)(STAT + 2 * (size_t)m) = st; }
        const float* mb = modl ? modl + (size_t)(m / SEQ) * MODW : nullptr;
#pragma unroll
        for (int j = 0; j < 4; ++j) { const int col = 4 * F.lane + 256 * j;
            const f32x4 gg = *(const GAS f32x4*)(g + col), bb = *(const GAS f32x4*)(bt + col);
            const f32x4 y = v[j] * rstd * gg + bb;
            if (write_x) *(GAS f32x4*)(x + (size_t)m * DMODEL + col) = y;
            if (modl) { const f32x4 sv = *(const GAS f32x4*)(mb + scoff + col), hv = *(const GAS f32x4*)(mb + shoff + col);
                const f32x4 h = y * (sv + 1.0f) + hv; u32x2 w; w.x = cvtpk(h[0], h[1]); w.y = cvtpk(h[2], h[3]);
                *(GAS u32x2*)(F.HA + (size_t)m * DMODEL + col) = w; } }
    }
}
__device__ __forceinline__ void rms_rows(Frame& F, const float* ga, const float* gl) {
    const int gw = F.vcu * NWAVES + F.wave, NGW = F.G * NWAVES;
    for (int m = gw; m < MTOK; m += NGW) {
#pragma unroll
        for (int hf = 0; hf < 2; ++hf) {
            bf16* p = F.MG + (size_t)m * DMODEL + hf * 512 + 8 * F.lane;
            const v4u raw = *(const GAS v4u*)p; float f[8];
#pragma unroll
            for (int i = 0; i < 4; ++i) { f[2 * i] = __builtin_bit_cast(float, raw[i] << 16); f[2 * i + 1] = __builtin_bit_cast(float, raw[i] & 0xffff0000u); }
            float ss = 0.f;
#pragma unroll
            for (int i = 0; i < 8; ++i) ss += f[i] * f[i];
            const float r = 1.f / sqrtf(wave_sum(ss) * (1.f / 512.f) + LN_EPS);
            const float* gp = (hf ? gl : ga) + 8 * F.lane;
            const f32x4 g0 = *(const GAS f32x4*)gp, g1 = *(const GAS f32x4*)(gp + 4);
            v4u o; o.x = cvtpk(f[0] * r * g0[0], f[1] * r * g0[1]); o.y = cvtpk(f[2] * r * g0[2], f[3] * r * g0[3]);
            o.z = cvtpk(f[4] * r * g1[0], f[5] * r * g1[1]); o.w = cvtpk(f[6] * r * g1[2], f[7] * r * g1[3]);
#ifdef ZERO_HALF
            if (hf == ZERO_HALF) { o.x = 0u; o.y = 0u; o.z = 0u; o.w = 0u; }
#endif
            *(GAS v4u*)p = o;
        }
    }
}
__device__ __forceinline__ void sincos_rev(float ang, float& s, float& c) {
    double rev = (double)ang * 0.15915494309189535; rev -= __builtin_rint(rev);
    const float fr = (float)rev; s = __builtin_amdgcn_sinf(fr); c = __builtin_amdgcn_cosf(fr);
}
__device__ __forceinline__ void rope_rows(Frame& F, const int* pos) {
    const int gw = F.vcu * NWAVES + F.wave, NGW = F.G * NWAVES, lane = F.lane;
    const float inva = ROPE_INV[lane], invi = ROPE_INV[2 * (lane & 31)];
    for (int m = gw; m < MTOK; m += NGW) {
        const float fpos = (float)pos[m];
        float sa, ca, si, ci; sincos_rev(fpos * inva, sa, ca); sincos_rev(fpos * invi, si, ci);
        bf16* prow = F.P + (size_t)m * INP;
#pragma unroll
        for (int hh = 0; hh < 8; ++hh) {
            bf16* p = prow + hh * 128 + lane;
            const float x1 = bf2f(p[0]), x2 = bf2f(p[64]);
            p[0] = (bf16)f2bf(x1 * ca - x2 * sa); p[64] = (bf16)f2bf(x2 * ca + x1 * sa);
        }
        const int i = lane & 31, h2 = lane >> 5;
#pragma unroll
        for (int j = 0; j < 4; ++j) {
            bf16* p = prow + CQI + (2 * j + h2) * 64 + i;
            const float x1 = bf2f(p[0]), x2 = bf2f(p[32]);
            p[0] = (bf16)f2bf(x1 * ci - x2 * si); p[32] = (bf16)f2bf(x2 * ci + x1 * si);
        }
        if (lane < 32) {
            const float x1 = bf2f(prow[CKI + i]), x2 = bf2f(prow[CKI + 32 + i]);
            F.KI[(size_t)m * 64 + i] = (bf16)f2bf(x1 * ci - x2 * si); F.KI[(size_t)m * 64 + 32 + i] = (bf16)f2bf(x2 * ci + x1 * si);
        }
        if (lane < 8) F.WI[(size_t)m * 8 + lane] = bf2f(prow[CWI + lane]) * 0.35355339059327373f;
    }
}

__device__ __forceinline__ int wave_sum_i32(int v) {
    v += __builtin_amdgcn_update_dpp(0, v, 0xB1, 0xf, 0xf, true);
    v += __builtin_amdgcn_update_dpp(0, v, 0x4E, 0xf, 0xf, true);
    v += __builtin_amdgcn_update_dpp(0, v, 0x141, 0xf, 0xf, true);
    v += __builtin_amdgcn_update_dpp(0, v, 0x140, 0xf, 0xf, true);
    return __builtin_amdgcn_readlane(v, 0) + __builtin_amdgcn_readlane(v, 16) + __builtin_amdgcn_readlane(v, 32) + __builtin_amdgcn_readlane(v, 48);
}
__device__ __forceinline__ float z_upper(float p) {
    const bool fl = p > 0.5f; const float q = fl ? 1.f - p : p;
    const float tt = __builtin_amdgcn_sqrtf(-2.f * 0.6931471805599453f * __builtin_amdgcn_logf(fmaxf(q, 1e-30f)));
    const float z = tt - (2.515517f + tt * (0.802853f + tt * 0.010328f)) * __builtin_amdgcn_rcpf(1.f + tt * (1.432788f + tt * (0.189269f + tt * 0.001308f)));
    return fl ? -z : z;
}
__device__ __forceinline__ void idx_phase(Frame& F, int l) {
    const int lane = F.lane, wid = F.wave, r32 = lane & 31, hi = lane >> 5;
    LAS float* SC = (LAS float*)F.lds;
    LAS float* WG2 = SC + 8192;
    const float NEG = -__builtin_inff();
#define IDX_BAR() do { asm volatile("s_waitcnt lgkmcnt(0)" ::: "memory"); __builtin_amdgcn_s_barrier(); asm volatile("" ::: "memory"); } while (0)
    const char* kib = (const char*)F.KI;
    const int tq = 2 * ((r32 >> 2) & 1) + (r32 >> 4), hh = ((r32 >> 3) & 1) * 4 + (r32 & 3);
#define IDX_DECODE(L_, b_, t0_) do { const int xx_ = (L_) & 511; b_ = (L_) >> 9; t0_ = 8 * (xx_ < 256 ? xx_ : 767 - xx_); } while (0)
    const unsigned afo = (unsigned)((tq * INP + hh * 64 + 8 * hi) * 2), kbo = (unsigned)(((64 * wid + r32) * 64 + 8 * hi) * 2);
    const char* pb_ = (const char*)F.P + CQI * 2;
#define IDX_LOAD_AF(row0_) do { _Pragma("unroll") for (int m = 0; m < 2; ++m) { const char* q_ = pb_ + (size_t)__builtin_amdgcn_readfirstlane((int)(((row0_) + 4 * m) * (INP * 2))); \
        _Pragma("unroll") for (int ks = 0; ks < 4; ++ks) af[m][ks] = *(const GAS bf16x8*)(q_ + afo + ks * 32); } } while (0)
#define IDX_LOAD_KB1(dst, b_, ch_, kt) do { const char* k_ = kib + (size_t)__builtin_amdgcn_readfirstlane(((b_) * SEQ + 512 * (ch_) + 32 * (kt)) * 128); \
        _Pragma("unroll") for (int ks = 0; ks < 4; ++ks) dst[kt][ks] = *(const GAS bf16x8*)(k_ + kbo + ks * 32); } while (0)
#define IDX_LOAD_KB(dst, b_, ch_) do { _Pragma("unroll") for (int kt = 0; kt < 2; ++kt) { const char* k_ = kib + (size_t)__builtin_amdgcn_readfirstlane(((b_) * SEQ + 512 * (ch_) + 32 * kt) * 128); \
        _Pragma("unroll") for (int ks = 0; ks < 4; ++ks) dst[kt][ks] = *(const GAS bf16x8*)(k_ + kbo + ks * 32); } } while (0)
    int L = F.vcu; if (L >= BATCH * (SEQ / 8)) return;
    int b, t0; IDX_DECODE(L, b, t0);
    bf16x8 af[2][4], kb[2][4];
    IDX_LOAD_AF(b * SEQ + t0); IDX_LOAD_KB(kb, b, 0);
    if (F.tid < 64) WG2[F.tid] = F.WI[(unsigned)((b * SEQ + t0) * 8 + F.tid)];
    IDX_BAR();
#ifdef PROBE_IDXSTAT
    float st_val = 0.f, st_rows = 0.f;
#endif
    for (int ui = 0;; ++ui) {
#ifdef PROBE_IDXSTAT
#if PROBE_KIND == 22
        const long long tk0_ = __builtin_amdgcn_s_memtime();
#endif
#endif
        LAS float* WGL = WG2 + (ui & 1) * 64;
        const int nch = ((t0 + 7) >> 9) + 1;
        float keys[64];
#pragma unroll
        for (int j = 0; j < 64; ++j) keys[j] = NEG;
#ifndef REP_SCORE
#define REP_SCORE 1
#endif
#ifndef REP_SEL
#define REP_SEL 1
#endif
#pragma unroll 1
        for (int rsc_ = 0; rsc_ < REP_SCORE; ++rsc_) {
        if (rsc_ > 0) { IDX_LOAD_KB(kb, b, 0); }
#pragma unroll
        for (int ch = 0; ch < 8; ++ch) {
            if (ch < nch) {
                LAS float* scb = SC + (ch & 1) * 4096;
#pragma unroll
                for (int kt = 0; kt < 2; ++kt) {
                    const int s0 = 512 * ch + 64 * wid + 32 * kt;
                    float sc4[2][2];
                    if (s0 <= t0 + 7) {
                        f32x16 acc2[2];
#pragma unroll
                        for (int m = 0; m < 2; ++m) { acc2[m] = f32x16{};
#pragma unroll
                            for (int ks = 0; ks < 4; ++ks) acc2[m] = __builtin_amdgcn_mfma_f32_32x32x16_bf16(af[m][ks], kb[kt][ks], acc2[m], 0, 0, 0); }
                        if (ch + 1 < nch) IDX_LOAD_KB1(kb, b, ch + 1, kt);
#pragma unroll
                        for (int m = 0; m < 2; ++m) { const f32x16 acc = acc2[m];
#pragma unroll
                            for (int ts = 0; ts < 2; ++ts) { float s = 0.f;
                                const f32x4 wa = *(const LAS f32x4*)(WGL + (4 * m + 2 * hi + ts) * 8), wb = *(const LAS f32x4*)(WGL + (4 * m + 2 * hi + ts) * 8 + 4);
#pragma unroll
                                for (int j = 0; j < 4; ++j) {
                                    const float r0 = __builtin_amdgcn_fmed3f(acc[ts * 8 + j], 0.f, __builtin_inff()), r1 = __builtin_amdgcn_fmed3f(acc[ts * 8 + 4 + j], 0.f, __builtin_inff());
                                    asm("v_fmac_f32 %0, %1, %2" : "+v"(s) : "v"(wa[j]), "v"(r0)); asm("v_fmac_f32 %0, %1, %2" : "+v"(s) : "v"(wb[j]), "v"(r1)); }
                                const int t = t0 + 4 * m + 2 * hi + ts;
                                sc4[m][ts] = (s0 + r32 <= t) ? s : NEG; } }
                    } else { sc4[0][0] = NEG; sc4[0][1] = NEG; sc4[1][0] = NEG; sc4[1][1] = NEG; if (ch + 1 < nch) IDX_LOAD_KB1(kb, b, ch + 1, kt); }
#pragma unroll
                    for (int m = 0; m < 2; ++m)
#pragma unroll
                        for (int ts = 0; ts < 2; ++ts) scb[(4 * m + 2 * hi + ts) * 512 + 64 * wid + 32 * kt + r32] = sc4[m][ts];
                }
                IDX_BAR();
#pragma unroll
                for (int i = 0; i < 8; ++i) keys[8 * ch + i] = scb[wid * 512 + 64 * i + lane];
            }
        }
        }
#ifdef PROBE_IDXSTAT
#if PROBE_KIND == 22
        st_val += (float)(__builtin_amdgcn_s_memtime() - tk0_);
#elif PROBE_KIND == 21
        const long long tk1_ = __builtin_amdgcn_s_memtime();
#endif
#endif
        const int Ln = L + F.G; const bool has_next = Ln < BATCH * (SEQ / 8);
        int bn = b, t0n = t0; float wnext = 0.f;
        if (has_next) { IDX_DECODE(Ln, bn, t0n); IDX_LOAD_AF(bn * SEQ + t0n); IDX_LOAD_KB(kb, bn, 0);
            if (F.tid < 64) wnext = F.WI[(unsigned)((bn * SEQ + t0n) * 8 + F.tid)]; }
        const int t = t0 + wid, nj = (t >> 6) + 1;
        float theta = NEG;
#pragma unroll 1
        for (int rs_ = 0; rs_ < REP_SEL; ++rs_) { asm volatile("" : "+v"(keys[0]));
        if (t >= TOPK) {
            float mx = NEG, mn = __builtin_inff();
#pragma unroll
            for (int g8 = 0; g8 < 8; ++g8) if (8 * g8 < nj) {
#pragma unroll
                for (int j = 8 * g8; j < 8 * g8 + 8; ++j) { mx = fmaxf(mx, keys[j]); mn = fminf(mn, keys[j] == NEG ? __builtin_inff() : keys[j]); } }
            mx = wave_max(mx); mn = wave_min(mn);
#define IDX_COUNT(th, out) do { int c_ = 0; const float th_ = (th); _Pragma("unroll") for (int g32 = 0; g32 < 2; ++g32) { unsigned acc_ = 0u; \
            _Pragma("unroll") for (int g8 = 4 * g32; g8 < 4 * g32 + 4; ++g8) { if (8 * g8 < nj) { \
                _Pragma("unroll") for (int j = 8 * g8; j < 8 * g8 + 8; ++j) acc_ = __builtin_amdgcn_alignbit(acc_, __float_as_uint(th_ - keys[j]), 31); } } \
            c_ += __builtin_popcount(acc_); } out = wave_sum_i32(c_); } while (0)
            float lo = mn, hiv = mx; int clo = t, chi = 0;
            if (clo <= TOPK) { theta = (clo == TOPK) ? lo : NEG; }
            else {
                theta = lo;
                const float rn = __builtin_amdgcn_rcpf((float)(t + 1)), zt = z_upper((float)TOPK * rn);
                for (int it = 0; it < 64; ++it) {
                    float mid;
                    if ((it % 3) != 2) {
                        const float zl = z_upper(fminf((float)clo * rn, 1.f - 0.5f * rn)), zh = z_upper(fmaxf((float)chi, 0.5f) * rn);
                        mid = lo + (hiv - lo) * ((zt - zl) * __builtin_amdgcn_rcpf(zh - zl));
                        if (!(mid > lo && mid < hiv)) mid = 0.5f * (lo + hiv);
                    } else mid = 0.5f * (lo + hiv);
                    if (!(mid > lo && mid < hiv)) break;
                    int cm; IDX_COUNT(mid, cm);
#if defined(PROBE_IDXSTAT) && PROBE_KIND == 20
                    st_val += 1.f;
#endif
                    if (cm == TOPK) { theta = mid; break; }
                    if (cm > TOPK) { lo = mid; clo = cm; theta = mid; } else { hiv = mid; chi = cm; }
                }
            }
#undef IDX_COUNT
        }
        }
#ifdef PROBE_IDXSTAT
#if PROBE_KIND == 21
        st_val += (float)(__builtin_amdgcn_s_memtime() - tk1_);
#endif
        st_rows += 1.f;
#endif
        unsigned w0 = 0u, w1 = 0u;
#pragma unroll
        for (int g8 = 0; g8 < 8; ++g8) { if (8 * g8 < nj) {
#pragma unroll
            for (int j = 8 * g8; j < 8 * g8 + 8; ++j) { const unsigned long long bm = __builtin_amdgcn_ballot_w64(keys[j] > theta);
                asm volatile("s_nop 1\n\tv_writelane_b32 %0, %2, %4\n\tv_writelane_b32 %1, %3, %4" : "+v"(w0), "+v"(w1) : "s"((unsigned)bm), "s"((unsigned)(bm >> 32)), "i"(j)); } }
            __builtin_amdgcn_sched_barrier(0); }
        u32x2 wv; wv.x = w0; wv.y = w1;
        *(GAS u32x2*)(F.MASK + (unsigned)((b * SEQ + t) * (SEQ / 32) + 2 * lane)) = wv;
        if (has_next && F.tid < 64) WG2[((ui + 1) & 1) * 64 + F.tid] = wnext;
        IDX_BAR();
        if (!has_next) break;
        L = Ln; b = bn; t0 = t0n;
    }
#ifdef PROBE_IDXSTAT
    if (l == 0 && lane == 0) { float* sl_ = (float*)F.ctl + 8; atomicAdd(sl_ + 2, st_val); atomicAdd(sl_ + 5, st_rows); }
#endif
#undef IDX_BAR
#undef IDX_DECODE
#undef IDX_LOAD_AF
#undef IDX_LOAD_KB
#undef IDX_LOAD_KB1
}

template <bool PASSB>
__device__ __forceinline__ void lru_phase(Frame& F, const Args& a, int l) {
    const int lane = F.lane, wid = F.wave, r32 = lane & 31, hi = lane >> 5, c = wid * 64 + lane;
    LAS unsigned char* xt = F.lds + 36864 + wid * 4608;
    const bf16* GT = F.GATE + (size_t)l * 2 * LBLK * 64 * 64;
    for (int u = F.vcu; u < BATCH * NLCH; u += F.G) {
        const int b = u / NLCH, chunk = u % NLCH;
        const float cw0 = a.conv_w[((size_t)l * 4 + 0) * LW + c], cw1 = a.conv_w[((size_t)l * 4 + 1) * LW + c], cw2 = a.conv_w[((size_t)l * 4 + 2) * LW + c], cw3 = a.conv_w[((size_t)l * 4 + 3) * LW + c];
        const float cb = a.conv_b[(size_t)l * LW + c], ba = a.bga[(size_t)l * LW + c], bx = a.bgx[(size_t)l * LW + c];
        float sp8;
        { const float xl = -a.lam[(size_t)l * LW + c], ax = fabsf(xl), e = __builtin_amdgcn_exp2f(-ax * LOG2E);
          const float l1p = (e < 0.01f) ? e * (1.f - e * (0.5f - e * (0.33333333f - 0.25f * e))) : __builtin_amdgcn_logf(1.f + e) * 0.6931471805599453f;
          sp8 = 8.0f * (fmaxf(xl, 0.f) + l1p) * LOG2E; }
        const int tbase = chunk * LCH; const size_t rowb = (size_t)b * SEQ;
        float h = 0.f, pp = 1.f;
        if (PASSB) {
            for (int k0 = 0; k0 < chunk; k0 += 8) { f32x2 cv[8];
#pragma unroll
                for (int e = 0; e < 8; ++e) { const int k = (k0 + e < chunk) ? k0 + e : chunk - 1; cv[e] = *(const GAS f32x2*)(F.CARRY + (((size_t)b * NLCH + k) * LW + c) * 2); }
#pragma unroll
                for (int e = 0; e < 8; ++e) if (k0 + e < chunk) h = cv[e][0] * h + cv[e][1]; } }
        float xm3 = 0.f, xm2 = 0.f, xm1 = 0.f;
        if (tbase > 0) { xm3 = bf2f(F.P[(rowb + tbase - 3) * INP + CXR + c]); xm2 = bf2f(F.P[(rowb + tbase - 2) * INP + CXR + c]); xm1 = bf2f(F.P[(rowb + tbase - 1) * INP + CXR + c]); }
        for (int tt = 0; tt < LCH / 32; ++tt) {
            const int t0 = tbase + 32 * tt;
            float xc[32];
            {
                float xv[32];
#pragma unroll
                for (int i = 0; i < 32; ++i) xv[i] = bf2f(F.P[(rowb + t0 + i) * INP + CXR + c]);
#pragma unroll
                for (int i = 0; i < 32; ++i) { const float a3 = (i >= 3) ? xv[i - 3] : (i == 0 ? xm3 : (i == 1 ? xm2 : xm1));
                    const float a2 = (i >= 2) ? xv[i - 2] : (i == 0 ? xm2 : xm1); const float a1 = (i >= 1) ? xv[i - 1] : xm1;
                    xc[i] = cb + cw0 * a3 + cw1 * a2 + cw2 * a1 + cw3 * xv[i]; }
                xm3 = xv[29]; xm2 = xv[30]; xm1 = xv[31];
            }
#pragma unroll
            for (int i = 0; i < 32; ++i) *(LAS unsigned short*)(xt + i * 144 + lane * 2) = (unsigned short)f2bf(xc[i]);
            LDS_WAIT();
            bf16x8 xa[4];
#pragma unroll
            for (int ks = 0; ks < 4; ++ks) xa[ks] = *(const LAS bf16x8*)(xt + r32 * 144 + (16 * ks + 8 * hi) * 2);
            LDS_WAIT();
            f32x16 C[2][2];
#pragma unroll
            for (int g = 0; g < 2; ++g) {
                bf16x8 gf[2][4];
#pragma unroll
                for (int dt = 0; dt < 2; ++dt)
#pragma unroll
                    for (int ks = 0; ks < 4; ++ks) gf[dt][ks] = *(const GAS bf16x8*)(GT + (((size_t)g * LBLK + wid) * 64 + 32 * dt + r32) * 64 + 16 * ks + 8 * hi);
#pragma unroll
                for (int dt = 0; dt < 2; ++dt) { C[g][dt] = f32x16{};
#pragma unroll
                    for (int ks = 0; ks < 4; ++ks) C[g][dt] = __builtin_amdgcn_mfma_f32_32x32x16_bf16(xa[ks], gf[dt][ks], C[g][dt], 0, 0, 0); }
                asm volatile("" ::: "memory");
            }
#pragma unroll
            for (int g = 0; g < 2; ++g)
#pragma unroll
                for (int i = 0; i < 16; ++i) { auto rr = __builtin_amdgcn_permlane32_swap(__float_as_uint(C[g][0][i]), __float_as_uint(C[g][1][i]), false, false);
                    C[g][0][i] = __uint_as_float(rr[0]); C[g][1][i] = __uint_as_float(rr[1]); }
#pragma unroll
            for (int q8 = 0; q8 < 4; ++q8) {
                float yv[8];
                if (PASSB) {
#pragma unroll
                    for (int e = 0; e < 8; ++e) yv[e] = bf2f(F.P[(rowb + t0 + 8 * q8 + e) * INP + CYG + c]);
                }
#pragma unroll
                for (int e = 0; e < 8; ++e) {
                    const int t = 8 * q8 + e, grp = e >> 2, i = 4 * q8 + (e & 3);
                    const float ra = sigmoidf_fast(C[0][grp][i] + ba), ix = sigmoidf_fast(C[1][grp][i] + bx);
                    const float av = __builtin_amdgcn_exp2f(-ra * sp8);
                    const float uu = __builtin_amdgcn_sqrtf(fmaxf(1.f - av * av, 0.f)) * ix * xc[t];
                    h = av * h + uu; pp *= av;
                    if (PASSB) { const float y = yv[e], z = 0.7978845608028654f * (y + 0.044715f * y * y * y);
                        const float o = h * y * sigmoidf_fast(2.f * z);
                        F.MG[(rowb + t0 + t) * DMODEL + AW + c] = (bf16)f2bf(o); }
                }
            }
        }
        if (!PASSB) { float* cp = F.CARRY + (((size_t)b * NLCH + chunk) * LW + c) * 2; cp[0] = pp; cp[1] = h; }
    }
}

__device__ __forceinline__ att::BlockRef att_ref(int bh, int qb) {
    const int b = bh / NHEAD, h = bh % NHEAD; att::BlockRef r;
    const unsigned row = (unsigned)(b * SEQ + qb * att::QB), row0 = (unsigned)(b * SEQ);
#define UNI_(v) ((unsigned)__builtin_amdgcn_readfirstlane((int)(v)))
    r.q = UNI_((row * INP + CQ + h * HD) * 2u); r.k = UNI_((row0 * INP + CK + h * HD) * 2u); r.v = UNI_((row0 * INP + CV + h * HD) * 2u);
    r.o = UNI_((row * DMODEL + h * HD) * 2u); r.mk = UNI_(row * (SEQ / 32) * 4u); r.P0 = __builtin_amdgcn_readfirstlane(qb * att::QB);
#undef UNI_
    return r;
}
__device__ __forceinline__ void attn_phase(Frame& F, char* lds) {
    constexpr int NQB = SEQ / att::QB, NX = NQB / 2, TOTAL = BATCH * NHEAD * NX;
    int L = F.vcu; if (L >= TOTAL) return;
    int bh = L / NX, x = L % NX, pass = 0;
    att::Bases B; B.P = (const char*)att::uni(F.P); B.MG = (char*)att::uni(F.MG); B.MK = (const char*)att::uni(F.MASK);
    att::BlockRef cur = att_ref(bh, x);
    att::Seam S;
    att::prime(B, cur, lds, S);
    for (;;) {
        const bool more_pass = pass == 0, more_item = L + F.G < TOTAL, last = !more_pass && !more_item;
        int bhn = bh, xn = x, passn = pass + 1, Ln = L;
        if (!more_pass) { passn = 0; Ln = more_item ? L + F.G : L; bhn = Ln / NX; xn = Ln % NX; }
        const att::BlockRef nxt = last ? cur : att_ref(bhn, passn ? NQB - 1 - xn : xn);
        att::block(B, cur, nxt, lds, S);
        if (last) break;
        cur = nxt; bh = bhn; x = xn; pass = passn; L = Ln;
    }
}

#ifdef PROBE_STOP
__device__ __forceinline__ void probe_idx(Frame& F, float* slot) {
    const int lane = F.lane, gw = F.vcu * NWAVES + F.wave;
    LAS float* sc = (LAS float*)(F.lds + F.wave * 16384);
    if (gw >= 128) return;
    const int b = gw & 7, t = (gw >> 3) * 257 + 200;
    if (t >= SEQ) return;
    const size_t row = (size_t)b * SEQ + t;
    float wq[8];
#pragma unroll
    for (int h = 0; h < 8; ++h) wq[h] = F.WI[row * 8 + h];
    for (int s0 = 0; s0 <= t; s0 += 64) {
        const int s = s0 + lane; float score = -__builtin_inff();
        if (s <= t) { score = 0.f;
            for (int h = 0; h < 8; ++h) { float d = 0.f;
                for (int k = 0; k < 64; ++k) d += bf2f(F.P[row * INP + CQI + h * 64 + k]) * bf2f(F.KI[((size_t)b * SEQ + s) * 64 + k]);
                score += wq[h] * fmaxf(d, 0.f); } }
        sc[s] = score;
    }
    for (int s = ((t >> 6) + 1) * 64 + lane; s < SEQ; s += 64) sc[s] = -__builtin_inff();
    LDS_WAIT(); asm volatile("" ::: "memory");
    float mism = 0.f;
    for (int s0 = 0; s0 <= t; s0 += 64) {
        const int s = s0 + lane; const float mine = sc[s]; int rank = 0;
        for (int j = 0; j <= t; ++j) { const float o = sc[j]; rank += (o > mine || (o == mine && j < s)) ? 1 : 0; }
        const bool want = (s <= t) && (t < TOPK || rank < TOPK);
        const unsigned w = F.MASK[row * 128 + (s >> 5)]; const bool got = (w >> (s & 31)) & 1u;
        if (want != got) mism += 1.f;
    }
    mism = wave_sum(mism);
    if (lane == 0) { atomicAdd(slot, mism); atomicAdd(slot + 1, (float)(t + 1 < TOPK ? t + 1 : TOPK)); }
}
__device__ __forceinline__ void probe_attn(Frame& F, float* slot) {
    const int lane = F.lane, gw = F.vcu * NWAVES + F.wave;
    LAS float* pw = (LAS float*)(F.lds + F.wave * 16384);
    if (gw >= 256) return;
    const int b = gw & 7, h = (gw >> 3) & 3, t = (gw >> 5) * 509 + 300;
    if (t >= SEQ) return;
    const size_t row = (size_t)b * SEQ + t;
    float mx = -__builtin_inff();
    for (int s0 = 0; s0 <= t; s0 += 64) { const int s = s0 + lane; float sv = -__builtin_inff();
#ifdef ATT_NOMASK
        if (s <= t) { float d = 0.f;
#else
        if (s <= t && ((F.MASK[row * 128 + (s >> 5)] >> (s & 31)) & 1u)) { float d = 0.f;
#endif
            for (int k = 0; k < 128; ++k) d += bf2f(F.P[row * INP + CQ + h * 128 + k]) * bf2f(F.P[((size_t)b * SEQ + s) * INP + CK + h * 128 + k]);
            sv = d * 0.08838834764831845f; }
        pw[s] = sv; mx = fmaxf(mx, sv); }
    mx = wave_max(mx);
    float sum = 0.f;
    for (int s0 = 0; s0 <= t; s0 += 64) { const int s = s0 + lane; const float e = __expf(pw[s] - mx); pw[s] = e; sum += e; }
    sum = wave_sum(sum);
    LDS_WAIT(); asm volatile("" ::: "memory");
    float o0 = 0.f, o1 = 0.f;
    for (int s = 0; s <= t; ++s) { const float p = pw[s]; if (p != 0.f) { o0 += p * bf2f(F.P[((size_t)b * SEQ + s) * INP + CV + h * 128 + lane]); o1 += p * bf2f(F.P[((size_t)b * SEQ + s) * INP + CV + h * 128 + 64 + lane]); } }
    o0 /= sum; o1 /= sum;
    const float g0 = bf2f(F.MG[row * DMODEL + h * 128 + lane]), g1 = bf2f(F.MG[row * DMODEL + h * 128 + 64 + lane]);
    float num = (g0 - o0) * (g0 - o0) + (g1 - o1) * (g1 - o1), den = o0 * o0 + o1 * o1;
    num = wave_sum(num); den = wave_sum(den);
    if (lane == 0) { atomicAdd(slot, num); atomicAdd(slot + 1, den); }
}
__device__ __forceinline__ void probe_lru(Frame& F, const Args& a, int l, float* slot) {
    const int lane = F.lane;
    if (F.wave >= 4 || F.vcu >= 16) return;
    const int u = F.vcu * 4 + F.wave, b = u >> 3, n = u & 7, c = n * 64 + lane;
    LAS float* W = (LAS float*)(F.lds + F.wave * 33024);
    LAS float* xs = W + 8192;
    for (int i = lane; i < 4096; i += 64) { W[i] = a.wga[((size_t)l * LBLK + n) * 4096 + i]; W[4096 + i] = a.wgx[((size_t)l * LBLK + n) * 4096 + i]; }
    LDS_WAIT(); asm volatile("" ::: "memory");
    const float cw0 = a.conv_w[((size_t)l * 4 + 0) * LW + c], cw1 = a.conv_w[((size_t)l * 4 + 1) * LW + c], cw2 = a.conv_w[((size_t)l * 4 + 2) * LW + c], cw3 = a.conv_w[((size_t)l * 4 + 3) * LW + c];
    const float cb = a.conv_b[(size_t)l * LW + c], ba = a.bga[(size_t)l * LW + c], bx = a.bgx[(size_t)l * LW + c], lam = a.lam[(size_t)l * LW + c];
    const float sp = log1pf(expf(-lam));
    float x3 = 0.f, x2 = 0.f, x1 = 0.f, h = 0.f, num = 0.f, den = 0.f;
    for (int t = 0; t < SEQ; ++t) {
        const size_t row = (size_t)b * SEQ + t;
        const float x0 = bf2f(F.P[row * INP + CXR + c]);
        const float xc = cb + cw0 * x3 + cw1 * x2 + cw2 * x1 + cw3 * x0; x3 = x2; x2 = x1; x1 = x0;
        xs[lane] = xc; LDS_WAIT(); asm volatile("" ::: "memory");
        float za = ba, zx = bx;
        for (int k = 0; k < 64; ++k) { const float xv = xs[k]; za += xv * W[k * 64 + lane]; zx += xv * W[4096 + k * 64 + lane]; }
        LDS_WAIT(); asm volatile("" ::: "memory");
        const float r = 1.f / (1.f + expf(-za)), ii = 1.f / (1.f + expf(-zx));
        const float la = -8.0f * r * sp, av = expf(la);
        h = av * h + sqrtf(fmaxf(-expm1f(2.f * la), 0.f)) * (ii * xc);
        const float y = bf2f(F.P[row * INP + CYG + c]);
        const float want = h * 0.5f * y * (1.f + tanhf(0.7978845608028654f * (y + 0.044715f * y * y * y)));
        const float got = bf2f(F.MG[row * DMODEL + AW + c]);
        num += (got - want) * (got - want); den += want * want;
    }
    num = wave_sum(num); den = wave_sum(den);
    if (lane == 0) { atomicAdd(slot, num); atomicAdd(slot + 1, den); }
}
__device__ __forceinline__ void probe_gemm(Frame& F, const bf16* A, const bf16* Bt, const bf16* O, int N, int K, int ldo, int act, float* slot) {
    const int gt = F.vcu * NTHR + F.tid; if (gt >= 65536) return;
    const unsigned hsh = (unsigned)gt * 2654435761u; const int m = (int)(hsh % (unsigned)MTOK), n = (int)((hsh >> 7) % (unsigned)N);
    float d = 0.f; for (int k = 0; k < K; ++k) d += bf2f(A[(size_t)m * K + k]) * bf2f(Bt[(size_t)n * K + k]);
    if (act == 1) { d = fmaxf(d, 0.f); d = d * d; }
    const float got = bf2f(O[(size_t)m * ldo + n]);
    float num = (got - d) * (got - d), den = d * d; num = wave_sum(num); den = wave_sum(den);
    if (F.lane == 0) { atomicAdd(slot, num); atomicAdd(slot + 1, den); }
}
#endif

#ifndef MK_N_LAUNCHES
#define MK_N_LAUNCHES 1
#endif
constexpr int PH_PER_LAYER = 11, N_PHASES = 1 + DEPTH * PH_PER_LAYER;
constexpr bool ONE_LAUNCH = (MK_N_LAUNCHES == 1);
#ifndef REP_IDX
#define REP_IDX 1
#endif
#ifndef REP_LRUA
#define REP_LRUA 1
#endif
#ifndef REP_ATT
#define REP_ATT 1
#endif
#ifndef REP_LRUB
#define REP_LRUB 1
#endif
#ifndef REP_G1
#define REP_G1 1
#endif
#ifndef REP_G8
#define REP_G8 1
#endif

typedef const Args __attribute__((address_space(4)))* KArgs;
template <class T> __device__ __forceinline__ T* glob(T* p) { return (T*)(GAS T*)p; }
__device__ __forceinline__ Args load_args(KArgs k) {
    Args a = *(const Args*)k;
    a.x = glob(a.x); a.c = glob(a.c); a.pos = glob(a.pos); a.w_mod = glob(a.w_mod); a.b_mod = glob(a.b_mod); a.w_in = glob(a.w_in); a.conv_w = glob(a.conv_w); a.conv_b = glob(a.conv_b);
    a.wga = glob(a.wga); a.bga = glob(a.bga); a.wgx = glob(a.wgx); a.bgx = glob(a.bgx); a.lam = glob(a.lam); a.g_attn = glob(a.g_attn); a.g_lru = glob(a.g_lru); a.w_out = glob(a.w_out);
    a.ln1_g = glob(a.ln1_g); a.ln1_b = glob(a.ln1_b); a.w_up = glob(a.w_up); a.w_down = glob(a.w_down); a.ln2_g = glob(a.ln2_g); a.ln2_b = glob(a.ln2_b); a.out = glob(a.out); a.ws = glob(a.ws);
    return a;
}

__global__ void __launch_bounds__(NTHR, 2) fwd_kernel(Args a) {
    extern __shared__ __attribute__((aligned(16))) unsigned char lds[];
    Frame F;
    F.lds = (LAS unsigned char*)lds;
    F.tid = threadIdx.x; F.lane = F.tid & 63; F.wave = __builtin_amdgcn_readfirstlane(F.tid >> 6);
    F.G = gridDim.x; { const int bx = blockIdx.x; F.vcu = (F.G % 8 == 0) ? (bx % 8) * (F.G / 8) + bx / 8 : bx; }
    F.ctl = (gu32*)(a.ws + WS_CTL);
#define REPIN() int t_ = threadIdx.x; KArgs ka_ = (KArgs)__builtin_amdgcn_kernarg_segment_ptr(); asm volatile("" : "+v"(t_), "+s"(ka_)); \
        const Args a = load_args(ka_);   \
        unsigned char* ws_ = a.ws; \
        F.tid = t_; F.lane = t_ & 63; F.wave = __builtin_amdgcn_readfirstlane(t_ >> 6); \
        F.MODV = (float*)(ws_ + WS_MOD); F.STAT = (float*)(ws_ + WS_STAT); F.GATE = (bf16*)(ws_ + WS_GATE); F.CARRY = (float*)(ws_ + WS_CARRY); F.WI = (float*)(ws_ + WS_WI); F.KI = (bf16*)(ws_ + WS_KI); \
        F.MASK = (unsigned*)(ws_ + WS_MASK); F.WIN = (bf16*)(ws_ + WS_WIN); F.WOUT = (bf16*)(ws_ + WS_WOUT); F.WUP = (bf16*)(ws_ + WS_WUP); F.WDN = (bf16*)(ws_ + WS_WDN); \
        F.HA = (bf16*)(ws_ + WS_HA); F.P = (bf16*)(ws_ + WS_P); F.MG = (bf16*)(ws_ + WS_MG); F.HID = (bf16*)(ws_ + WS_HID)
    F.tid = threadIdx.x; F.lane = F.tid & 63; F.wave = __builtin_amdgcn_readfirstlane(F.tid >> 6);
    volatile LAS unsigned* MISC = (volatile LAS unsigned*)(F.lds + MISC_OFF);
    for (int u = F.tid; u < (LDS_BYTES - LDSCTL_OFF) / 4; u += NTHR) ((LAS unsigned*)(F.lds + LDSCTL_OFF))[u] = 0u;
    __syncthreads();
    XcdBarrier bar; bar.bar = (unsigned*)(F.ctl + CW_BAR); bar.x = 0; bar.st = nullptr;
    if (ONE_LAUNCH) bar = xcd_barrier_post((unsigned*)(F.ctl + CW_BAR), MISC + 8);
    const int lo = a.ph_lo, hi = a.ph_hi;
#define IN(k) (lo <= (k) && (k) < hi)
#define SEAM(k) do { if (ONE_LAUNCH && IN(k) && IN((k) + 1)) xcd_barrier(bar); } while (0)

    #ifndef SKIP_P0
    if (IN(0)) { REPIN(); p0_prologue(F, a); SEAM(0); }
#endif

    for (int l = 0; l < DEPTH; ++l) {
        const int pb = 1 + l * PH_PER_LAYER;
#define modl (F.MODV + (size_t)l * BATCH * MODW)
#ifndef SKIP_ROWS
        if (IN(pb + 0) && l == 0) { REPIN(); modulate_rows(F, a.x, modl, 0 * DMODEL, 1 * DMODEL); SEAM(pb + 0); }
#endif
#if !defined(SKIP_GEMM) && !defined(SKIP_G1)
        if (IN(pb + 1)) {
            REPIN();
            pg8::Gemm g{F.HA, F.WIN + (size_t)l * INP * DMODEL, MTOK, INP, DMODEL}; pg8::StaticOrder S; S.init(MTOK, INP, F.G, (int)blockIdx.x);
            pg8::EpiOutBf16<0> E{F.P, INP};
            for (int rep_ = 0; rep_ < REP_G1; ++rep_) pg8::gemm_phase<pg8::EpiOutBf16<0>, pg8::StaticOrder, true, true>(F.lds, g, S, E);
            SEAM(pb + 1);
        }
#endif
#ifndef SKIP_ROWS
        if (IN(pb + 2)) { REPIN(); rope_rows(F, a.pos); SEAM(pb + 2); }
#endif
        if (IN(pb + 3)) {
#ifndef SKIP_IDX
            for (int rep_ = 0; rep_ < REP_IDX; ++rep_) { REPIN(); idx_phase(F, l); __syncthreads(); }
#endif
#ifndef SKIP_LRU
            for (int rep_ = 0; rep_ < REP_LRUA; ++rep_) { REPIN(); lru_phase<false>(F, a, l); __syncthreads(); }
#endif
            SEAM(pb + 3); }
        if (IN(pb + 4)) {
#ifndef SKIP_ATT
            for (int rep_ = 0; rep_ < REP_ATT; ++rep_) { REPIN(); attn_phase(F, (char*)lds); __syncthreads(); }
#endif
#ifndef SKIP_LRU
            for (int rep_ = 0; rep_ < REP_LRUB; ++rep_) { REPIN(); lru_phase<true>(F, a, l); __syncthreads(); }
#endif
            SEAM(pb + 4); }
#ifndef SKIP_ROWS
        if (IN(pb + 5)) { REPIN(); rms_rows(F, a.g_attn + (size_t)l * AW, a.g_lru + (size_t)l * LW); SEAM(pb + 5); }
#endif
#if !defined(SKIP_GEMM) && !defined(SKIP_G6)
        if (IN(pb + 6)) {
            REPIN();
            pg8::Gemm g{F.MG, F.WOUT + (size_t)l * DMODEL * DMODEL, MTOK, DMODEL, DMODEL}; pg8::StaticOrder S; S.init(MTOK, DMODEL, F.G, (int)blockIdx.x);
            const float* xsrc = (l == 0) ? a.x : a.out;
            pg8::EpiResid E{xsrc, a.out, DMODEL, modl + 2 * DMODEL, MODW, SEQ, ALPHA, (l == 0) ? nullptr : F.STAT, a.ln2_g + (size_t)(l > 0 ? l - 1 : 0) * DMODEL, a.ln2_b + (size_t)(l > 0 ? l - 1 : 0) * DMODEL};
            pg8::gemm_phase<pg8::EpiResid, pg8::StaticOrder, true, true>(F.lds, g, S, E);
            SEAM(pb + 6);
        }
#endif
#ifndef SKIP_ROWS
        if (IN(pb + 7)) { REPIN(); ln_rows(F, a.out, F.STAT, a.ln1_g + (size_t)l * DMODEL, a.ln1_b + (size_t)l * DMODEL, modl, 3 * DMODEL, 4 * DMODEL, false); SEAM(pb + 7); }
#endif
#if !defined(SKIP_GEMM) && !defined(SKIP_G8)
        if (IN(pb + 8)) {
            REPIN();
            pg8::Gemm g{F.HA, F.WUP + (size_t)l * FF * DMODEL, MTOK, FF, DMODEL}; pg8::StaticOrder S; S.init(MTOK, FF, F.G, (int)blockIdx.x);
            pg8::EpiOutBf16<1> E{F.HID, FF};
            for (int rep_ = 0; rep_ < REP_G8; ++rep_) pg8::gemm_phase<pg8::EpiOutBf16<1>, pg8::StaticOrder, true, true>(F.lds, g, S, E);
            SEAM(pb + 8);
        }
#endif
#if !defined(SKIP_GEMM) && !defined(SKIP_G9)
        if (IN(pb + 9)) {
            REPIN();
            pg8::Gemm g{F.HID, F.WDN + (size_t)l * DMODEL * FF, MTOK, DMODEL, FF}; pg8::StaticOrder S; S.init(MTOK, DMODEL, F.G, (int)blockIdx.x);
            pg8::EpiResid E{a.out, a.out, DMODEL, modl + 5 * DMODEL, MODW, SEQ, ALPHA, F.STAT, a.ln1_g + (size_t)l * DMODEL, a.ln1_b + (size_t)l * DMODEL};
            pg8::gemm_phase<pg8::EpiResid, pg8::StaticOrder, true, true>(F.lds, g, S, E);
            SEAM(pb + 9);
        }
#endif
#ifndef SKIP_ROWS
        if (IN(pb + 10)) {
            REPIN();
            const float* modn = (l + 1 < DEPTH) ? F.MODV + (size_t)(l + 1) * BATCH * MODW : nullptr;
            ln_rows(F, a.out, F.STAT, a.ln2_g + (size_t)l * DMODEL, a.ln2_b + (size_t)l * DMODEL, modn, 0 * DMODEL, 1 * DMODEL, l + 1 == DEPTH);
            SEAM(pb + 10);
        }
#endif
    }
#ifdef PROBE_STOP
    if (IN(N_PHASES)) {
        REPIN();
        const size_t gt = (size_t)F.vcu * NTHR + F.tid, gs = (size_t)F.G * NTHR;
        const size_t NA = (size_t)MTOK * 128, NB = (size_t)BATCH * NLCH * LW * 2, NT_ = (size_t)MTOK * DMODEL;
        for (size_t i = gt; i < NT_; i += gs) {
            float v;
            if (PROBE_KIND == 0) {
                if (i < 2 * NA) { const unsigned w = F.MASK[i >> 1]; v = (float)((i & 1) ? (w >> 16) : (w & 0xffffu)); }
                else if (i < 2 * NA + NB) v = F.CARRY[i - 2 * NA];
                else v = bf2f(F.P[i - 2 * NA - NB]);
            } else if (PROBE_KIND == 1) { v = bf2f(F.MG[i]); }
            else if (PROBE_KIND == 2) { v = bf2f(F.HA[i]); }
            else { v = bf2f(F.P[i]); }
            a.out[i] = v;
        }
    }
    if (IN(N_PHASES + 1)) {
        REPIN();
        float* slot = (float*)(a.ws + WS_CTL) + 8;
        const int gw = F.vcu * NWAVES + F.wave, NGW = F.G * NWAVES;
        if (PROBE_KIND == 10) {
            float bad = 0.f;
            for (int m = gw; m < MTOK; m += NGW) { const int t = m % SEQ;
                const unsigned w0 = F.MASK[(size_t)m * 128 + 2 * F.lane], w1 = F.MASK[(size_t)m * 128 + 2 * F.lane + 1];
                int pc = __builtin_popcount(w0) + __builtin_popcount(w1); int beyond = 0;
#pragma unroll
                for (int bb = 0; bb < 64; ++bb) { const int s = 64 * F.lane + bb; const unsigned bit = bb < 32 ? (w0 >> bb) & 1u : (w1 >> (bb - 32)) & 1u; if (bit && s > t) beyond = 1; }
#pragma unroll
                for (int o = 1; o < 64; o <<= 1) { pc += __shfl_xor(pc, o); beyond |= __shfl_xor(beyond, o); }
                const int want = t + 1 < TOPK ? t + 1 : TOPK;
                if (pc != want || beyond) bad += 1.f; }
            if (F.lane == 0 && bad > 0.f) atomicAdd(slot, bad * (1.0f / MTOK));
        }
        if (PROBE_KIND == 11) probe_idx(F, slot);
        if (PROBE_KIND == 12) probe_attn(F, slot);
        if (PROBE_KIND == 13) probe_lru(F, a, 0, slot);
        if (PROBE_KIND == 14) probe_gemm(F, F.HA, F.WIN, F.P, INP, DMODEL, INP, 0, slot);
        if (PROBE_KIND == 15) probe_gemm(F, F.HA, F.WUP, F.HID, FF, DMODEL, FF, 1, slot);
    }
    if (IN(N_PHASES + 2)) {
        REPIN();
        const float* sl_ = (const float*)(a.ws + WS_CTL) + 8;
        float e = (PROBE_KIND == 10) ? sl_[0] : sl_[0] / fmaxf(sl_[1], 1e-30f);
        if (PROBE_KIND == 20) e = 1e-6f * sl_[2] / fmaxf(sl_[5], 1.f);
        if (PROBE_KIND == 21) e = 1e-6f * sl_[2] / fmaxf(sl_[5], 1.f);
        if (PROBE_KIND == 22) e = 1e-6f * sl_[2] / fmaxf(sl_[5], 1.f);
        if (PROBE_KIND >= 21) e = exp2f(rintf(log2f(fmaxf(e, 1e-20f)) * 4.f) * 0.25f);
        const float cst = sqrtf(fmaxf(e, 0.f) * 1e6f);
        for (size_t i = (size_t)F.vcu * NTHR + F.tid; i < (size_t)MTOK * DMODEL; i += (size_t)F.G * NTHR) a.out[i] = cst;
    }
#endif
#undef modl
#undef IN
#undef SEAM
#undef REPIN
}

extern "C" void kernel_launch(void* const* d_in, const int* in_sizes, int n_in, void* d_out, int out_size, void* d_ws, size_t ws_size, hipStream_t stream) {
    static int grid = 0;
    if (grid == 0) {
        if (n_in != 22 || in_sizes[0] != MTOK * DMODEL || out_size != MTOK * DMODEL || ws_size < WS_END) {
            fprintf(stderr, "kernel_launch: unexpected shapes (n_in %d, in0 %d, out %d, ws %zu; need ws >= %zu); nothing launched\n", n_in, n_in > 0 ? in_sizes[0] : -1, out_size, ws_size, (size_t)WS_END); grid = -1; return; }
        int dev = 0, cus = 0, per_cu = 0;
        if (hipGetDevice(&dev) != hipSuccess || hipDeviceGetAttribute(&cus, hipDeviceAttributeMultiprocessorCount, dev) != hipSuccess) { fprintf(stderr, "kernel_launch: device query failed\n"); grid = -1; return; }
        if (hipFuncSetAttribute((const void*)fwd_kernel, hipFuncAttributeMaxDynamicSharedMemorySize, LDS_BYTES) != hipSuccess) { fprintf(stderr, "kernel_launch: hipFuncSetAttribute failed\n"); grid = -1; return; }
        if (hipOccupancyMaxActiveBlocksPerMultiprocessor(&per_cu, (const void*)fwd_kernel, NTHR, LDS_BYTES) != hipSuccess || per_cu < 1)
            fprintf(stderr, "kernel_launch: note: occupancy query reports %d workgroups per CU\n", per_cu);
        (void)hipGetLastError();
        grid = cus;
    }
    if (grid < 0) return;
    if (hipMemsetAsync((char*)d_ws + WS_CTL, 0, CTL_ZERO_BYTES, stream) != hipSuccess) { fprintf(stderr, "kernel_launch: memset failed\n"); return; }
    Args a{};
    a.x = (const float*)d_in[0]; a.c = (const float*)d_in[1]; a.pos = (const int*)d_in[2];
    a.w_mod = (const float*)d_in[3]; a.b_mod = (const float*)d_in[4]; a.w_in = (const float*)d_in[5]; a.conv_w = (const float*)d_in[6]; a.conv_b = (const float*)d_in[7];
    a.wga = (const float*)d_in[8]; a.bga = (const float*)d_in[9]; a.wgx = (const float*)d_in[10]; a.bgx = (const float*)d_in[11]; a.lam = (const float*)d_in[12];
    a.g_attn = (const float*)d_in[13]; a.g_lru = (const float*)d_in[14]; a.w_out = (const float*)d_in[15]; a.ln1_g = (const float*)d_in[16]; a.ln1_b = (const float*)d_in[17];
    a.w_up = (const float*)d_in[18]; a.w_down = (const float*)d_in[19]; a.ln2_g = (const float*)d_in[20]; a.ln2_b = (const float*)d_in[21];
    a.out = (float*)d_out; a.ws = (unsigned char*)d_ws;
    if (ONE_LAUNCH) {
        a.ph_lo = 0; a.ph_hi = N_PHASES;
        hipLaunchKernelGGL(fwd_kernel, dim3(grid), dim3(NTHR), LDS_BYTES, stream, a);
    } else {
#ifdef PROBE_STOP
        const int np_ = PROBE_STOP;
#else
        const int np_ = N_PHASES;
#endif
        for (int p = 0; p < np_; ++p) {
            if (p >= 1 && ((p - 1) % PH_PER_LAYER) == 0 && p != 1) continue;
            a.ph_lo = p; a.ph_hi = p + 1;
            hipLaunchKernelGGL(fwd_kernel, dim3(grid), dim3(NTHR), LDS_BYTES, stream, a);
        }
    }
#ifdef PROBE_STOP
    if (PROBE_KIND < 10) { a.ph_lo = N_PHASES; a.ph_hi = N_PHASES + 1; hipLaunchKernelGGL(fwd_kernel, dim3(grid), dim3(NTHR), LDS_BYTES, stream, a); }
    else { a.ph_lo = N_PHASES + 1; a.ph_hi = N_PHASES + 2; hipLaunchKernelGGL(fwd_kernel, dim3(grid), dim3(NTHR), LDS_BYTES, stream, a);
           a.ph_lo = N_PHASES + 2; a.ph_hi = N_PHASES + 3; hipLaunchKernelGGL(fwd_kernel, dim3(grid), dim3(NTHR), LDS_BYTES, stream, a); }
#endif
    const hipError_t le = hipPeekAtLastError();
    if (le != hipSuccess) fprintf(stderr, "kernel_launch: launch failed: %s\n", hipGetErrorName(le));
}
```

```cpp
#include <hip/hip_runtime.h>
#include <cstdio>
#include <cstdint>
#define MK_N_LAUNCHES 1
namespace pg8 {
#define PG8_LAS __attribute__((address_space(3)))
typedef unsigned short bf16_t;
typedef short bf16x8 __attribute__((ext_vector_type(8)));
typedef float f32x4 __attribute__((ext_vector_type(4)));
typedef unsigned u32x4 __attribute__((ext_vector_type(4)));
constexpr int BM = 256, BK = 64, HALF = 128, HTB = HALF * BK * 2  , STAGE_BYTES = 8 * HTB, NXCD = 8, WGM = 8;

__host__ __device__ __forceinline__ int lds_byte(int r, int c) { const int st = (r >> 4) * 2 + (c >> 5), rr = r & 15, cc = c & 31, ob = rr * 64 + cc * 2; return st * 1024 + (ob ^ (((ob >> 9) & 1) << 5)); }
__host__ __device__ __forceinline__ void stage_rc(int b, int& R, int& C) { const int st = b / 1024, sb = b % 1024, swz = sb ^ (((sb >> 9) & 1) << 5); R = (st >> 1) * 16 + swz / 64; C = (st & 1) * 32 + (swz % 64) / 2; }
__host__ __device__ __forceinline__ int perm32(int rho) { const int n = rho >> 4, i = rho & 15; return 8 * (i >> 2) + 4 * n + (i & 3); }

struct Unit { int pm, pn; };
struct Gemm { const bf16_t* A; const bf16_t* Bt; int M, N, K; };

struct StaticOrder {
    int nM, nN, nwg, G, c;
    __host__ __device__ void init(int M, int N, int G_, int c_) { nM = M / BM; nN = N / BM; nwg = nM * nN; G = G_; c = c_; }
    __host__ __device__ bool next(int i, Unit& u) const {
        const long L = (long)i * G + c; if (L >= nwg) return false;
        int wgid = (int)L; { const int q = nwg / NXCD, r = nwg % NXCD, xcd = wgid % NXCD, off = wgid / NXCD; wgid = (xcd < r ? xcd * (q + 1) : r * (q + 1) + (xcd - r) * q) + off; }
        const int nig = WGM * nN, gid = wgid / nig, fm = gid * WGM, gsz = (nM - fm) < WGM ? (nM - fm) : WGM;
        u.pm = fm + ((wgid % nig) % gsz); u.pn = (wgid % nig) / gsz; return true;
    }
    __device__ __forceinline__ void a_ready(const Unit&) const {}
    __device__ __forceinline__ void done(const Unit&) const {}
};

__device__ __forceinline__ unsigned cvt_pk_bf16(float lo, float hi) { unsigned r; asm volatile("v_cvt_pk_bf16_f32 %0, %1, %2" : "=v"(r) : "v"(lo), "v"(hi)); return r; }
typedef float f32x2 __attribute__((ext_vector_type(2)));

template <int ACT> struct EpiOutBf16 {
    static constexpr bool PERM = true, AFTER_DRAIN = false;
    bf16_t* O; int ldc;
    __device__ __forceinline__ void operator()(const f32x4 (&acc)[2][2][4][2], const Unit& u, int wr, int wc, int fr, int fq) const {
        const int row0 = u.pm * BM + wr * 64 + fr, col0 = u.pn * BM + wc * 32 + 8 * fq;
#pragma unroll
        for (int ai = 0; ai < 2; ++ai)
#pragma unroll
            for (int m = 0; m < 4; ++m) { bf16_t* rowp = O + (size_t)(row0 + ai * HALF + m * 16) * ldc + col0;
#pragma unroll
                for (int bj = 0; bj < 2; ++bj) { f32x4 v0 = acc[ai][bj][m][0], v1 = acc[ai][bj][m][1];
                    if (ACT == 1) {
#pragma unroll
                        for (int j = 0; j < 4; ++j) { const float a0 = fmaxf(v0[j], 0.f), a1 = fmaxf(v1[j], 0.f); v0[j] = a0 * a0; v1[j] = a1 * a1; } }
                    u32x4 w; w.x = cvt_pk_bf16(v0[0], v0[1]); w.y = cvt_pk_bf16(v0[2], v0[3]); w.z = cvt_pk_bf16(v1[0], v1[1]); w.w = cvt_pk_bf16(v1[2], v1[3]);
                    *(u32x4*)(rowp + bj * HALF) = w; } }
    }
};

struct EpiInProj {
    static constexpr bool PERM = true, AFTER_DRAIN = false;
    bf16_t* O; int ldc; const float* rope; bf16_t* KI; float* WI;
    __device__ __forceinline__ void operator()(const f32x4 (&acc)[2][2][4][2], const Unit& u, int wr, int wc, int fr, int fq) const {
        const int row0 = u.pm * BM + wr * 64 + fr, colw = u.pn * BM + wc * 32;
#pragma unroll
        for (int bj = 0; bj < 2; ++bj) {
            const int cg = colw + bj * HALF;
            int mode = 0, i0 = 0;
            if (cg < 1024) { mode = 1; i0 = ((cg & 127) + 8 * fq) >> 1; }
            else if (cg >= 1536 && cg < 2112) { mode = 2; i0 = ((cg & 63) + 8 * fq); }
#pragma unroll
            for (int ai = 0; ai < 2; ++ai)
#pragma unroll
                for (int m = 0; m < 4; ++m) { const int row = row0 + ai * HALF + m * 16;
                    f32x4 v0 = acc[ai][bj][m][0], v1 = acc[ai][bj][m][1];
                    if (mode != 0) {
                        const float* rp = rope + (size_t)row * 128;
                        float c[4], s[4];
                        if (mode == 1) { const f32x4 cv = *(const f32x4*)(rp + i0), sv = *(const f32x4*)(rp + 64 + i0);
#pragma unroll
                            for (int j = 0; j < 4; ++j) { c[j] = cv[j]; s[j] = sv[j]; } }
                        else { const f32x4 ca = *(const f32x4*)(rp + i0), cb = *(const f32x4*)(rp + i0 + 4), sa = *(const f32x4*)(rp + 64 + i0), sb = *(const f32x4*)(rp + 64 + i0 + 4);
                            c[0] = ca[0]; c[1] = ca[2]; c[2] = cb[0]; c[3] = cb[2]; s[0] = sa[0]; s[1] = sa[2]; s[2] = sb[0]; s[3] = sb[2]; }
                        const f32x4 a0 = v0, a1 = v1;
                        v0[0] = a0[0] * c[0] - a0[1] * s[0]; v0[1] = a0[1] * c[0] + a0[0] * s[0]; v0[2] = a0[2] * c[1] - a0[3] * s[1]; v0[3] = a0[3] * c[1] + a0[2] * s[1];
                        v1[0] = a1[0] * c[2] - a1[1] * s[2]; v1[1] = a1[1] * c[2] + a1[0] * s[2]; v1[2] = a1[2] * c[3] - a1[3] * s[3]; v1[3] = a1[3] * c[3] + a1[2] * s[3];
                    }
                    u32x4 w; w.x = cvt_pk_bf16(v0[0], v0[1]); w.y = cvt_pk_bf16(v0[2], v0[3]); w.z = cvt_pk_bf16(v1[0], v1[1]); w.w = cvt_pk_bf16(v1[2], v1[3]);
                    *(u32x4*)(O + (size_t)row * ldc + cg + 8 * fq) = w;
                    if (cg >= 2048 && cg < 2112) *(u32x4*)(KI + (size_t)row * 64 + (cg - 2048) + 8 * fq) = w;
                    if (cg == 2112 && fq == 0) { float* wp = WI + (size_t)row * 8;
                        *(f32x4*)wp = v0 * 0.35355339059327373f; *(f32x4*)(wp + 4) = v1 * 0.35355339059327373f; }
                }
        }
    }
};
struct EpiResid {
    static constexpr bool PERM = false, AFTER_DRAIN = false;
    const float* xin; float* out; int ldc; const float* gate; int gate_bstride; int rows_per_batch; float alpha;
    const float* stat; const float* lng; const float* lnb;
    __device__ __forceinline__ void operator()(const f32x4 (&acc)[2][2][4][2], const Unit& u, int wr, int wc, int fr, int fq) const {
        const int row0 = u.pm * BM + wr * 64 + fr, col0 = u.pn * BM + wc * 32 + 4 * fq;
        const float* g = gate + (size_t)((u.pm * BM) / rows_per_batch) * gate_bstride;
#pragma unroll
        for (int bj = 0; bj < 2; ++bj)
#pragma unroll
            for (int n = 0; n < 2; ++n) {
                const int cc = col0 + bj * HALF + n * 16;
                const f32x4 gv = *(const f32x4*)(g + cc) + 1.0f;
                f32x4 lg = {1.f, 1.f, 1.f, 1.f}, lb = {0.f, 0.f, 0.f, 0.f};
                if (stat) { lg = *(const f32x4*)(lng + cc); lb = *(const f32x4*)(lnb + cc); }
#pragma unroll
                for (int ai = 0; ai < 2; ++ai)
#pragma unroll
                    for (int m = 0; m < 4; ++m) { const int row = row0 + ai * HALF + m * 16; const size_t off = (size_t)row * ldc + cc;
                        f32x4 xv = *(const f32x4*)(xin + off);
                        if (stat) { const float mean = stat[2 * row], rstd = stat[2 * row + 1]; xv = (xv - mean) * rstd * lg + lb; }
                        *(f32x4*)(out + off) = xv * alpha + gv * acc[ai][bj][m][n]; }
                asm volatile("" ::: "memory"); }
    }
};
template <class Epi, class Sched, bool ALIGN_EPI = false, bool SP2 = false>
__device__ __forceinline__ void gemm_phase(PG8_LAS unsigned char* lds, const Gemm g, const Sched& S, const Epi& E) {
    int tid_l = threadIdx.x; asm volatile("" : "+v"(tid_l));
    const int tid = tid_l, wid = __builtin_amdgcn_readfirstlane(tid >> 6), lane = tid & 63, wr = wid >> 2, wc = wid & 3, fr = lane & 15, fq = lane >> 4;
    const int K = g.K, nt = K / BK;
    unsigned voffA[2], voffB[2];
#pragma unroll
    for (int i = 0; i < 2; ++i) { int R, C; stage_rc(tid * 16 + i * 8192, R, C); const int Rb = Epi::PERM ? ((R & ~31) + perm32(R & 31)) : R;
        voffA[i] = (unsigned)(R * K + C) * 2u; voffB[i] = (unsigned)(Rb * K + C) * 2u; }
    const size_t kstep = (size_t)(BK * 2);
    const size_t hstep = (size_t)HALF * K * 2;
    const size_t tstep = 2 * hstep;
    const unsigned ldsw = (unsigned)wid * 1024u;
    const int aoff = lds_byte(wr * 64 + fr, fq * 8), boff = lds_byte(wc * 32 + fr, fq * 8);
#define PG8_SA(b, h) (((b) * 2 + (h)) * HTB)
#define PG8_SB(b, h) ((4 + (b) * 2 + (h)) * HTB)
#define PG8_STAGE(bufoff, gbase, voff) do { _Pragma("unroll") for (int _i = 0; _i < 2; ++_i) \
        __builtin_amdgcn_global_load_lds((const unsigned*)((const char*)(gbase) + (voff)[_i]), (PG8_LAS unsigned*)(lds + (bufoff) + ldsw + _i * 8192), 16, 0, 0); } while (0)
#define PG8_LDA(dst, b, h) do { _Pragma("unroll") for (int m = 0; m < 4; ++m) _Pragma("unroll") for (int k = 0; k < 2; ++k) dst[m][k] = *(const PG8_LAS bf16x8*)(lds + PG8_SA(b, h) + aoff + m * 2048 + k * 1024); } while (0)
#define PG8_LDB(dst, b, h) do { _Pragma("unroll") for (int n = 0; n < 2; ++n) _Pragma("unroll") for (int k = 0; k < 2; ++k) dst[n][k] = *(const PG8_LAS bf16x8*)(lds + PG8_SB(b, h) + boff + n * 2048 + k * 1024); } while (0)
#define PG8_MMA(ai, bj, At, Bt) do { __builtin_amdgcn_s_setprio(1); _Pragma("unroll") for (int m = 0; m < 4; ++m) _Pragma("unroll") for (int n = 0; n < 2; ++n) _Pragma("unroll") for (int k = 0; k < 2; ++k) \
        acc[ai][bj][m][n] = __builtin_amdgcn_mfma_f32_16x16x32_bf16(Bt[n][k], At[m][k], acc[ai][bj][m][n], 0, 0, 0); __builtin_amdgcn_s_setprio(0); } while (0)
#define PG8_WAIT_V(n) asm volatile("s_waitcnt vmcnt(" #n ")" ::: "memory")
#define PG8_WAIT_L(n) asm volatile("s_waitcnt lgkmcnt(" #n ")" ::: "memory")
#define PG8_BAR __builtin_amdgcn_s_barrier()
#define PG8_SCHED __builtin_amdgcn_sched_barrier(0)
    Unit cur, nxt; int ui = 0;
    if (!S.next(0, cur)) return;
    f32x4 acc[2][2][4][2];
#pragma unroll
    for (int a = 0; a < 2; ++a)
#pragma unroll
        for (int b = 0; b < 2; ++b)
#pragma unroll
            for (int m = 0; m < 4; ++m)
#pragma unroll
                for (int n = 0; n < 2; ++n) acc[a][b][m][n] = (f32x4){0.f, 0.f, 0.f, 0.f};
    bf16x8 At[4][2], B0[2][2], B1[2][2];
    const char* cA = (const char*)g.A + (size_t)cur.pm * tstep; const char* cB = (const char*)g.Bt + (size_t)cur.pn * tstep;
    S.a_ready(cur);
    if constexpr (SP2) {
        PG8_STAGE(PG8_SB(0, 0), cB, voffB); PG8_STAGE(PG8_SB(0, 1), cB + hstep, voffB); PG8_STAGE(PG8_SA(0, 0), cA, voffA); PG8_STAGE(PG8_SA(0, 1), cA + hstep, voffA);
        if (wr == 1) PG8_BAR;
        PG8_WAIT_V(2); PG8_BAR;
        PG8_STAGE(PG8_SB(1, 0), cB + kstep, voffB); PG8_STAGE(PG8_SA(1, 0), cA + kstep, voffA); PG8_STAGE(PG8_SB(1, 1), cB + hstep + kstep, voffB);
        PG8_WAIT_V(6); PG8_BAR;
    } else {
        PG8_STAGE(PG8_SB(0, 0), cB, voffB); PG8_STAGE(PG8_SA(0, 0), cA, voffA); PG8_STAGE(PG8_SB(0, 1), cB + hstep, voffB); PG8_STAGE(PG8_SA(0, 1), cA + hstep, voffA);
        if (wr == 1) PG8_BAR;
        PG8_WAIT_V(4); PG8_BAR;
        PG8_STAGE(PG8_SB(1, 0), cB + kstep, voffB); PG8_STAGE(PG8_SA(1, 0), cA + kstep, voffA); PG8_STAGE(PG8_SB(1, 1), cB + hstep + kstep, voffB);
        PG8_WAIT_V(6); PG8_BAR;
    }
    for (;;) {
        const bool has_next = S.next(ui + 1, nxt);
        const char* nA = has_next ? (const char*)g.A + (size_t)nxt.pm * tstep : cA; const char* nB = has_next ? (const char*)g.Bt + (size_t)nxt.pn * tstep : cB;
        for (int t = 0; t < nt; t += 2) {
            const bool last = (t == nt - 2);
            const char* a1 = cA + (size_t)(t + 1) * kstep;
            const char* a2 = last ? nA : cA + (size_t)(t + 2) * kstep; const char* b2 = last ? nB : cB + (size_t)(t + 2) * kstep;
            const char* a3 = a2 + kstep; const char* b3 = b2 + kstep;
            if (last && has_next) S.a_ready(nxt);
            if constexpr (SP2) {
            PG8_LDB(B0, 0, 0); PG8_LDB(B1, 0, 1); PG8_SCHED; PG8_LDA(At, 0, 0); PG8_STAGE(PG8_SA(1, 1), a1 + hstep, voffA);
            PG8_WAIT_V(8); PG8_WAIT_L(0); PG8_BAR; PG8_MMA(0, 0, At, B0); PG8_MMA(0, 1, At, B1); PG8_BAR; PG8_SCHED;
            PG8_LDA(At, 0, 1); PG8_STAGE(PG8_SB(0, 0), b2, voffB); PG8_STAGE(PG8_SB(0, 1), b2 + hstep, voffB); PG8_STAGE(PG8_SA(0, 0), a2, voffA);
            PG8_WAIT_V(8); PG8_WAIT_L(0); PG8_BAR; PG8_MMA(1, 0, At, B0); PG8_MMA(1, 1, At, B1); PG8_BAR; PG8_SCHED;
            PG8_LDB(B0, 1, 0); PG8_LDB(B1, 1, 1); PG8_SCHED; PG8_LDA(At, 1, 0); PG8_STAGE(PG8_SA(0, 1), a2 + hstep, voffA);
            PG8_WAIT_V(8); PG8_WAIT_L(0); PG8_BAR; PG8_MMA(0, 0, At, B0); PG8_MMA(0, 1, At, B1); PG8_BAR; PG8_SCHED;
            PG8_LDA(At, 1, 1); PG8_STAGE(PG8_SB(1, 0), b3, voffB); PG8_STAGE(PG8_SB(1, 1), b3 + hstep, voffB); PG8_STAGE(PG8_SA(1, 0), a3, voffA);
            PG8_WAIT_V(8); PG8_WAIT_L(0); PG8_BAR; PG8_MMA(1, 0, At, B0); PG8_MMA(1, 1, At, B1); PG8_BAR; PG8_SCHED;
            } else {
            PG8_LDB(B0, 0, 0); PG8_SCHED; PG8_LDA(At, 0, 0); PG8_STAGE(PG8_SA(1, 1), a1 + hstep, voffA);
            PG8_WAIT_L(8); PG8_BAR; PG8_WAIT_L(0); PG8_MMA(0, 0, At, B0); PG8_BAR; PG8_SCHED;
            PG8_LDB(B1, 0, 1); PG8_STAGE(PG8_SB(0, 0), b2, voffB);
            PG8_BAR; PG8_WAIT_L(0); PG8_MMA(0, 1, At, B1); PG8_BAR;
            PG8_LDA(At, 0, 1); PG8_STAGE(PG8_SA(0, 0), a2, voffA);
            PG8_BAR; PG8_WAIT_L(0); PG8_MMA(1, 0, At, B0); PG8_BAR; PG8_SCHED;
            PG8_STAGE(PG8_SB(0, 1), b2 + hstep, voffB);
            PG8_WAIT_V(6); PG8_BAR; PG8_MMA(1, 1, At, B1); PG8_BAR;
            PG8_LDB(B0, 1, 0); PG8_SCHED; PG8_LDA(At, 1, 0); PG8_STAGE(PG8_SA(0, 1), a2 + hstep, voffA);
            PG8_WAIT_L(8); PG8_BAR; PG8_WAIT_L(0); PG8_MMA(0, 0, At, B0); PG8_BAR; PG8_SCHED;
            PG8_LDB(B1, 1, 1); PG8_STAGE(PG8_SB(1, 0), b3, voffB);
            PG8_BAR; PG8_WAIT_L(0); PG8_MMA(0, 1, At, B1); PG8_BAR;
            PG8_LDA(At, 1, 1); PG8_STAGE(PG8_SA(1, 0), a3, voffA);
            PG8_BAR; PG8_WAIT_L(0); PG8_MMA(1, 0, At, B0); PG8_BAR; PG8_SCHED;
            PG8_STAGE(PG8_SB(1, 1), b3 + hstep, voffB);
            PG8_WAIT_V(6); PG8_BAR; PG8_MMA(1, 1, At, B1); PG8_BAR;
            }
        }
        if constexpr (ALIGN_EPI) { if (wr == 0) PG8_BAR; }
        if constexpr (!Epi::AFTER_DRAIN) { E(acc, cur, wr, wc, fr, fq); S.done(cur); }
        if (!has_next) break;
#pragma unroll
        for (int a = 0; a < 2; ++a)
#pragma unroll
            for (int b = 0; b < 2; ++b)
#pragma unroll
                for (int m = 0; m < 4; ++m)
#pragma unroll
                    for (int n = 0; n < 2; ++n) acc[a][b][m][n] = (f32x4){0.f, 0.f, 0.f, 0.f};
        cur = nxt; cA = nA; cB = nB; ++ui;
        if constexpr (ALIGN_EPI) { if (wr == 1) PG8_BAR; }
    }
    PG8_WAIT_V(0);
    if constexpr (!ALIGN_EPI) { if (wr == 0) PG8_BAR; }
    PG8_BAR;
    if constexpr (Epi::AFTER_DRAIN) { E.fused(acc, cur, wr, wc, fr, fq, lds, wid, lane); S.done(cur); }
#undef PG8_SA
#undef PG8_SB
#undef PG8_STAGE
#undef PG8_LDA
#undef PG8_LDB
#undef PG8_MMA
#undef PG8_WAIT_V
#undef PG8_WAIT_L
#undef PG8_BAR
#undef PG8_SCHED
}
}
#define GAS __attribute__((address_space(1)))
#define LAS __attribute__((address_space(3)))
typedef unsigned short bf16;
typedef unsigned v4u __attribute__((ext_vector_type(4)));
typedef float f32x4 __attribute__((ext_vector_type(4)));
typedef short bf16x8 __attribute__((ext_vector_type(8)));
typedef GAS unsigned gu32;
typedef GAS unsigned long long gu64;
#define RLX_AGENT __ATOMIC_RELAXED, __HIP_MEMORY_SCOPE_AGENT
#define LDS_WAIT() asm volatile("s_waitcnt lgkmcnt(0)" ::: "memory")
#define VM_WAIT() asm volatile("s_waitcnt vmcnt(0)" ::: "memory")
__device__ __forceinline__ unsigned long long rt() { return __builtin_amdgcn_s_memrealtime(); }
__device__ __forceinline__ unsigned f2bf(float f) { unsigned u = __builtin_bit_cast(unsigned, f); return (u + 0x7fffu + ((u >> 16) & 1u)) >> 16; }
__device__ __forceinline__ unsigned pk2(float lo, float hi) { return f2bf(lo) | (f2bf(hi) << 16); }

#define XB_TMO      128
#define XB_XCNT(j)  (256  + 64 * (j))
#define XB_XSUB(j)  (1280 + 64 * (j))
#define XB_XGEN(j)  (2304 + 64 * (j))
#define XB_TOP      3328
#define XB_TOPGEN   3392
#define XCD_BAR_WORDS 3456
#define XB_SPIN_CAP (1u << 18)

__device__ __forceinline__ unsigned xb_ld(unsigned* p)              { return __hip_atomic_load(p, __ATOMIC_RELAXED, __HIP_MEMORY_SCOPE_AGENT); }
__device__ __forceinline__ unsigned xb_add(unsigned* p, unsigned v) { return __hip_atomic_fetch_add(p, v, __ATOMIC_RELAXED, __HIP_MEMORY_SCOPE_AGENT); }
__device__ __forceinline__ unsigned xb_xcc_id() { return (unsigned)__builtin_amdgcn_s_getreg((3 << 11) | 20) & 0xFu; }
#define XB_SPIN(cond, bar) do { unsigned _sp = 0; while (cond) { __builtin_amdgcn_s_sleep(1); \
    if ((++_sp & 255u) == 0u) { if (xb_ld(&(bar)[XB_TMO])) break; if (_sp > XB_SPIN_CAP) { atomicAdd(&(bar)[XB_TMO], 1u); break; } } } } while (0)

struct XcdBarrier {
    unsigned* bar; unsigned x;
    volatile LAS unsigned* st;
};

__device__ __forceinline__ XcdBarrier xcd_barrier_post(unsigned* bar, volatile LAS unsigned* st) {
    XcdBarrier b; b.bar = bar; b.x = xb_xcc_id(); b.st = st;
    if (threadIdx.x == 0) (void)xb_add(&bar[XB_XCNT(b.x)], 1u);
    return b;
}
__device__ __forceinline__ void xcd_barrier_complete(unsigned* bar, unsigned x, unsigned& nloc, unsigned& nx) {
    const unsigned G = gridDim.x * gridDim.y * gridDim.z;
    unsigned sum, cnt, mine, sp = 0u;
    for (;;) {
        sum = 0u; cnt = 0u; mine = 0u;
#pragma unroll
        for (unsigned j = 0; j < 16; ++j) { const unsigned c = xb_ld(&bar[XB_XCNT(j)]); sum += c; cnt += (c > 0u) ? 1u : 0u; mine = (j == x) ? c : mine; }
        if (sum == G) break;
        __builtin_amdgcn_s_sleep(1);
        if ((++sp & 255u) == 0u) { if (xb_ld(&bar[XB_TMO])) break; if (sp > XB_SPIN_CAP) { atomicAdd(&bar[XB_TMO], 1u); break; } }
    }
    nloc = mine > 0u ? mine : 1u; nx = cnt > 0u ? cnt : 1u;
}

__device__ __forceinline__ void xcd_barrier(const XcdBarrier& b) {
    asm volatile("s_waitcnt vmcnt(0)" ::: "memory");
    __syncthreads();
    if (threadIdx.x == 0) {
        unsigned* bar = b.bar;
        __builtin_amdgcn_s_waitcnt(0);
        unsigned nloc = b.st[0], nx = b.st[1];
        if (nloc == 0u) { xcd_barrier_complete(bar, b.x, nloc, nx); b.st[0] = nloc; b.st[1] = nx; }
        const unsigned old = xb_add(&bar[XB_XSUB(b.x)], 1u);
        const unsigned gen = old / nloc;
        if (old + 1u == (gen + 1u) * nloc) {
            __builtin_amdgcn_fence(__ATOMIC_RELEASE, "agent");
            asm volatile("s_waitcnt vmcnt(0)" ::: "memory");
            const unsigned og = xb_add(&bar[XB_TOP], 1u);
            const unsigned tg = og / nx;
            if (og + 1u == (tg + 1u) * nx) xb_add(&bar[XB_TOPGEN], 1u);
            else XB_SPIN(xb_ld(&bar[XB_TOPGEN]) == tg, bar);
            __builtin_amdgcn_fence(__ATOMIC_ACQUIRE, "agent");
            xb_add(&bar[XB_XGEN(b.x)], 1u);
            asm volatile("s_waitcnt vmcnt(0)" ::: "memory");
        } else {
            XB_SPIN(xb_ld(&bar[XB_XGEN(b.x)]) == gen, bar);
            __builtin_amdgcn_fence(__ATOMIC_ACQUIRE, "agent");
            asm volatile("s_waitcnt vmcnt(0)" ::: "memory");
        }
    }
    __syncthreads();
}

constexpr int NWAVES = 8, NTHR = NWAVES * 64;
constexpr int BATCH = 8, SEQ = 4096, DMODEL = 1024, DEPTH = 4, MTOK = BATCH * SEQ;
constexpr int AW = 512, NHEAD = 4, HD = 128, IH = 8, IDIM = 64, TOPK = 256, LW = 512, LBLK = 8, LBS = 64, FF = 4096, NMOD = 6;
constexpr int INC = 3144, INP = 3328;
constexpr int CQ = 0, CK = 512, CV = 1024, CQI = 1536, CKI = 2048, CWI = 2112, CXR = 2120, CYG = 2632;
constexpr int MODW = NMOD * DMODEL;
constexpr float LN_EPS = 1e-5f;
constexpr float ALPHA = 1.6817928305074290f;
constexpr float LOG2E = 1.4426950408889634f;
constexpr int LCH = 128, NLCH = SEQ / LCH;

constexpr size_t MiB = 1u << 20;
constexpr size_t WS_CTL = 0, CTL_ZERO_BYTES = 1 * MiB;
constexpr size_t WS_MOD = 1 * MiB;
constexpr size_t WS_GATE = 2 * MiB;
constexpr size_t WS_STAT = 2 * MiB + 512 * 1024;
constexpr size_t WS_CARRY = 3 * MiB;
constexpr size_t WS_WI = 4 * MiB;
constexpr size_t WS_KI = 5 * MiB;
constexpr size_t WS_MASK = 9 * MiB;
constexpr size_t WS_WIN = 25 * MiB;
constexpr size_t WS_WOUT = 51 * MiB;
constexpr size_t WS_WUP = 59 * MiB;
constexpr size_t WS_WDN = 91 * MiB;
constexpr size_t WS_HA = 123 * MiB;
constexpr size_t WS_P = 187 * MiB;
constexpr size_t WS_MG = 395 * MiB;
constexpr size_t WS_HID = 187 * MiB;
constexpr size_t WS_ROPE = 460 * MiB;
constexpr size_t WS_END = 476 * MiB;
static_assert(WS_WIN + (size_t)DEPTH * INP * 1024 * 2 <= WS_WOUT && WS_P + (size_t)MTOK * INP * 2 <= WS_MG && WS_HID + (size_t)MTOK * FF * 2 <= WS_END && WS_MG + (size_t)MTOK * 1024 * 2 <= WS_END, "d_ws map");
constexpr int CW_BAR = 4096;

constexpr int RING_BYTES = 131072;
constexpr int LDSCTL_OFF = RING_BYTES, MISC_OFF = LDSCTL_OFF + 320;
constexpr int LDS_BYTES = 147456;

__device__ __constant__ float ROPE_INV[64] = {
1.000000000e+00f, 8.659643531e-01f, 7.498942614e-01f, 6.493816376e-01f, 5.623413324e-01f, 4.869675338e-01f, 4.216965139e-01f, 3.651741147e-01f, 3.162277639e-01f, 2.738419771e-01f, 2.371373773e-01f, 2.053525001e-01f, 1.778279394e-01f, 1.539926529e-01f, 1.333521307e-01f, 1.154782027e-01f, 1.000000015e-01f, 8.659642935e-02f, 7.498941571e-02f, 6.493816525e-02f, 5.623413250e-02f, 4.869675264e-02f, 4.216965288e-02f, 3.651741147e-02f, 3.162277490e-02f, 2.738419734e-02f, 2.371373773e-02f, 2.053525113e-02f, 1.778279431e-02f, 1.539926510e-02f, 1.333521493e-02f, 1.154782064e-02f, 9.999999776e-03f, 8.659643121e-03f, 7.498941850e-03f, 6.493816152e-03f, 5.623413250e-03f, 4.869675264e-03f, 4.216964822e-03f, 3.651741194e-03f, 3.162277630e-03f, 2.738419687e-03f, 2.371373586e-03f, 2.053524833e-03f, 1.778279431e-03f, 1.539926510e-03f, 1.333521446e-03f, 1.154781901e-03f, 1.000000047e-03f, 8.659643354e-04f, 7.498942432e-04f, 6.493816618e-04f, 5.623413017e-04f, 4.869675322e-04f, 4.216965172e-04f, 3.651741426e-04f, 3.162277571e-04f, 2.738419571e-04f, 2.371373703e-04f, 2.053525095e-04f, 1.778279402e-04f, 1.539926452e-04f, 1.333521504e-04f, 1.154782003e-04f };

typedef float f32x16 __attribute__((ext_vector_type(16)));
typedef unsigned u32x2 __attribute__((ext_vector_type(2)));
typedef float f32x2 __attribute__((ext_vector_type(2)));
__device__ __forceinline__ float bf2f(unsigned short b) { return __builtin_bit_cast(float, ((unsigned)b) << 16); }
__device__ __forceinline__ unsigned cvtpk(float lo, float hi) { unsigned r; asm volatile("v_cvt_pk_bf16_f32 %0, %1, %2" : "=v"(r) : "v"(lo), "v"(hi)); return r; }
__device__ __forceinline__ float wave_sum(float v) {
#pragma unroll
    for (int o = 1; o < 64; o <<= 1) v += __shfl_xor(v, o);
    return v;
}
__device__ __forceinline__ float wave_max(float v) {
#pragma unroll
    for (int o = 1; o < 64; o <<= 1) v = fmaxf(v, __shfl_xor(v, o));
    return v;
}
__device__ __forceinline__ float wave_min(float v) {
#pragma unroll
    for (int o = 1; o < 64; o <<= 1) v = fminf(v, __shfl_xor(v, o));
    return v;
}
__device__ __forceinline__ float sigmoidf_fast(float z) { return __builtin_amdgcn_rcpf(1.0f + __builtin_amdgcn_exp2f(-z * LOG2E)); }

struct Args {
    const float* x; const float* c; const int* pos;
    const float *w_mod, *b_mod, *w_in, *conv_w, *conv_b, *wga, *bga, *wgx, *bgx, *lam, *g_attn, *g_lru, *w_out, *ln1_g, *ln1_b, *w_up, *w_down, *ln2_g, *ln2_b;
    float* out; unsigned char* ws; int ph_lo, ph_hi;
};

namespace att {
constexpr int D = 128, NW = 8, QBLK = 32, KVBLK = 64, QB = NW * QBLK;
constexpr int SHM_V = KVBLK * D * 2, SHM_K = KVBLK * D * 2;
constexpr int LDS_BYTES = 2 * SHM_V + 2 * SHM_K + NW * 64 * 4;
constexpr float SCALE = 0.08838834764831845f, THR = 8.f;
constexpr int PQ = INP, PO = DMODEL;
constexpr int MKW = SEQ / 32;
#define KSWZ(row, colB) ((row) * 256 + ((colB) ^ (((row) & 7) << 4)))
#define SBAR() __builtin_amdgcn_sched_barrier(0)
__device__ __forceinline__ int v_st(int k, int c) { const int kk = (k & ~0xC) | ((k & 4) << 1) | ((k & 8) >> 1); return ((kk >> 3) * 4 + (c >> 5)) * 512 + ((kk & 7) * 32 + (c & 31)) * 2; }
__device__ __forceinline__ int v_rd_base(int lane) { return ((lane & 3) << 3) | (((lane >> 2) & 3) << 6) | (((lane >> 4) & 1) << 5) | (((lane >> 5) & 1) << 8); }
constexpr int v_rd_off(int d0, int ks, int half) { return d0 * 512 + ks * 4096 + half * 2048; }
__device__ __forceinline__ int crow(int r, int hi) { return (r & 3) + 8 * (r >> 2) + 4 * hi; }
typedef short s16x4 __attribute__((ext_vector_type(4)));
template <class T> __device__ __forceinline__ T* uni(T* p) { const unsigned long long v = (unsigned long long)(uintptr_t)p; const unsigned lo = __builtin_amdgcn_readfirstlane((unsigned)v), hi = __builtin_amdgcn_readfirstlane((unsigned)(v >> 32)); return (T*)(GAS T*)(uintptr_t)(((unsigned long long)hi << 32) | lo); }
__device__ __forceinline__ bf16x8 load8(const bf16* p) { return *reinterpret_cast<const bf16x8*>(p); }
__device__ __forceinline__ void mask_tile(f32x16& p0, f32x16& p1, int dq) {
    const float NEG = -__builtin_inff();
#pragma unroll
    for (int r = 0; r < 16; ++r) {
        const int c = (r & 3) + 8 * (r >> 2);
        if (dq - c < 0) p0[r] = NEG;
        if (dq - c - 32 < 0) p1[r] = NEG;
    }
}
__device__ __forceinline__ void apply_bits(f32x16& p, unsigned ws) {
#ifdef ATT_NOMASK
    return;
#endif
#pragma unroll
    for (int r = 0; r < 16; ++r) { const int c = (r & 3) + 8 * (r >> 2); const unsigned m = (unsigned)(((int)(ws << (31 - c))) >> 31); const float pv = p[r]; p[r] = __uint_as_float(__float_as_uint(pv) & m); }
}
__device__ __forceinline__ void partialSM(f32x16& p0, f32x16& p1, float& m_reg, float& mn, float& alpha, unsigned w0s) {
    float pmax = p0[0];
#pragma unroll
    for (int r = 1; r < 16; ++r) pmax = fmaxf(pmax, p0[r]);
#pragma unroll
    for (int r = 0; r < 16; ++r) pmax = fmaxf(pmax, p1[r]);
    { auto rr = __builtin_amdgcn_permlane32_swap(__float_as_uint(pmax), __float_as_uint(pmax), false, false);
      pmax = fmaxf(__uint_as_float(rr[0]), __uint_as_float(rr[1])); }
    constexpr float C2 = 1.4426950408889634f * SCALE;
    if (__builtin_expect(__all((pmax - m_reg) * SCALE <= THR), 1)) { mn = m_reg; alpha = 1.f; }
    else { mn = fmaxf(m_reg, pmax); alpha = __builtin_amdgcn_exp2f((m_reg - mn) * C2); m_reg = mn; }
    const float mnL = -mn * C2;
#pragma unroll
    for (int r = 0; r < 16; ++r) p0[r] = fmaf(p0[r], C2, mnL);
#pragma unroll
    for (int r = 0; r < 16; ++r) p1[r] = fmaf(p1[r], C2, mnL);
#pragma unroll
    for (int r = 0; r < 16; ++r) p0[r] = __builtin_amdgcn_exp2f(p0[r]);
    apply_bits(p0, w0s);
}
__device__ __forceinline__ void finishSM(f32x16& p0, f32x16& p1, float alpha, float& l_reg, bf16x8& pa0, bf16x8& pa1, bf16x8& pa2, bf16x8& pa3, unsigned w1s) {
#pragma unroll
    for (int r = 0; r < 16; ++r) p1[r] = __builtin_amdgcn_exp2f(p1[r]);
    apply_bits(p1, w1s);
    float ps = 0;
#pragma unroll
    for (int r = 0; r < 16; ++r) ps += p0[r];
#pragma unroll
    for (int r = 0; r < 16; ++r) ps += p1[r];
    { auto rr = __builtin_amdgcn_permlane32_swap(__float_as_uint(ps), __float_as_uint(ps), false, false);
      ps = __uint_as_float(rr[0]) + __uint_as_float(rr[1]); }
    l_reg = l_reg * alpha + ps;
#define PK4(P, B_, OUT) do { unsigned a0 = cvtpk(P[B_+0], P[B_+1]), a1 = cvtpk(P[B_+2], P[B_+3]);                          \
        unsigned b0 = cvtpk(P[B_+4], P[B_+5]), b1 = cvtpk(P[B_+6], P[B_+7]);                                             \
        auto r0 = __builtin_amdgcn_permlane32_swap(a0, b0, false, false); auto r1 = __builtin_amdgcn_permlane32_swap(a1, b1, false, false); \
        v4u w = {r0[0], r1[0], r0[1], r1[1]}; OUT = *reinterpret_cast<bf16x8*>(&w); } while (0)
    PK4(p0, 0, pa0); PK4(p0, 8, pa1); PK4(p1, 0, pa2); PK4(p1, 8, pa3);
#undef PK4
}
template <int KB>
__device__ __forceinline__ void qkt(f32x16& p0, f32x16& p1, const char* K_lds, int r32, int hi, const bf16x8* qr) {
    p0 = f32x16{}; p1 = f32x16{};
    const char* kb[4];
#pragma unroll
    for (int dd = 0; dd < 4; ++dd) kb[dd] = K_lds + KB * SHM_K + KSWZ(r32, (dd * 16 + hi * 8) * 2);
#pragma unroll
    for (int d0 = 0; d0 < 8; ++d0) { const char* a = kb[d0 & 3] + (d0 >> 2) * 128;
        bf16x8 b0 = *reinterpret_cast<const bf16x8*>(a);
        bf16x8 b1 = *reinterpret_cast<const bf16x8*>(a + 32 * 256);
        p0 = __builtin_amdgcn_mfma_f32_32x32x16_bf16(b0, qr[d0], p0, 0, 0, 0);
        p1 = __builtin_amdgcn_mfma_f32_32x32x16_bf16(b1, qr[d0], p1, 0, 0, 0); }
}
template <int VB>
__device__ __forceinline__ void pv_tile(f32x16* o, int vb0, bf16x8 pa0, bf16x8 pa1, bf16x8 pa2, bf16x8 pa3) {
#define TRRD(dst, off) asm volatile("ds_read_b64_tr_b16 %0, %1 offset:%2" : "=&v"(dst) : "v"(vb0), "i"(off) : "memory")
#define PV_D0(d0) do { s16x4 l0, l1, l2, l3, h0, h1, h2, h3; constexpr int b_ = VB * SHM_V + v_rd_off(d0, 0, 0); \
        TRRD(l0, b_); TRRD(h0, b_ + 2048); TRRD(l1, b_ + 4096); TRRD(h1, b_ + 6144); TRRD(l2, b_ + 8192); TRRD(h2, b_ + 10240); TRRD(l3, b_ + 12288); TRRD(h3, b_ + 14336); \
        asm volatile("s_waitcnt lgkmcnt(0)" ::: "memory"); SBAR();   \
        o[d0] = __builtin_amdgcn_mfma_f32_32x32x16_bf16(pa0, (bf16x8){l0[0], l0[1], l0[2], l0[3], h0[0], h0[1], h0[2], h0[3]}, o[d0], 0, 0, 0);   \
        o[d0] = __builtin_amdgcn_mfma_f32_32x32x16_bf16(pa1, (bf16x8){l1[0], l1[1], l1[2], l1[3], h1[0], h1[1], h1[2], h1[3]}, o[d0], 0, 0, 0);   \
        o[d0] = __builtin_amdgcn_mfma_f32_32x32x16_bf16(pa2, (bf16x8){l2[0], l2[1], l2[2], l2[3], h2[0], h2[1], h2[2], h2[3]}, o[d0], 0, 0, 0);   \
        o[d0] = __builtin_amdgcn_mfma_f32_32x32x16_bf16(pa3, (bf16x8){l3[0], l3[1], l3[2], l3[3], h3[0], h3[1], h3[2], h3[3]}, o[d0], 0, 0, 0); } while (0)
    PV_D0(0); PV_D0(1); PV_D0(2); PV_D0(3);
#undef PV_D0
#undef TRRD
}
struct Bases { const char* P; char* MG; const char* MK; };
struct BlockRef { unsigned q, k, v, o, mk; int P0; };
struct Seam { bf16x8 qr[8]; bf16x8 st_v0, st_v1, st_k0, st_k1; };
#define VMW() asm volatile("s_waitcnt vmcnt(0)" ::: "memory")
#define VMWN(n) asm volatile("s_waitcnt vmcnt(%0)" :: "i"(n) : "memory")
#define SLOAD_H(Kp, Vp, k0) do { const char* kk_ = (Kp) + (size_t)(k0) * (PQ * 2); const char* vv_ = (Vp) + (size_t)(k0) * (PQ * 2);              \
                         S.st_v0 = *(const bf16x8*)(vv_ + so0); S.st_v1 = *(const bf16x8*)(vv_ + so1);              \
                         S.st_k0 = *(const bf16x8*)(kk_ + so0); S.st_k1 = *(const bf16x8*)(kk_ + so1); } while (0)
#define SWRITE_HK(bf) do { *(bf16x8*)(K_lds + (bf) * SHM_K + kws) = S.st_k0; *(bf16x8*)(K_lds + (bf) * SHM_K + kws + 32 * 256) = S.st_k1; } while (0)
#define SWRITE_HV(bf) do { *(bf16x8*)(V_lds + (bf) * SHM_V + vst0) = S.st_v0; *(bf16x8*)(V_lds + (bf) * SHM_V + vst1) = S.st_v1; } while (0)
#define SWRITE_H(bf) do { SWRITE_HV(bf); SWRITE_HK(bf); } while (0)
__device__ __forceinline__ void prime(const Bases& B, const BlockRef& cur, char* lds, Seam& S) {
    int tid_l = threadIdx.x; asm volatile("" : "+v"(tid_l));
    const int tid = tid_l, wid = __builtin_amdgcn_readfirstlane(tid >> 6), lane = tid & 63, r32 = lane & 31, hi = lane >> 5;
    const int sr = tid >> 4, sc = (tid & 15) * 8, kws = KSWZ(sr, sc * 2); char* K_lds = lds + 2 * SHM_V;
    const unsigned so0 = (unsigned)(sr * PQ + sc) * 2u, so1 = so0 + 32u * PQ * 2u;
    const unsigned qo = (unsigned)((wid * QBLK + r32) * PQ + hi * 8) * 2u;
    const char* Qb = B.P + cur.q; const char* Kb = B.P + cur.k; const char* Vb = B.P + cur.v;
#pragma unroll
    for (int d0 = 0; d0 < 8; ++d0) S.qr[d0] = *(const bf16x8*)(Qb + qo + d0 * 32);
    SLOAD_H(Kb, Vb, 0); VMW(); SWRITE_HK(0);
    __syncthreads();
}
__device__ __forceinline__ void block(const Bases& B, const BlockRef& cur, const BlockRef& nxt, char* lds, Seam& S) {
    int tid_l = threadIdx.x; asm volatile("" : "+v"(tid_l));
    const int tid = tid_l, wid = __builtin_amdgcn_readfirstlane(tid >> 6), lane = tid & 63, r32 = lane & 31, hi = lane >> 5;
    const int NT = cur.P0 / KVBLK + QB / KVBLK;
    const int qlo = cur.P0 + wid * QBLK, qm = qlo + r32 - 4 * hi;
    char* V_lds = lds; char* K_lds = lds + 2 * SHM_V;
    float* ws = (float*)(lds + 2 * SHM_V + 2 * SHM_K) + wid * 64; float* li_l = ws, * al_l = ws + 32;
    float m_reg = -1e30f, l_reg = 0; f32x16 o[4] = {};
    const int sr = tid >> 4, sc = (tid & 15) * 8, vst0 = v_st(sr, sc), vst1 = v_st(32 + sr, sc), kws = KSWZ(sr, sc * 2);
    const int vb0 = (int)(uintptr_t)V_lds + v_rd_base(lane);
    const char* Kh = B.P + cur.k; const char* Vh = B.P + cur.v;
    const unsigned so0 = (unsigned)(sr * PQ + sc) * 2u, so1 = so0 + 32u * PQ * 2u;
    const unsigned qo = (unsigned)((wid * QBLK + r32) * PQ + hi * 8) * 2u;
    const char* mkb = B.MK + cur.mk; const unsigned mo = (unsigned)(wid * QBLK + r32) * (MKW * 4u);
    const int sh4 = 4 * hi;
#define RESC(a) do { if (__any((a) < 1.f)) { if (hi == 0) al_l[r32] = (a); asm volatile("s_waitcnt lgkmcnt(0)" ::: "memory");              \
                     for (int d_ = 0; d_ < 4; ++d_) for (int r = 0; r < 16; ++r) o[d_][r] *= al_l[crow(r, hi)]; } } while (0)
#define KBASE(t) ((t) * KVBLK)
#define MASKT(P0_, P1_, t) do { const int kb_ = KBASE(t); if (kb_ + KVBLK - 1 > qlo) mask_tile(P0_, P1_, qm - kb_); } while (0)
#define MLOAD(t) (*(const u32x2*)(mkb + (size_t)(t) * 8 + mo))
    f32x16 pA0, pA1, pB0, pB1; float mnA, mnB, alA, alB; bf16x8 pa0, pa1, pa2, pa3; u32x2 mA, mB;
    SWRITE_HV(0); SBAR();
    SLOAD_H(Kh, Vh, KBASE(1));
    mA = MLOAD(0);
    SBAR(); qkt<0>(pA0, pA1, K_lds, r32, hi, S.qr);
    MASKT(pA0, pA1, 0); partialSM(pA0, pA1, m_reg, mnA, alA, mA.x >> sh4);
    VMW(); SWRITE_H(1);
    __syncthreads();
#define HALF_STEP(PX0, PX1, mnX, alX, mX, PY0, PY1, alY, mY, t, KB, VB, SB) do {                                              \
        SBAR(); mX = MLOAD(t); qkt<KB>(PX0, PX1, K_lds, r32, hi, S.qr);                                                      \
        finishSM(PY0, PY1, alY, l_reg, pa0, pa1, pa2, pa3, mY.y >> sh4); SBAR();                                              \
        if ((t) + 1 < NT) { SLOAD_H(Kh, Vh, KBASE((t) + 1)); SBAR(); }                                                        \
        pv_tile<VB>(o, vb0, pa0, pa1, pa2, pa3); MASKT(PX0, PX1, (t)); partialSM(PX0, PX1, m_reg, mnX, alX, mX.x >> sh4);    \
        __syncthreads();                                                                                                      \
        if ((t) + 1 < NT) { VMW(); SWRITE_H(SB); }                                                                            \
        RESC(alX); __syncthreads(); } while (0)
    for (int t = 1; t + 1 < NT; t += 2) {
        HALF_STEP(pB0, pB1, mnB, alB, mB, pA0, pA1, alA, mA, t, 1, 0, 0);
        HALF_STEP(pA0, pA1, mnA, alA, mA, pB0, pB1, alB, mB, t + 1, 0, 1, 1);
    }
    SBAR(); mB = MLOAD(NT - 1); qkt<1>(pB0, pB1, K_lds, r32, hi, S.qr); SBAR();
    { const char* nK = B.P + nxt.k; const char* nV = B.P + nxt.v; SLOAD_H(nK, nV, 0); } SBAR();
    { const char* nQ = B.P + nxt.q;
#pragma unroll
    for (int d0 = 0; d0 < 8; ++d0) S.qr[d0] = *(const bf16x8*)(nQ + qo + d0 * 32); }
    SBAR();
    finishSM(pA0, pA1, alA, l_reg, pa0, pa1, pa2, pa3, mA.y >> sh4); SBAR();
    pv_tile<0>(o, vb0, pa0, pa1, pa2, pa3);
    MASKT(pB0, pB1, NT - 1); partialSM(pB0, pB1, m_reg, mnB, alB, mB.x >> sh4); __syncthreads(); RESC(alB);
    finishSM(pB0, pB1, alB, l_reg, pa0, pa1, pa2, pa3, mB.y >> sh4); SBAR(); pv_tile<1>(o, vb0, pa0, pa1, pa2, pa3);
    SBAR(); VMWN(8); SWRITE_HK(0); SBAR();
    if (hi == 0) li_l[r32] = l_reg; asm volatile("s_waitcnt lgkmcnt(0)" ::: "memory");
    float rli[16];
#pragma unroll
    for (int r = 0; r < 16; ++r) rli[r] = __builtin_amdgcn_rcpf(li_l[crow(r, hi)]);
    char* Ob = B.MG + cur.o; const unsigned oo = (unsigned)((wid * QBLK) * PO + r32) * 2u;
#pragma unroll
    for (int r = 0; r < 16; ++r) { const int orow = crow(r, hi);
#pragma unroll
        for (int d0 = 0; d0 < 4; ++d0) { const float v = o[d0][r] * rli[r];
            const float vn = __shfl_xor(v, 1);
            if ((r32 & 1) == 0) *(unsigned*)(Ob + oo + (unsigned)(orow * PO + d0 * 32) * 2u) = cvtpk(v, vn); } }
    __syncthreads();
#undef RESC
#undef KBASE
#undef MASKT
#undef MLOAD
#undef HALF_STEP
}
#undef VMW
#undef VMWN
#undef SLOAD_H
#undef SWRITE_HK
#undef SWRITE_HV
#undef SWRITE_H
#undef SBAR
#undef KSWZ
}

struct Frame {
    LAS unsigned char* lds;
    gu32* ctl;
    int tid, lane, wave, vcu, G;
    float* MODV; float* STAT; float* ROPE; bf16* GATE; float* CARRY; float* WI; bf16* KI; unsigned* MASK; bf16 *WIN, *WOUT, *WUP, *WDN, *HA, *P, *MG, *HID;
};

__device__ __forceinline__ void sincos_rev(float ang, float& s, float& c) {
    double rev = (double)ang * 0.15915494309189535; rev -= __builtin_rint(rev);
    const float fr = (float)rev; s = __builtin_amdgcn_sinf(fr); c = __builtin_amdgcn_cosf(fr);
}
__device__ __forceinline__ int inproj_src_col(int d) {
    if (d < 1024) { const int p = d & 127; return (d & ~127) + (p >> 1) + 64 * (p & 1); }
    if (d >= 1536 && d < 2112) { const int p = d & 63; return (d & ~63) + (p >> 1) + 32 * (p & 1); }
    return d;
}
template <bool PERM_IN>
__device__ __forceinline__ void transpose_item(const float* W, int K, int N, bf16* WT, LAS float* scr, int item, int nblk, int lane) {
    const int kb = item / nblk, nb = item % nblk, k0 = 64 * kb, n0 = 32 * nb;
    const int nd = n0 + (lane & 31), nn = PERM_IN ? inproj_src_col(nd) : nd;
#pragma unroll 8
    for (int i = 0; i < 32; ++i) { const int kk = 2 * i + (lane >> 5); scr[kk * 33 + (lane & 31)] = (nn < N) ? W[(size_t)(k0 + kk) * N + nn] : 0.f; }
    LDS_WAIT(); asm volatile("" ::: "memory");
    const int c = lane & 7;
#pragma unroll
    for (int j = 0; j < 4; ++j) { const int n = (lane >> 3) + 8 * j; const LAS float* s = scr + (8 * c) * 33 + n;
        v4u o; o.x = pk2(s[0 * 33], s[1 * 33]); o.y = pk2(s[2 * 33], s[3 * 33]); o.z = pk2(s[4 * 33], s[5 * 33]); o.w = pk2(s[6 * 33], s[7 * 33]);
        *(GAS v4u*)(WT + (size_t)(n0 + n) * K + k0 + 8 * c) = o; }
    LDS_WAIT(); asm volatile("" ::: "memory");
}
__device__ __forceinline__ void p0_prologue(Frame& F, const Args& a) {
    LAS float* scr = (LAS float*)(F.lds + F.wave * 16384);
    const int gw = F.vcu * NWAVES + F.wave, NGW = F.G * NWAVES;
    constexpr int I_IN = (DMODEL / 64) * (INP / 32), I_OUT = (DMODEL / 64) * (DMODEL / 32), I_UP = (DMODEL / 64) * (FF / 32), I_DN = (FF / 64) * (DMODEL / 32);
    constexpr int PER_L = I_IN + I_OUT + I_UP + I_DN;
    for (int it = gw; it < DEPTH * PER_L; it += NGW) {
        const int l = it / PER_L; int r = it % PER_L;
        if (r < I_IN) { transpose_item<true>(a.w_in + (size_t)l * DMODEL * INC, DMODEL, INC, F.WIN + (size_t)l * INP * DMODEL, scr, r, INP / 32, F.lane); continue; } r -= I_IN;
        if (r < I_OUT) { transpose_item<false>(a.w_out + (size_t)l * DMODEL * DMODEL, DMODEL, DMODEL, F.WOUT + (size_t)l * DMODEL * DMODEL, scr, r, DMODEL / 32, F.lane); continue; } r -= I_OUT;
        if (r < I_UP) { transpose_item<false>(a.w_up + (size_t)l * DMODEL * FF, DMODEL, FF, F.WUP + (size_t)l * FF * DMODEL, scr, r, FF / 32, F.lane); continue; } r -= I_UP;
        transpose_item<false>(a.w_down + (size_t)l * FF * DMODEL, FF, DMODEL, F.WDN + (size_t)l * DMODEL * FF, scr, r, DMODEL / 32, F.lane);
    }
    for (int i = F.vcu * NTHR + F.tid; i < DEPTH * 2 * LBLK * 64 * 64; i += F.G * NTHR) {
        const int c = i & 63, d = (i >> 6) & 63, n = (i >> 12) & 7, g = (i >> 15) & 1, l = i >> 16;
        const float* src = g ? a.wgx : a.wga;
        F.GATE[i] = (bf16)f2bf(src[(((size_t)l * LBLK + n) * 64 + c) * 64 + d]);
    }
    for (int m = gw; m < MTOK; m += NGW) { float sn, cs; sincos_rev((float)a.pos[m] * ROPE_INV[F.lane], sn, cs);
        F.ROPE[(size_t)m * 128 + F.lane] = cs; F.ROPE[(size_t)m * 128 + 64 + F.lane] = sn; }
    __syncthreads();
    LAS float* sc = (LAS float*)F.lds;
    LAS float* red = (LAS float*)(F.lds + 32768);
    for (int i = F.tid; i < BATCH * DMODEL; i += NTHR) { const int b = i >> 10, k = i & 1023; const float v = a.c[i]; sc[k * 8 + b] = v * sigmoidf_fast(v); }
    __syncthreads();
    for (int u = F.vcu; u < DEPTH * (MODW / 64); u += F.G) {
        const int l = u / (MODW / 64), j = (u % (MODW / 64)) * 64 + F.lane;
        float acc[8];
#pragma unroll
        for (int b = 0; b < 8; ++b) acc[b] = 0.f;
        const float* wp = a.w_mod + (size_t)l * DMODEL * MODW + j;
#pragma unroll 4
        for (int kk = 0; kk < 128; ++kk) { const int k = F.wave * 128 + kk; const float wv = wp[(size_t)k * MODW];
            const f32x4 s0 = *(const LAS f32x4*)(sc + k * 8), s1 = *(const LAS f32x4*)(sc + k * 8 + 4);
            acc[0] += s0[0] * wv; acc[1] += s0[1] * wv; acc[2] += s0[2] * wv; acc[3] += s0[3] * wv;
            acc[4] += s1[0] * wv; acc[5] += s1[1] * wv; acc[6] += s1[2] * wv; acc[7] += s1[3] * wv; }
#pragma unroll
        for (int b = 0; b < 8; ++b) red[(F.wave * 8 + b) * 64 + F.lane] = acc[b];
        __syncthreads();
        float s = a.b_mod[(size_t)l * MODW + j];
#pragma unroll
        for (int w2 = 0; w2 < 8; ++w2) s += red[(w2 * 8 + F.wave) * 64 + F.lane];
        F.MODV[((size_t)l * BATCH + F.wave) * MODW + j] = s;
        __syncthreads();
    }
}

__device__ __forceinline__ void modulate_rows(Frame& F, const float* x, const float* modl, int shoff, int scoff) {
    const int gw = F.vcu * NWAVES + F.wave, NGW = F.G * NWAVES;
    for (int m = gw; m < MTOK; m += NGW) {
        const float* mb = modl + (size_t)(m / SEQ) * MODW;
#pragma unroll
        for (int j = 0; j < 4; ++j) { const int col = 4 * F.lane + 256 * j;
            const f32x4 v = *(const GAS f32x4*)(x + (size_t)m * DMODEL + col), s = *(const GAS f32x4*)(mb + scoff + col), h = *(const GAS f32x4*)(mb + shoff + col);
            const f32x4 y = v * (s + 1.0f) + h;
            u32x2 w; w.x = cvtpk(y[0], y[1]); w.y = cvtpk(y[2], y[3]);
            *(GAS u32x2*)(F.HA + (size_t)m * DMODEL + col) = w; }
    }
}
__device__ __forceinline__ void ln_rows(Frame& F, float* x, float* STAT, const float* g, const float* bt, const float* modl, int shoff, int scoff, bool write_x) {
    const int gw = F.vcu * NWAVES + F.wave, NGW = F.G * NWAVES;
    for (int m0 = gw; m0 < MTOK; m0 += 2 * NGW) {
        f32x4 v[2][4]; float s[2], s2[2], mean[2], rstd[2];
#pragma unroll
        for (int rr = 0; rr < 2; ++rr) { const int m = m0 + rr * NGW;
            if (m < MTOK) {
#pragma unroll
                for (int j = 0; j < 4; ++j) v[rr][j] = *(const GAS f32x4*)(x + (size_t)m * DMODEL + 4 * F.lane + 256 * j); } }
#pragma unroll
        for (int rr = 0; rr < 2; ++rr) { s[rr] = 0.f;
#pragma unroll
            for (int j = 0; j < 4; ++j) s[rr] += (v[rr][j][0] + v[rr][j][1]) + (v[rr][j][2] + v[rr][j][3]);
            mean[rr] = wave_sum(s[rr]) * (1.f / DMODEL); s2[rr] = 0.f;
#pragma unroll
            for (int j = 0; j < 4; ++j) { v[rr][j] = v[rr][j] - mean[rr]; s2[rr] += (v[rr][j][0] * v[rr][j][0] + v[rr][j][1] * v[rr][j][1]) + (v[rr][j][2] * v[rr][j][2] + v[rr][j][3] * v[rr][j][3]); }
            rstd[rr] = 1.f / sqrtf(wave_sum(s2[rr]) * (1.f / DMODEL) + LN_EPS); }
#pragma unroll
        for (int rr = 0; rr < 2; ++rr) { const int m = m0 + rr * NGW;
            if (m < MTOK) {
                if (F.lane == 0) { f32x2 st; st[0] = mean[rr]; st[1] = rstd[rr]; *(GAS f32x2*)(STAT + 2 * (size_t)m) = st; }
                const float* mb = modl ? modl + (size_t)(m / SEQ) * MODW : nullptr;
#pragma unroll
                for (int j = 0; j < 4; ++j) { const int col = 4 * F.lane + 256 * j;
                    const f32x4 gg = *(const GAS f32x4*)(g + col), bb = *(const GAS f32x4*)(bt + col);
                    const f32x4 y = v[rr][j] * rstd[rr] * gg + bb;
                    if (write_x) *(GAS f32x4*)(x + (size_t)m * DMODEL + col) = y;
                    if (modl) { const f32x4 sv = *(const GAS f32x4*)(mb + scoff + col), hv = *(const GAS f32x4*)(mb + shoff + col);
                        const f32x4 h = y * (sv + 1.0f) + hv; u32x2 w; w.x = cvtpk(h[0], h[1]); w.y = cvtpk(h[2], h[3]);
                        *(GAS u32x2*)(F.HA + (size_t)m * DMODEL + col) = w; } } } }
    }
}
__device__ __forceinline__ void rms_rows(Frame& F, const float* ga, const float* gl) {
    const int gw = F.vcu * NWAVES + F.wave, NGW = F.G * NWAVES;
    for (int m = gw; m < MTOK; m += NGW) {
#pragma unroll
        for (int hf = 0; hf < 2; ++hf) {
            bf16* p = F.MG + (size_t)m * DMODEL + hf * 512 + 8 * F.lane;
            const v4u raw = *(const GAS v4u*)p; float f[8];
#pragma unroll
            for (int i = 0; i < 4; ++i) { f[2 * i] = __builtin_bit_cast(float, raw[i] << 16); f[2 * i + 1] = __builtin_bit_cast(float, raw[i] & 0xffff0000u); }
            float ss = 0.f;
#pragma unroll
            for (int i = 0; i < 8; ++i) ss += f[i] * f[i];
            const float r = 1.f / sqrtf(wave_sum(ss) * (1.f / 512.f) + LN_EPS);
            const float* gp = (hf ? gl : ga) + 8 * F.lane;
            const f32x4 g0 = *(const GAS f32x4*)gp, g1 = *(const GAS f32x4*)(gp + 4);
            v4u o; o.x = cvtpk(f[0] * r * g0[0], f[1] * r * g0[1]); o.y = cvtpk(f[2] * r * g0[2], f[3] * r * g0[3]);
            o.z = cvtpk(f[4] * r * g1[0], f[5] * r * g1[1]); o.w = cvtpk(f[6] * r * g1[2], f[7] * r * g1[3]);
#ifdef ZERO_HALF
            if (hf == ZERO_HALF) { o.x = 0u; o.y = 0u; o.z = 0u; o.w = 0u; }
#endif
            *(GAS v4u*)p = o;
        }
    }
}
__device__ __forceinline__ void rope_rows(Frame& F, const int* pos) {
    const int gw = F.vcu * NWAVES + F.wave, NGW = F.G * NWAVES, lane = F.lane;
    const float inva = ROPE_INV[lane], invi = ROPE_INV[2 * (lane & 31)];
    for (int m = gw; m < MTOK; m += NGW) {
        const float fpos = (float)pos[m];
        float sa, ca, si, ci; sincos_rev(fpos * inva, sa, ca); sincos_rev(fpos * invi, si, ci);
        bf16* prow = F.P + (size_t)m * INP;
#pragma unroll
        for (int hh = 0; hh < 8; ++hh) {
            bf16* p = prow + hh * 128 + lane;
            const float x1 = bf2f(p[0]), x2 = bf2f(p[64]);
            p[0] = (bf16)f2bf(x1 * ca - x2 * sa); p[64] = (bf16)f2bf(x2 * ca + x1 * sa);
        }
        const int i = lane & 31, h2 = lane >> 5;
#pragma unroll
        for (int j = 0; j < 4; ++j) {
            bf16* p = prow + CQI + (2 * j + h2) * 64 + i;
            const float x1 = bf2f(p[0]), x2 = bf2f(p[32]);
            p[0] = (bf16)f2bf(x1 * ci - x2 * si); p[32] = (bf16)f2bf(x2 * ci + x1 * si);
        }
        if (lane < 32) {
            const float x1 = bf2f(prow[CKI + i]), x2 = bf2f(prow[CKI + 32 + i]);
            F.KI[(size_t)m * 64 + i] = (bf16)f2bf(x1 * ci - x2 * si); F.KI[(size_t)m * 64 + 32 + i] = (bf16)f2bf(x2 * ci + x1 * si);
        }
        if (lane < 8) F.WI[(size_t)m * 8 + lane] = bf2f(prow[CWI + lane]) * 0.35355339059327373f;
    }
}

__device__ __forceinline__ int wave_sum_i32(int v) {
    v += __builtin_amdgcn_update_dpp(0, v, 0xB1, 0xf, 0xf, true);
    v += __builtin_amdgcn_update_dpp(0, v, 0x4E, 0xf, 0xf, true);
    v += __builtin_amdgcn_update_dpp(0, v, 0x141, 0xf, 0xf, true);
    v += __builtin_amdgcn_update_dpp(0, v, 0x140, 0xf, 0xf, true);
    return __builtin_amdgcn_readlane(v, 0) + __builtin_amdgcn_readlane(v, 16) + __builtin_amdgcn_readlane(v, 32) + __builtin_amdgcn_readlane(v, 48);
}
__device__ __forceinline__ float z_upper(float p) {
    const bool fl = p > 0.5f; const float q = fl ? 1.f - p : p;
    const float tt = __builtin_amdgcn_sqrtf(-2.f * 0.6931471805599453f * __builtin_amdgcn_logf(fmaxf(q, 1e-30f)));
    const float z = tt - (2.515517f + tt * (0.802853f + tt * 0.010328f)) * __builtin_amdgcn_rcpf(1.f + tt * (1.432788f + tt * (0.189269f + tt * 0.001308f)));
    return fl ? -z : z;
}
__device__ __forceinline__ void idx_phase(Frame& F, int l) {
    const int lane = F.lane, wid = F.wave, r32 = lane & 31, hi = lane >> 5;
    LAS float* SC = (LAS float*)F.lds;
    LAS float* WG2 = SC + 8192;
    const float NEG = -__builtin_inff();
#define IDX_BAR() do { asm volatile("s_waitcnt lgkmcnt(0)" ::: "memory"); __builtin_amdgcn_s_barrier(); asm volatile("" ::: "memory"); } while (0)
    const char* kib = (const char*)F.KI;
    const int tq = 2 * ((r32 >> 2) & 1) + (r32 >> 4), hh = ((r32 >> 3) & 1) * 4 + (r32 & 3);
#define IDX_DECODE(L_, b_, t0_) do { const int xx_ = (L_) & 511; b_ = (L_) >> 9; t0_ = 8 * (xx_ < 256 ? xx_ : 767 - xx_); } while (0)
    const unsigned afo = (unsigned)((tq * INP + hh * 64 + 8 * hi) * 2), kbo = (unsigned)(((64 * wid + r32) * 64 + 8 * hi) * 2);
    const char* pb_ = (const char*)F.P + CQI * 2;
#define IDX_LOAD_AF(row0_) do { _Pragma("unroll") for (int m = 0; m < 2; ++m) { const char* q_ = pb_ + (size_t)__builtin_amdgcn_readfirstlane((int)(((row0_) + 4 * m) * (INP * 2))); \
        _Pragma("unroll") for (int ks = 0; ks < 4; ++ks) af[m][ks] = *(const GAS bf16x8*)(q_ + afo + ks * 32); } } while (0)
#define IDX_LOAD_KB1(dst, b_, ch_, kt) do { const char* k_ = kib + (size_t)__builtin_amdgcn_readfirstlane(((b_) * SEQ + 512 * (ch_) + 32 * (kt)) * 128); \
        _Pragma("unroll") for (int ks = 0; ks < 4; ++ks) dst[kt][ks] = *(const GAS bf16x8*)(k_ + kbo + ks * 32); } while (0)
#define IDX_LOAD_KB(dst, b_, ch_) do { _Pragma("unroll") for (int kt = 0; kt < 2; ++kt) { const char* k_ = kib + (size_t)__builtin_amdgcn_readfirstlane(((b_) * SEQ + 512 * (ch_) + 32 * kt) * 128); \
        _Pragma("unroll") for (int ks = 0; ks < 4; ++ks) dst[kt][ks] = *(const GAS bf16x8*)(k_ + kbo + ks * 32); } } while (0)
    int L = F.vcu; if (L >= BATCH * (SEQ / 8)) return;
    int b, t0; IDX_DECODE(L, b, t0);
    bf16x8 af[2][4], kb[2][4];
    IDX_LOAD_AF(b * SEQ + t0); IDX_LOAD_KB(kb, b, 0);
    if (F.tid < 64) WG2[F.tid] = F.WI[(unsigned)((b * SEQ + t0) * 8 + F.tid)];
    IDX_BAR();
#ifdef PROBE_IDXSTAT
    float st_val = 0.f, st_rows = 0.f;
#endif
    for (int ui = 0;; ++ui) {
#ifdef PROBE_IDXSTAT
#if PROBE_KIND == 22
        const long long tk0_ = __builtin_amdgcn_s_memtime();
#endif
#endif
        LAS float* WGL = WG2 + (ui & 1) * 64;
        const int nch = ((t0 + 7) >> 9) + 1;
        float keys[64];
#pragma unroll
        for (int j = 0; j < 64; ++j) keys[j] = NEG;
#ifndef REP_SCORE
#define REP_SCORE 1
#endif
#ifndef REP_SEL
#define REP_SEL 1
#endif
#pragma unroll 1
        for (int rsc_ = 0; rsc_ < REP_SCORE; ++rsc_) {
        if (rsc_ > 0) { IDX_LOAD_KB(kb, b, 0); }
#pragma unroll
        for (int ch = 0; ch < 8; ++ch) {
            if (ch < nch) {
                LAS float* scb = SC + (ch & 1) * 4096;
#pragma unroll
                for (int kt = 0; kt < 2; ++kt) {
                    const int s0 = 512 * ch + 64 * wid + 32 * kt;
                    float sc4[2][2];
                    if (s0 <= t0 + 7) {
                        f32x16 acc2[2];
#pragma unroll
                        for (int m = 0; m < 2; ++m) { acc2[m] = f32x16{};
#pragma unroll
                            for (int ks = 0; ks < 4; ++ks) acc2[m] = __builtin_amdgcn_mfma_f32_32x32x16_bf16(af[m][ks], kb[kt][ks], acc2[m], 0, 0, 0); }
                        if (ch + 1 < nch) IDX_LOAD_KB1(kb, b, ch + 1, kt);
#pragma unroll
                        for (int m = 0; m < 2; ++m) { const f32x16 acc = acc2[m];
#pragma unroll
                            for (int ts = 0; ts < 2; ++ts) { float s = 0.f;
                                const f32x4 wa = *(const LAS f32x4*)(WGL + (4 * m + 2 * hi + ts) * 8), wb = *(const LAS f32x4*)(WGL + (4 * m + 2 * hi + ts) * 8 + 4);
#pragma unroll
                                for (int j = 0; j < 4; ++j) {
                                    const float r0 = __builtin_amdgcn_fmed3f(acc[ts * 8 + j], 0.f, __builtin_inff()), r1 = __builtin_amdgcn_fmed3f(acc[ts * 8 + 4 + j], 0.f, __builtin_inff());
                                    asm("v_fmac_f32 %0, %1, %2" : "+v"(s) : "v"(wa[j]), "v"(r0)); asm("v_fmac_f32 %0, %1, %2" : "+v"(s) : "v"(wb[j]), "v"(r1)); }
                                const int t = t0 + 4 * m + 2 * hi + ts;
                                sc4[m][ts] = (s0 + r32 <= t) ? s : NEG; } }
                    } else { sc4[0][0] = NEG; sc4[0][1] = NEG; sc4[1][0] = NEG; sc4[1][1] = NEG; if (ch + 1 < nch) IDX_LOAD_KB1(kb, b, ch + 1, kt); }
#pragma unroll
                    for (int m = 0; m < 2; ++m)
#pragma unroll
                        for (int ts = 0; ts < 2; ++ts) scb[(4 * m + 2 * hi + ts) * 512 + 64 * wid + 32 * kt + r32] = sc4[m][ts];
                }
                IDX_BAR();
#pragma unroll
                for (int i = 0; i < 8; ++i) keys[8 * ch + i] = scb[wid * 512 + 64 * i + lane];
            }
        }
        }
#ifdef PROBE_IDXSTAT
#if PROBE_KIND == 22
        st_val += (float)(__builtin_amdgcn_s_memtime() - tk0_);
#elif PROBE_KIND == 21
        const long long tk1_ = __builtin_amdgcn_s_memtime();
#endif
#endif
        const int Ln = L + F.G; const bool has_next = Ln < BATCH * (SEQ / 8);
        int bn = b, t0n = t0; float wnext = 0.f;
        if (has_next) { IDX_DECODE(Ln, bn, t0n); IDX_LOAD_AF(bn * SEQ + t0n); IDX_LOAD_KB(kb, bn, 0);
            if (F.tid < 64) wnext = F.WI[(unsigned)((bn * SEQ + t0n) * 8 + F.tid)]; }
        const int t = t0 + wid, nj = (t >> 6) + 1;
        float theta = NEG;
#pragma unroll 1
        for (int rs_ = 0; rs_ < REP_SEL; ++rs_) { asm volatile("" : "+v"(keys[0]));
        if (t >= TOPK) {
            float mx = NEG, mn = __builtin_inff();
#pragma unroll
            for (int g8 = 0; g8 < 8; ++g8) if (8 * g8 < nj) {
#pragma unroll
                for (int j = 8 * g8; j < 8 * g8 + 8; ++j) { mx = fmaxf(mx, keys[j]); mn = fminf(mn, keys[j] == NEG ? __builtin_inff() : keys[j]); } }
            mx = wave_max(mx); mn = wave_min(mn);
#define IDX_COUNT(th, out) do { int c_ = 0; const float th_ = (th); _Pragma("unroll") for (int g32 = 0; g32 < 2; ++g32) { unsigned acc_ = 0u; \
            _Pragma("unroll") for (int g8 = 4 * g32; g8 < 4 * g32 + 4; ++g8) { if (8 * g8 < nj) { \
                _Pragma("unroll") for (int j = 8 * g8; j < 8 * g8 + 8; ++j) acc_ = __builtin_amdgcn_alignbit(acc_, __float_as_uint(th_ - keys[j]), 31); } } \
            c_ += __builtin_popcount(acc_); } out = wave_sum_i32(c_); } while (0)
            float lo = mn, hiv = mx; int clo = t, chi = 0;
            if (clo <= TOPK) { theta = (clo == TOPK) ? lo : NEG; }
            else {
                theta = lo;
                const float rn = __builtin_amdgcn_rcpf((float)(t + 1)), zt = z_upper((float)TOPK * rn);
                for (int it = 0; it < 64; ++it) {
                    float mid;
                    if ((it % 3) != 2) {
                        const float zl = z_upper(fminf((float)clo * rn, 1.f - 0.5f * rn)), zh = z_upper(fmaxf((float)chi, 0.5f) * rn);
                        mid = lo + (hiv - lo) * ((zt - zl) * __builtin_amdgcn_rcpf(zh - zl));
                        if (!(mid > lo && mid < hiv)) mid = 0.5f * (lo + hiv);
                    } else mid = 0.5f * (lo + hiv);
                    if (!(mid > lo && mid < hiv)) break;
                    int cm; IDX_COUNT(mid, cm);
#if defined(PROBE_IDXSTAT) && PROBE_KIND == 20
                    st_val += 1.f;
#endif
                    if (cm == TOPK) { theta = mid; break; }
                    if (cm > TOPK) { lo = mid; clo = cm; theta = mid; } else { hiv = mid; chi = cm; }
                }
            }
#undef IDX_COUNT
        }
        }
#ifdef PROBE_IDXSTAT
#if PROBE_KIND == 21
        st_val += (float)(__builtin_amdgcn_s_memtime() - tk1_);
#endif
        st_rows += 1.f;
#endif
        unsigned w0 = 0u, w1 = 0u;
#pragma unroll
        for (int g8 = 0; g8 < 8; ++g8) { if (8 * g8 < nj) {
#pragma unroll
            for (int j = 8 * g8; j < 8 * g8 + 8; ++j) { const unsigned long long bm = __builtin_amdgcn_ballot_w64(keys[j] > theta);
                asm volatile("s_nop 1\n\tv_writelane_b32 %0, %2, %4\n\tv_writelane_b32 %1, %3, %4" : "+v"(w0), "+v"(w1) : "s"((unsigned)bm), "s"((unsigned)(bm >> 32)), "i"(j)); } }
            __builtin_amdgcn_sched_barrier(0); }
        u32x2 wv; wv.x = w0; wv.y = w1;
        *(GAS u32x2*)(F.MASK + (unsigned)((b * SEQ + t) * (SEQ / 32) + 2 * lane)) = wv;
        if (has_next && F.tid < 64) WG2[((ui + 1) & 1) * 64 + F.tid] = wnext;
        IDX_BAR();
        if (!has_next) break;
        L = Ln; b = bn; t0 = t0n;
    }
#ifdef PROBE_IDXSTAT
    if (l == 0 && lane == 0) { float* sl_ = (float*)F.ctl + 8; atomicAdd(sl_ + 2, st_val); atomicAdd(sl_ + 5, st_rows); }
#endif
#undef IDX_BAR
#undef IDX_DECODE
#undef IDX_LOAD_AF
#undef IDX_LOAD_KB
#undef IDX_LOAD_KB1
}

template <bool PASSB>
__device__ __forceinline__ void lru_phase(Frame& F, const Args& a, int l) {
    const int lane = F.lane, wid = F.wave, r32 = lane & 31, hi = lane >> 5, c = wid * 64 + lane;
    LAS unsigned char* xt = F.lds + 36864 + wid * 4608;
    const bf16* GT = F.GATE + (size_t)l * 2 * LBLK * 64 * 64;
    for (int u = F.vcu; u < BATCH * NLCH; u += F.G) {
        const int b = u / NLCH, chunk = u % NLCH;
        const float cw0 = a.conv_w[((size_t)l * 4 + 0) * LW + c], cw1 = a.conv_w[((size_t)l * 4 + 1) * LW + c], cw2 = a.conv_w[((size_t)l * 4 + 2) * LW + c], cw3 = a.conv_w[((size_t)l * 4 + 3) * LW + c];
        const float cb = a.conv_b[(size_t)l * LW + c], ba = a.bga[(size_t)l * LW + c], bx = a.bgx[(size_t)l * LW + c];
        float sp8;
        { const float xl = -a.lam[(size_t)l * LW + c], ax = fabsf(xl), e = __builtin_amdgcn_exp2f(-ax * LOG2E);
          const float l1p = (e < 0.01f) ? e * (1.f - e * (0.5f - e * (0.33333333f - 0.25f * e))) : __builtin_amdgcn_logf(1.f + e) * 0.6931471805599453f;
          sp8 = 8.0f * (fmaxf(xl, 0.f) + l1p) * LOG2E; }
        const int tbase = chunk * LCH; const size_t rowb = (size_t)b * SEQ;
        float h = 0.f, pp = 1.f;
        if (PASSB) {
            for (int k0 = 0; k0 < chunk; k0 += 8) { f32x2 cv[8];
#pragma unroll
                for (int e = 0; e < 8; ++e) { const int k = (k0 + e < chunk) ? k0 + e : chunk - 1; cv[e] = *(const GAS f32x2*)(F.CARRY + (((size_t)b * NLCH + k) * LW + c) * 2); }
#pragma unroll
                for (int e = 0; e < 8; ++e) if (k0 + e < chunk) h = cv[e][0] * h + cv[e][1]; } }
        float xm3 = 0.f, xm2 = 0.f, xm1 = 0.f;
        if (tbase > 0) { xm3 = bf2f(F.P[(rowb + tbase - 3) * INP + CXR + c]); xm2 = bf2f(F.P[(rowb + tbase - 2) * INP + CXR + c]); xm1 = bf2f(F.P[(rowb + tbase - 1) * INP + CXR + c]); }
        for (int tt = 0; tt < LCH / 32; ++tt) {
            const int t0 = tbase + 32 * tt;
            float xc[32];
            {
                float xv[32];
#pragma unroll
                for (int i = 0; i < 32; ++i) xv[i] = bf2f(F.P[(rowb + t0 + i) * INP + CXR + c]);
#pragma unroll
                for (int i = 0; i < 32; ++i) { const float a3 = (i >= 3) ? xv[i - 3] : (i == 0 ? xm3 : (i == 1 ? xm2 : xm1));
                    const float a2 = (i >= 2) ? xv[i - 2] : (i == 0 ? xm2 : xm1); const float a1 = (i >= 1) ? xv[i - 1] : xm1;
                    xc[i] = cb + cw0 * a3 + cw1 * a2 + cw2 * a1 + cw3 * xv[i]; }
                xm3 = xv[29]; xm2 = xv[30]; xm1 = xv[31];
            }
#pragma unroll
            for (int i = 0; i < 32; ++i) *(LAS unsigned short*)(xt + i * 144 + lane * 2) = (unsigned short)f2bf(xc[i]);
            LDS_WAIT();
            bf16x8 xa[4];
#pragma unroll
            for (int ks = 0; ks < 4; ++ks) xa[ks] = *(const LAS bf16x8*)(xt + r32 * 144 + (16 * ks + 8 * hi) * 2);
            LDS_WAIT();
            f32x16 C[2][2];
#pragma unroll
            for (int g = 0; g < 2; ++g) {
                bf16x8 gf[2][4];
#pragma unroll
                for (int dt = 0; dt < 2; ++dt)
#pragma unroll
                    for (int ks = 0; ks < 4; ++ks) gf[dt][ks] = *(const GAS bf16x8*)(GT + (((size_t)g * LBLK + wid) * 64 + 32 * dt + r32) * 64 + 16 * ks + 8 * hi);
#pragma unroll
                for (int dt = 0; dt < 2; ++dt) { C[g][dt] = f32x16{};
#pragma unroll
                    for (int ks = 0; ks < 4; ++ks) C[g][dt] = __builtin_amdgcn_mfma_f32_32x32x16_bf16(xa[ks], gf[dt][ks], C[g][dt], 0, 0, 0); }
                asm volatile("" ::: "memory");
            }
#pragma unroll
            for (int g = 0; g < 2; ++g)
#pragma unroll
                for (int i = 0; i < 16; ++i) { auto rr = __builtin_amdgcn_permlane32_swap(__float_as_uint(C[g][0][i]), __float_as_uint(C[g][1][i]), false, false);
                    C[g][0][i] = __uint_as_float(rr[0]); C[g][1][i] = __uint_as_float(rr[1]); }
#pragma unroll
            for (int q8 = 0; q8 < 4; ++q8) {
                float yv[8];
                if (PASSB) {
#pragma unroll
                    for (int e = 0; e < 8; ++e) yv[e] = bf2f(F.P[(rowb + t0 + 8 * q8 + e) * INP + CYG + c]);
                }
#pragma unroll
                for (int e = 0; e < 8; ++e) {
                    const int t = 8 * q8 + e, grp = e >> 2, i = 4 * q8 + (e & 3);
                    const float ra = sigmoidf_fast(C[0][grp][i] + ba), ix = sigmoidf_fast(C[1][grp][i] + bx);
                    const float av = __builtin_amdgcn_exp2f(-ra * sp8);
                    const float uu = __builtin_amdgcn_sqrtf(fmaxf(1.f - av * av, 0.f)) * ix * xc[t];
                    h = av * h + uu; pp *= av;
                    if (PASSB) { const float y = yv[e], z = 0.7978845608028654f * (y + 0.044715f * y * y * y);
                        const float o = h * y * sigmoidf_fast(2.f * z);
                        F.MG[(rowb + t0 + t) * DMODEL + AW + c] = (bf16)f2bf(o); }
                }
            }
        }
        if (!PASSB) { float* cp = F.CARRY + (((size_t)b * NLCH + chunk) * LW + c) * 2; cp[0] = pp; cp[1] = h; }
    }
}

__device__ __forceinline__ att::BlockRef att_ref(int bh, int qb) {
    const int b = bh / NHEAD, h = bh % NHEAD; att::BlockRef r;
    const unsigned row = (unsigned)(b * SEQ + qb * att::QB), row0 = (unsigned)(b * SEQ);
#define UNI_(v) ((unsigned)__builtin_amdgcn_readfirstlane((int)(v)))
    r.q = UNI_((row * INP + CQ + h * HD) * 2u); r.k = UNI_((row0 * INP + CK + h * HD) * 2u); r.v = UNI_((row0 * INP + CV + h * HD) * 2u);
    r.o = UNI_((row * DMODEL + h * HD) * 2u); r.mk = UNI_(row * (SEQ / 32) * 4u); r.P0 = __builtin_amdgcn_readfirstlane(qb * att::QB);
#undef UNI_
    return r;
}
__device__ __forceinline__ void attn_phase(Frame& F, char* lds) {
    constexpr int NQB = SEQ / att::QB, NX = NQB / 2, TOTAL = BATCH * NHEAD * NX;
    int L = F.vcu; if (L >= TOTAL) return;
    int bh = L / NX, x = L % NX, pass = 0;
    att::Bases B; B.P = (const char*)att::uni(F.P); B.MG = (char*)att::uni(F.MG); B.MK = (const char*)att::uni(F.MASK);
    att::BlockRef cur = att_ref(bh, x);
    att::Seam S;
    att::prime(B, cur, lds, S);
    for (;;) {
        const bool more_pass = pass == 0, more_item = L + F.G < TOTAL, last = !more_pass && !more_item;
        int bhn = bh, xn = x, passn = pass + 1, Ln = L;
        if (!more_pass) { passn = 0; Ln = more_item ? L + F.G : L; bhn = Ln / NX; xn = Ln % NX; }
        const att::BlockRef nxt = last ? cur : att_ref(bhn, passn ? NQB - 1 - xn : xn);
        att::block(B, cur, nxt, lds, S);
        if (last) break;
        cur = nxt; bh = bhn; x = xn; pass = passn; L = Ln;
    }
}

#ifdef PROBE_STOP
__device__ __forceinline__ void probe_idx(Frame& F, float* slot) {
    const int lane = F.lane, gw = F.vcu * NWAVES + F.wave;
    LAS float* sc = (LAS float*)(F.lds + F.wave * 16384);
    if (gw >= 128) return;
    const int b = gw & 7, t = (gw >> 3) * 257 + 200;
    if (t >= SEQ) return;
    const size_t row = (size_t)b * SEQ + t;
    float wq[8];
#pragma unroll
    for (int h = 0; h < 8; ++h) wq[h] = F.WI[row * 8 + h];
    for (int s0 = 0; s0 <= t; s0 += 64) {
        const int s = s0 + lane; float score = -__builtin_inff();
        if (s <= t) { score = 0.f;
            for (int h = 0; h < 8; ++h) { float d = 0.f;
                for (int k = 0; k < 64; ++k) d += bf2f(F.P[row * INP + CQI + h * 64 + k]) * bf2f(F.KI[((size_t)b * SEQ + s) * 64 + k]);
                score += wq[h] * fmaxf(d, 0.f); } }
        sc[s] = score;
    }
    for (int s = ((t >> 6) + 1) * 64 + lane; s < SEQ; s += 64) sc[s] = -__builtin_inff();
    LDS_WAIT(); asm volatile("" ::: "memory");
    float mism = 0.f;
    for (int s0 = 0; s0 <= t; s0 += 64) {
        const int s = s0 + lane; const float mine = sc[s]; int rank = 0;
        for (int j = 0; j <= t; ++j) { const float o = sc[j]; rank += (o > mine || (o == mine && j < s)) ? 1 : 0; }
        const bool want = (s <= t) && (t < TOPK || rank < TOPK);
        const unsigned w = F.MASK[row * 128 + (s >> 5)]; const bool got = (w >> (s & 31)) & 1u;
        if (want != got) mism += 1.f;
    }
    mism = wave_sum(mism);
    if (lane == 0) { atomicAdd(slot, mism); atomicAdd(slot + 1, (float)(t + 1 < TOPK ? t + 1 : TOPK)); }
}
__device__ __forceinline__ void probe_attn(Frame& F, float* slot) {
    const int lane = F.lane, gw = F.vcu * NWAVES + F.wave;
    LAS float* pw = (LAS float*)(F.lds + F.wave * 16384);
    if (gw >= 256) return;
    const int b = gw & 7, h = (gw >> 3) & 3, t = (gw >> 5) * 509 + 300;
    if (t >= SEQ) return;
    const size_t row = (size_t)b * SEQ + t;
    float mx = -__builtin_inff();
    for (int s0 = 0; s0 <= t; s0 += 64) { const int s = s0 + lane; float sv = -__builtin_inff();
#ifdef ATT_NOMASK
        if (s <= t) { float d = 0.f;
#else
        if (s <= t && ((F.MASK[row * 128 + (s >> 5)] >> (s & 31)) & 1u)) { float d = 0.f;
#endif
            for (int k = 0; k < 128; ++k) d += bf2f(F.P[row * INP + CQ + h * 128 + k]) * bf2f(F.P[((size_t)b * SEQ + s) * INP + CK + h * 128 + k]);
            sv = d * 0.08838834764831845f; }
        pw[s] = sv; mx = fmaxf(mx, sv); }
    mx = wave_max(mx);
    float sum = 0.f;
    for (int s0 = 0; s0 <= t; s0 += 64) { const int s = s0 + lane; const float e = __expf(pw[s] - mx); pw[s] = e; sum += e; }
    sum = wave_sum(sum);
    LDS_WAIT(); asm volatile("" ::: "memory");
    float o0 = 0.f, o1 = 0.f;
    for (int s = 0; s <= t; ++s) { const float p = pw[s]; if (p != 0.f) { o0 += p * bf2f(F.P[((size_t)b * SEQ + s) * INP + CV + h * 128 + lane]); o1 += p * bf2f(F.P[((size_t)b * SEQ + s) * INP + CV + h * 128 + 64 + lane]); } }
    o0 /= sum; o1 /= sum;
    const float g0 = bf2f(F.MG[row * DMODEL + h * 128 + lane]), g1 = bf2f(F.MG[row * DMODEL + h * 128 + 64 + lane]);
    float num = (g0 - o0) * (g0 - o0) + (g1 - o1) * (g1 - o1), den = o0 * o0 + o1 * o1;
    num = wave_sum(num); den = wave_sum(den);
    if (lane == 0) { atomicAdd(slot, num); atomicAdd(slot + 1, den); }
}
__device__ __forceinline__ void probe_lru(Frame& F, const Args& a, int l, float* slot) {
    const int lane = F.lane;
    if (F.wave >= 4 || F.vcu >= 16) return;
    const int u = F.vcu * 4 + F.wave, b = u >> 3, n = u & 7, c = n * 64 + lane;
    LAS float* W = (LAS float*)(F.lds + F.wave * 33024);
    LAS float* xs = W + 8192;
    for (int i = lane; i < 4096; i += 64) { W[i] = a.wga[((size_t)l * LBLK + n) * 4096 + i]; W[4096 + i] = a.wgx[((size_t)l * LBLK + n) * 4096 + i]; }
    LDS_WAIT(); asm volatile("" ::: "memory");
    const float cw0 = a.conv_w[((size_t)l * 4 + 0) * LW + c], cw1 = a.conv_w[((size_t)l * 4 + 1) * LW + c], cw2 = a.conv_w[((size_t)l * 4 + 2) * LW + c], cw3 = a.conv_w[((size_t)l * 4 + 3) * LW + c];
    const float cb = a.conv_b[(size_t)l * LW + c], ba = a.bga[(size_t)l * LW + c], bx = a.bgx[(size_t)l * LW + c], lam = a.lam[(size_t)l * LW + c];
    const float sp = log1pf(expf(-lam));
    float x3 = 0.f, x2 = 0.f, x1 = 0.f, h = 0.f, num = 0.f, den = 0.f;
    for (int t = 0; t < SEQ; ++t) {
        const size_t row = (size_t)b * SEQ + t;
        const float x0 = bf2f(F.P[row * INP + CXR + c]);
        const float xc = cb + cw0 * x3 + cw1 * x2 + cw2 * x1 + cw3 * x0; x3 = x2; x2 = x1; x1 = x0;
        xs[lane] = xc; LDS_WAIT(); asm volatile("" ::: "memory");
        float za = ba, zx = bx;
        for (int k = 0; k < 64; ++k) { const float xv = xs[k]; za += xv * W[k * 64 + lane]; zx += xv * W[4096 + k * 64 + lane]; }
        LDS_WAIT(); asm volatile("" ::: "memory");
        const float r = 1.f / (1.f + expf(-za)), ii = 1.f / (1.f + expf(-zx));
        const float la = -8.0f * r * sp, av = expf(la);
        h = av * h + sqrtf(fmaxf(-expm1f(2.f * la), 0.f)) * (ii * xc);
        const float y = bf2f(F.P[row * INP + CYG + c]);
        const float want = h * 0.5f * y * (1.f + tanhf(0.7978845608028654f * (y + 0.044715f * y * y * y)));
        const float got = bf2f(F.MG[row * DMODEL + AW + c]);
        num += (got - want) * (got - want); den += want * want;
    }
    num = wave_sum(num); den = wave_sum(den);
    if (lane == 0) { atomicAdd(slot, num); atomicAdd(slot + 1, den); }
}
__device__ __forceinline__ void probe_gemm(Frame& F, const bf16* A, const bf16* Bt, const bf16* O, int N, int K, int ldo, int act, float* slot) {
    const int gt = F.vcu * NTHR + F.tid; if (gt >= 65536) return;
    const unsigned hsh = (unsigned)gt * 2654435761u; const int m = (int)(hsh % (unsigned)MTOK), n = (int)((hsh >> 7) % (unsigned)N);
    float d = 0.f; for (int k = 0; k < K; ++k) d += bf2f(A[(size_t)m * K + k]) * bf2f(Bt[(size_t)n * K + k]);
    if (act == 1) { d = fmaxf(d, 0.f); d = d * d; }
    const float got = bf2f(O[(size_t)m * ldo + n]);
    float num = (got - d) * (got - d), den = d * d; num = wave_sum(num); den = wave_sum(den);
    if (F.lane == 0) { atomicAdd(slot, num); atomicAdd(slot + 1, den); }
}
#endif

#ifndef MK_N_LAUNCHES
#define MK_N_LAUNCHES 1
#endif
constexpr int PH_PER_LAYER = 11, N_PHASES = 1 + DEPTH * PH_PER_LAYER;
constexpr bool ONE_LAUNCH = (MK_N_LAUNCHES == 1);
#ifndef REP_IDX
#define REP_IDX 1
#endif
#ifndef REP_LRUA
#define REP_LRUA 1
#endif
#ifndef REP_ATT
#define REP_ATT 1
#endif
#ifndef REP_LRUB
#define REP_LRUB 1
#endif
#ifndef REP_G1
#define REP_G1 1
#endif
#ifndef REP_G8
#define REP_G8 1
#endif
#ifndef REP_LN
#define REP_LN 1
#endif

typedef const Args __attribute__((address_space(4)))* KArgs;
template <class T> __device__ __forceinline__ T* glob(T* p) { return (T*)(GAS T*)p; }
__device__ __forceinline__ Args load_args(KArgs k) {
    Args a = *(const Args*)k;
    a.x = glob(a.x); a.c = glob(a.c); a.pos = glob(a.pos); a.w_mod = glob(a.w_mod); a.b_mod = glob(a.b_mod); a.w_in = glob(a.w_in); a.conv_w = glob(a.conv_w); a.conv_b = glob(a.conv_b);
    a.wga = glob(a.wga); a.bga = glob(a.bga); a.wgx = glob(a.wgx); a.bgx = glob(a.bgx); a.lam = glob(a.lam); a.g_attn = glob(a.g_attn); a.g_lru = glob(a.g_lru); a.w_out = glob(a.w_out);
    a.ln1_g = glob(a.ln1_g); a.ln1_b = glob(a.ln1_b); a.w_up = glob(a.w_up); a.w_down = glob(a.w_down); a.ln2_g = glob(a.ln2_g); a.ln2_b = glob(a.ln2_b); a.out = glob(a.out); a.ws = glob(a.ws);
    return a;
}

__global__ void __launch_bounds__(NTHR, 2) fwd_kernel(Args a) {
    extern __shared__ __attribute__((aligned(16))) unsigned char lds[];
    Frame F;
    F.lds = (LAS unsigned char*)lds;
    F.tid = threadIdx.x; F.lane = F.tid & 63; F.wave = __builtin_amdgcn_readfirstlane(F.tid >> 6);
    F.G = gridDim.x; { const int bx = blockIdx.x; F.vcu = (F.G % 8 == 0) ? (bx % 8) * (F.G / 8) + bx / 8 : bx; }
    F.ctl = (gu32*)(a.ws + WS_CTL);
#define REPIN() int t_ = threadIdx.x; KArgs ka_ = (KArgs)__builtin_amdgcn_kernarg_segment_ptr(); asm volatile("" : "+v"(t_), "+s"(ka_)); \
        const Args a = load_args(ka_);   \
        unsigned char* ws_ = a.ws; \
        F.tid = t_; F.lane = t_ & 63; F.wave = __builtin_amdgcn_readfirstlane(t_ >> 6); \
        F.MODV = (float*)(ws_ + WS_MOD); F.STAT = (float*)(ws_ + WS_STAT); F.ROPE = (float*)(ws_ + WS_ROPE); F.GATE = (bf16*)(ws_ + WS_GATE); F.CARRY = (float*)(ws_ + WS_CARRY); F.WI = (float*)(ws_ + WS_WI); F.KI = (bf16*)(ws_ + WS_KI); \
        F.MASK = (unsigned*)(ws_ + WS_MASK); F.WIN = (bf16*)(ws_ + WS_WIN); F.WOUT = (bf16*)(ws_ + WS_WOUT); F.WUP = (bf16*)(ws_ + WS_WUP); F.WDN = (bf16*)(ws_ + WS_WDN); \
        F.HA = (bf16*)(ws_ + WS_HA); F.P = (bf16*)(ws_ + WS_P); F.MG = (bf16*)(ws_ + WS_MG); F.HID = (bf16*)(ws_ + WS_HID)
    F.tid = threadIdx.x; F.lane = F.tid & 63; F.wave = __builtin_amdgcn_readfirstlane(F.tid >> 6);
    volatile LAS unsigned* MISC = (volatile LAS unsigned*)(F.lds + MISC_OFF);
    for (int u = F.tid; u < (LDS_BYTES - LDSCTL_OFF) / 4; u += NTHR) ((LAS unsigned*)(F.lds + LDSCTL_OFF))[u] = 0u;
    __syncthreads();
    XcdBarrier bar; bar.bar = (unsigned*)(F.ctl + CW_BAR); bar.x = 0; bar.st = nullptr;
    if (ONE_LAUNCH) bar = xcd_barrier_post((unsigned*)(F.ctl + CW_BAR), MISC + 8);
    const int lo = a.ph_lo, hi = a.ph_hi;
#define IN(k) (lo <= (k) && (k) < hi)
#if defined(PROBE_STOP) && PROBE_KIND >= 30
#define PH_T0(kk) const unsigned long long pht0_ = (l == 0 && PROBE_KIND == 30 + (kk)) ? __builtin_amdgcn_s_memrealtime() : 0ull
#define PH_T1(kk) do { if (l == 0 && PROBE_KIND == 30 + (kk)) { __syncthreads(); if (threadIdx.x == 0) { float* sl__ = (float*)F.ctl + 8; atomicAdd(sl__ + 2, (float)(__builtin_amdgcn_s_memrealtime() - pht0_)); atomicAdd(sl__ + 5, 1.0f); } } } while (0)
#else
#define PH_T0(kk) do { } while (0)
#define PH_T1(kk) do { } while (0)
#endif
#define SEAM(k) do { if (ONE_LAUNCH && IN(k) && IN((k) + 1)) xcd_barrier(bar); } while (0)

    #ifndef SKIP_P0
    if (IN(0)) { REPIN(); p0_prologue(F, a); SEAM(0); }
#endif

    for (int l = 0; l < DEPTH; ++l) {
        const int pb = 1 + l * PH_PER_LAYER;
#define modl (F.MODV + (size_t)l * BATCH * MODW)
#ifndef SKIP_ROWS
        if (IN(pb + 0) && l == 0) { REPIN(); modulate_rows(F, a.x, modl, 0 * DMODEL, 1 * DMODEL); SEAM(pb + 0); }
#endif
#if !defined(SKIP_GEMM) && !defined(SKIP_G1)
        if (IN(pb + 1)) { PH_T0(1);
            REPIN();
            pg8::Gemm g{F.HA, F.WIN + (size_t)l * INP * DMODEL, MTOK, INP, DMODEL}; pg8::StaticOrder S; S.init(MTOK, INP, F.G, (int)blockIdx.x);
            pg8::EpiInProj E{F.P, INP, F.ROPE, F.KI, F.WI};
            for (int rep_ = 0; rep_ < REP_G1; ++rep_) pg8::gemm_phase<pg8::EpiInProj, pg8::StaticOrder, true, true>(F.lds, g, S, E);
            PH_T1(1); SEAM(pb + 1);
        }
#endif
#ifndef SKIP_ROWS
#endif
        if (IN(pb + 3)) { PH_T0(3);
#ifndef SKIP_IDX
            { PH_T0(11); for (int rep_ = 0; rep_ < REP_IDX; ++rep_) { REPIN(); idx_phase(F, l); __syncthreads(); } PH_T1(11); }
#endif
#ifndef SKIP_LRU
            { PH_T0(12); for (int rep_ = 0; rep_ < REP_LRUA; ++rep_) { REPIN(); lru_phase<false>(F, a, l); __syncthreads(); } PH_T1(12); }
#endif
            PH_T1(3); SEAM(pb + 3); }
        if (IN(pb + 4)) { PH_T0(4);
#ifndef SKIP_ATT
            { PH_T0(13); for (int rep_ = 0; rep_ < REP_ATT; ++rep_) { REPIN(); attn_phase(F, (char*)lds); __syncthreads(); } PH_T1(13); }
#endif
#ifndef SKIP_LRU
            { PH_T0(14); for (int rep_ = 0; rep_ < REP_LRUB; ++rep_) { REPIN(); lru_phase<true>(F, a, l); __syncthreads(); } PH_T1(14); }
#endif
            PH_T1(4); SEAM(pb + 4); }
#ifndef SKIP_ROWS
        if (IN(pb + 5)) { PH_T0(5); REPIN(); rms_rows(F, a.g_attn + (size_t)l * AW, a.g_lru + (size_t)l * LW); PH_T1(5); SEAM(pb + 5); }
#endif
#if !defined(SKIP_GEMM) && !defined(SKIP_G6)
        if (IN(pb + 6)) { PH_T0(6);
            REPIN();
            pg8::Gemm g{F.MG, F.WOUT + (size_t)l * DMODEL * DMODEL, MTOK, DMODEL, DMODEL}; pg8::StaticOrder S; S.init(MTOK, DMODEL, F.G, (int)blockIdx.x);
            const float* xsrc = (l == 0) ? a.x : a.out;
            pg8::EpiResid E{xsrc, a.out, DMODEL, modl + 2 * DMODEL, MODW, SEQ, ALPHA, (l == 0) ? nullptr : F.STAT, a.ln2_g + (size_t)(l > 0 ? l - 1 : 0) * DMODEL, a.ln2_b + (size_t)(l > 0 ? l - 1 : 0) * DMODEL};
            pg8::gemm_phase<pg8::EpiResid, pg8::StaticOrder, true, true>(F.lds, g, S, E);
            PH_T1(6); SEAM(pb + 6);
        }
#endif
#ifndef SKIP_ROWS
        if (IN(pb + 7)) { PH_T0(7); REPIN(); for (int rep_ = 0; rep_ < REP_LN; ++rep_) ln_rows(F, a.out, F.STAT, a.ln1_g + (size_t)l * DMODEL, a.ln1_b + (size_t)l * DMODEL, modl, 3 * DMODEL, 4 * DMODEL, false); PH_T1(7); SEAM(pb + 7); }
#endif
#if !defined(SKIP_GEMM) && !defined(SKIP_G8)
        if (IN(pb + 8)) { PH_T0(8);
            REPIN();
            pg8::Gemm g{F.HA, F.WUP + (size_t)l * FF * DMODEL, MTOK, FF, DMODEL}; pg8::StaticOrder S; S.init(MTOK, FF, F.G, (int)blockIdx.x);
            pg8::EpiOutBf16<1> E{F.HID, FF};
            for (int rep_ = 0; rep_ < REP_G8; ++rep_) pg8::gemm_phase<pg8::EpiOutBf16<1>, pg8::StaticOrder, true, true>(F.lds, g, S, E);
            PH_T1(8); SEAM(pb + 8);
        }
#endif
#if !defined(SKIP_GEMM) && !defined(SKIP_G9)
        if (IN(pb + 9)) { PH_T0(9);
            REPIN();
            pg8::Gemm g{F.HID, F.WDN + (size_t)l * DMODEL * FF, MTOK, DMODEL, FF}; pg8::StaticOrder S; S.init(MTOK, DMODEL, F.G, (int)blockIdx.x);
            pg8::EpiResid E{a.out, a.out, DMODEL, modl + 5 * DMODEL, MODW, SEQ, ALPHA, F.STAT, a.ln1_g + (size_t)l * DMODEL, a.ln1_b + (size_t)l * DMODEL};
            pg8::gemm_phase<pg8::EpiResid, pg8::StaticOrder, true, true>(F.lds, g, S, E);
            PH_T1(9); SEAM(pb + 9);
        }
#endif
#ifndef SKIP_ROWS
        if (IN(pb + 10)) { PH_T0(10);
            REPIN();
            const float* modn = (l + 1 < DEPTH) ? F.MODV + (size_t)(l + 1) * BATCH * MODW : nullptr;
            ln_rows(F, a.out, F.STAT, a.ln2_g + (size_t)l * DMODEL, a.ln2_b + (size_t)l * DMODEL, modn, 0 * DMODEL, 1 * DMODEL, l + 1 == DEPTH);
            PH_T1(10); SEAM(pb + 10);
        }
#endif
    }
#ifdef PROBE_STOP
    if (IN(N_PHASES)) {
        REPIN();
        const size_t gt = (size_t)F.vcu * NTHR + F.tid, gs = (size_t)F.G * NTHR;
        const size_t NA = (size_t)MTOK * 128, NB = (size_t)BATCH * NLCH * LW * 2, NT_ = (size_t)MTOK * DMODEL;
        for (size_t i = gt; i < NT_; i += gs) {
            float v;
            if (PROBE_KIND == 0) {
                if (i < 2 * NA) { const unsigned w = F.MASK[i >> 1]; v = (float)((i & 1) ? (w >> 16) : (w & 0xffffu)); }
                else if (i < 2 * NA + NB) v = F.CARRY[i - 2 * NA];
                else v = bf2f(F.P[i - 2 * NA - NB]);
            } else if (PROBE_KIND == 1) { v = bf2f(F.MG[i]); }
            else if (PROBE_KIND == 2) { v = bf2f(F.HA[i]); }
            else { v = bf2f(F.P[i]); }
            a.out[i] = v;
        }
    }
    if (IN(N_PHASES + 1)) {
        REPIN();
        float* slot = (float*)(a.ws + WS_CTL) + 8;
        const int gw = F.vcu * NWAVES + F.wave, NGW = F.G * NWAVES;
        if (PROBE_KIND == 10) {
            float bad = 0.f;
            for (int m = gw; m < MTOK; m += NGW) { const int t = m % SEQ;
                const unsigned w0 = F.MASK[(size_t)m * 128 + 2 * F.lane], w1 = F.MASK[(size_t)m * 128 + 2 * F.lane + 1];
                int pc = __builtin_popcount(w0) + __builtin_popcount(w1); int beyond = 0;
#pragma unroll
                for (int bb = 0; bb < 64; ++bb) { const int s = 64 * F.lane + bb; const unsigned bit = bb < 32 ? (w0 >> bb) & 1u : (w1 >> (bb - 32)) & 1u; if (bit && s > t) beyond = 1; }
#pragma unroll
                for (int o = 1; o < 64; o <<= 1) { pc += __shfl_xor(pc, o); beyond |= __shfl_xor(beyond, o); }
                const int want = t + 1 < TOPK ? t + 1 : TOPK;
                if (pc != want || beyond) bad += 1.f; }
            if (F.lane == 0 && bad > 0.f) atomicAdd(slot, bad * (1.0f / MTOK));
        }
        if (PROBE_KIND == 11) probe_idx(F, slot);
        if (PROBE_KIND == 12) probe_attn(F, slot);
        if (PROBE_KIND == 13) probe_lru(F, a, 0, slot);
        if (PROBE_KIND == 14) probe_gemm(F, F.HA, F.WIN, F.P, INP, DMODEL, INP, 0, slot);
        if (PROBE_KIND == 15) probe_gemm(F, F.HA, F.WUP, F.HID, FF, DMODEL, FF, 1, slot);
    }
    if (IN(N_PHASES + 2)) {
        REPIN();
        const float* sl_ = (const float*)(a.ws + WS_CTL) + 8;
        float e = (PROBE_KIND == 10) ? sl_[0] : sl_[0] / fmaxf(sl_[1], 1e-30f);
        if (PROBE_KIND == 20) e = 1e-6f * sl_[2] / fmaxf(sl_[5], 1.f);
        if (PROBE_KIND == 21) e = 1e-6f * sl_[2] / fmaxf(sl_[5], 1.f);
        if (PROBE_KIND == 22) e = 1e-6f * sl_[2] / fmaxf(sl_[5], 1.f);
        if (PROBE_KIND >= 30) e = 1e-6f * sl_[2] / fmaxf(sl_[5], 1.f);
        if (PROBE_KIND >= 21 && PROBE_KIND < 30) e = exp2f(rintf(log2f(fmaxf(e, 1e-20f)) * 4.f) * 0.25f);
        if (PROBE_KIND >= 30) e = exp2f(rintf(log2f(fmaxf(e, 1e-20f)) * 2.f) * 0.5f);
        const float cst = sqrtf(fmaxf(e, 0.f) * 1e6f);
        for (size_t i = (size_t)F.vcu * NTHR + F.tid; i < (size_t)MTOK * DMODEL; i += (size_t)F.G * NTHR) a.out[i] = cst;
    }
#endif
#undef modl
#undef IN
#undef SEAM
#undef REPIN
}

extern "C" void kernel_launch(void* const* d_in, const int* in_sizes, int n_in, void* d_out, int out_size, void* d_ws, size_t ws_size, hipStream_t stream) {
    static int grid = 0;
    if (grid == 0) {
        if (n_in != 22 || in_sizes[0] != MTOK * DMODEL || out_size != MTOK * DMODEL || ws_size < WS_END) {
            fprintf(stderr, "kernel_launch: unexpected shapes (n_in %d, in0 %d, out %d, ws %zu; need ws >= %zu); nothing launched\n", n_in, n_in > 0 ? in_sizes[0] : -1, out_size, ws_size, (size_t)WS_END); grid = -1; return; }
        int dev = 0, cus = 0, per_cu = 0;
        if (hipGetDevice(&dev) != hipSuccess || hipDeviceGetAttribute(&cus, hipDeviceAttributeMultiprocessorCount, dev) != hipSuccess) { fprintf(stderr, "kernel_launch: device query failed\n"); grid = -1; return; }
        if (hipFuncSetAttribute((const void*)fwd_kernel, hipFuncAttributeMaxDynamicSharedMemorySize, LDS_BYTES) != hipSuccess) { fprintf(stderr, "kernel_launch: hipFuncSetAttribute failed\n"); grid = -1; return; }
        if (hipOccupancyMaxActiveBlocksPerMultiprocessor(&per_cu, (const void*)fwd_kernel, NTHR, LDS_BYTES) != hipSuccess || per_cu < 1)
            fprintf(stderr, "kernel_launch: note: occupancy query reports %d workgroups per CU\n", per_cu);
        (void)hipGetLastError();
        grid = cus;
    }
    if (grid < 0) return;
    if (hipMemsetAsync((char*)d_ws + WS_CTL, 0, CTL_ZERO_BYTES, stream) != hipSuccess) { fprintf(stderr, "kernel_launch: memset failed\n"); return; }
    Args a{};
    a.x = (const float*)d_in[0]; a.c = (const float*)d_in[1]; a.pos = (const int*)d_in[2];
    a.w_mod = (const float*)d_in[3]; a.b_mod = (const float*)d_in[4]; a.w_in = (const float*)d_in[5]; a.conv_w = (const float*)d_in[6]; a.conv_b = (const float*)d_in[7];
    a.wga = (const float*)d_in[8]; a.bga = (const float*)d_in[9]; a.wgx = (const float*)d_in[10]; a.bgx = (const float*)d_in[11]; a.lam = (const float*)d_in[12];
    a.g_attn = (const float*)d_in[13]; a.g_lru = (const float*)d_in[14]; a.w_out = (const float*)d_in[15]; a.ln1_g = (const float*)d_in[16]; a.ln1_b = (const float*)d_in[17];
    a.w_up = (const float*)d_in[18]; a.w_down = (const float*)d_in[19]; a.ln2_g = (const float*)d_in[20]; a.ln2_b = (const float*)d_in[21];
    a.out = (float*)d_out; a.ws = (unsigned char*)d_ws;
    if (ONE_LAUNCH) {
        a.ph_lo = 0; a.ph_hi = N_PHASES;
        hipLaunchKernelGGL(fwd_kernel, dim3(grid), dim3(NTHR), LDS_BYTES, stream, a);
    } else {
#ifdef PROBE_STOP
        const int np_ = PROBE_STOP;
#else
        const int np_ = N_PHASES;
#endif
        for (int p = 0; p < np_; ++p) {
            if (p >= 1 && ((p - 1) % PH_PER_LAYER) == 0 && p != 1) continue;
            a.ph_lo = p; a.ph_hi = p + 1;
            hipLaunchKernelGGL(fwd_kernel, dim3(grid), dim3(NTHR), LDS_BYTES, stream, a);
        }
    }
#ifdef PROBE_STOP
    if (PROBE_KIND < 10) { a.ph_lo = N_PHASES; a.ph_hi = N_PHASES + 1; hipLaunchKernelGGL(fwd_kernel, dim3(grid), dim3(NTHR), LDS_BYTES, stream, a); }
    else { a.ph_lo = N_PHASES + 1; a.ph_hi = N_PHASES + 2; hipLaunchKernelGGL(fwd_kernel, dim3(grid), dim3(NTHR), LDS_BYTES, stream, a);
           a.ph_lo = N_PHASES + 2; a.ph_hi = N_PHASES + 3; hipLaunchKernelGGL(fwd_kernel, dim3(grid), dim3(NTHR), LDS_BYTES, stream, a); }
#endif
    const hipError_t le = hipPeekAtLastError();
    if (le != hipSuccess) fprintf(stderr, "kernel_launch: launch failed: %s\n", hipGetErrorName(le));
}
```
